# Optimizing an MI355X kernel written in HIP

```python
import math
import jax, jax.numpy as jnp
from jax import lax
import numpy as np

D_MODEL = 1024
BATCH = 8
SEQ = 2048
DEPTH = 4

HEAD_DIM = 64
MIX_WIDTH = D_MODEL
A_HEADS = MIX_WIDTH // 2 // HEAD_DIM
A_PATTERNS = ((128, 1), (512, 4), (2048, 16))
B_HEADS = MIX_WIDTH // 2 // (2 * HEAD_DIM)
C_HEADS = MIX_WIDTH // HEAD_DIM
C_KV_HEADS = C_HEADS // 4
C_HALF_WINDOW = 128
Q_BLOCK = 128
A_WIDTH = A_HEADS * HEAD_DIM
B_QK_WIDTH = B_HEADS * 2 * HEAD_DIM
B_V_WIDTH = B_HEADS * 2 * HEAD_DIM
EVEN_IN = 3 * A_WIDTH + 2 * B_QK_WIDTH + B_V_WIDTH + MIX_WIDTH
C_KV_WIDTH = C_KV_HEADS * HEAD_DIM
ODD_IN = MIX_WIDTH + 2 * C_KV_WIDTH + MIX_WIDTH
EPS = 1e-6
NEG_INF = -1e30

kernel_name = "hybrid_dilated_diff_swa_encoder"


def rms_norm(x, g):
    x32 = x.astype(jnp.float32)
    y = x32 * lax.rsqrt(jnp.mean(x32 * x32, axis=-1, keepdims=True) + EPS)
    return (y * g.astype(jnp.float32)).astype(x.dtype)


def alibi_slopes(n):
    return 2.0 ** (-8.0 * jnp.arange(1, n + 1, dtype=jnp.float32) / n)


def banded_attention(q, k, v, slopes, spacing, W):
    B, G, R, L, dh = q.shape
    nb = -(-L // W)
    Lp = nb * W
    pad = Lp - L
    qb = jnp.pad(q, ((0, 0), (0, 0), (0, 0), (0, pad), (0, 0))).reshape(B, G, R, nb, W, dh)

    def windows(t):
        tp = jnp.pad(t, ((0, 0), (0, 0), (W, W + pad), (0, 0))).reshape(B, G, nb + 2, W, t.shape[-1])
        return jnp.concatenate([tp[:, :, 0:nb], tp[:, :, 1:nb + 1], tp[:, :, 2:nb + 2]], axis=3)

    kw, vw = windows(k), windows(v)
    s = jnp.einsum('bgrnid,bgncd->bgrnic', qb, kw, preferred_element_type=jnp.float32)
    blk = jnp.arange(nb)[:, None, None]
    qpos = blk * W + jnp.arange(W)[None, :, None]
    kpos = blk * W - W + jnp.arange(3 * W)[None, None, :]
    rel = jnp.abs(kpos - qpos)
    valid = (rel <= W) & (kpos >= 0) & (kpos < L)
    dist = (rel * spacing).astype(jnp.float32)
    s = s - slopes.astype(jnp.float32)[None, :, :, None, None, None] * dist
    s = jnp.where(valid, s, NEG_INF)
    m = jnp.max(s, axis=-1)
    p = jnp.exp(s - m[..., None])
    l = jnp.sum(p, axis=-1)
    acc = jnp.einsum('bgrnic,bgncd->bgrnid', p, vw.astype(jnp.float32))
    m = m.reshape(B, G, R, Lp)[..., :L]
    l = l.reshape(B, G, R, Lp)[..., :L]
    acc = acc.reshape(B, G, R, Lp, -1)[:, :, :, :L]
    return m, l, acc


def dilated_mixture_attention(q, k, v):
    B, H, S, dh = q.shape
    q = q * (dh ** -0.5)
    slopes = alibi_slopes(H)
    ms, ls, accs = [], [], []
    for window, dil in A_PATTERNS:
        L = S // dil
        half = window // (2 * dil)

        def to_res(t):
            return t.reshape(B, H, L, dil, t.shape[-1]).transpose(0, 1, 3, 2, 4).reshape(B, H * dil, L, t.shape[-1])

        def from_res(t):
            t = t.reshape((B, H, dil, L) + t.shape[3:])
            t = jnp.swapaxes(t, 2, 3)
            return t.reshape((B, H, S) + t.shape[4:])

        m, l, acc = banded_attention(to_res(q)[:, :, None], to_res(k), to_res(v),
                                     jnp.repeat(slopes, dil)[:, None], dil, half)
        ms.append(from_res(m[:, :, 0]))
        ls.append(from_res(l[:, :, 0]))
        accs.append(from_res(acc[:, :, 0]))
    m = jnp.stack(ms)
    w = jnp.exp(m - jnp.max(m, axis=0))
    num = jnp.sum(w[..., None] * jnp.stack(accs), axis=0)
    den = jnp.sum(w * jnp.stack(ls), axis=0)
    return num / den[..., None]


def differential_attention(q1, q2, k1, k2, v, lam, lam_init, subln_g):
    B, H, S, dh = q1.shape
    scale = dh ** -0.5
    slopes = alibi_slopes(H)
    kpos = jnp.arange(S)
    v32 = v.astype(jnp.float32)

    def block(n):
        start = n * Q_BLOCK
        qpos = start + jnp.arange(Q_BLOCK)
        bias = -slopes[:, None, None] * jnp.abs(qpos[:, None] - kpos[None, :]).astype(jnp.float32)

        def attn(q, k):
            qs = lax.dynamic_slice_in_dim(q, start, Q_BLOCK, axis=2)
            s = jnp.einsum('bhqd,bhkd->bhqk', qs, k, preferred_element_type=jnp.float32) * scale + bias
            return jax.nn.softmax(s, axis=-1)

        a = attn(q1, k1) - lam * attn(q2, k2)
        return jnp.einsum('bhqk,bhkd->bhqd', a, v32)

    out = lax.map(block, jnp.arange(S // Q_BLOCK))
    out = jnp.moveaxis(out, 0, 2).reshape(B, H, S, 2 * dh)
    return rms_norm(out, subln_g) * (1.0 - lam_init)


def even_mixer(h, w_in, w_out, lq1, lk1, lq2, lk2, subln_g, lam_init):
    B, S, _ = h.shape
    proj = h @ w_in
    cuts = np.cumsum([A_WIDTH] * 3 + [B_QK_WIDTH] * 2 + [B_V_WIDTH]).tolist()
    qa, ka, va, qb, kb, vb, g = jnp.split(proj, cuts, axis=-1)

    def heads(t, n):
        return t.reshape(B, S, n, -1).transpose(0, 2, 1, 3)

    ya = dilated_mixture_attention(heads(qa, A_HEADS), heads(ka, A_HEADS), heads(va, A_HEADS))
    qb, kb, vb = heads(qb, B_HEADS), heads(kb, B_HEADS), heads(vb, B_HEADS)
    f32 = jnp.float32
    lam = (jnp.exp(jnp.sum(lq1.astype(f32) * lk1.astype(f32)))
           - jnp.exp(jnp.sum(lq2.astype(f32) * lk2.astype(f32))) + lam_init)
    yb = differential_attention(qb[..., :HEAD_DIM], qb[..., HEAD_DIM:],
                                kb[..., :HEAD_DIM], kb[..., HEAD_DIM:], vb, lam, lam_init, subln_g)
    y = jnp.concatenate([ya.transpose(0, 2, 1, 3).reshape(B, S, A_WIDTH),
                         yb.transpose(0, 2, 1, 3).reshape(B, S, B_V_WIDTH)], axis=-1).astype(h.dtype)
    return (y * jax.nn.silu(g)) @ w_out


def odd_mixer(h, w_in, w_out, sink):
    B, S, _ = h.shape
    R = C_HEADS // C_KV_HEADS
    proj = h @ w_in
    q, k, v, g = jnp.split(proj, [MIX_WIDTH, MIX_WIDTH + C_KV_WIDTH, MIX_WIDTH + 2 * C_KV_WIDTH], axis=-1)
    q = q.reshape(B, S, C_KV_HEADS, R, HEAD_DIM).transpose(0, 2, 3, 1, 4) * (HEAD_DIM ** -0.5)
    k = k.reshape(B, S, C_KV_HEADS, HEAD_DIM).transpose(0, 2, 1, 3)
    v = v.reshape(B, S, C_KV_HEADS, HEAD_DIM).transpose(0, 2, 1, 3)
    slopes = alibi_slopes(C_HEADS).reshape(C_KV_HEADS, R)
    m, l, acc = banded_attention(q, k, v, slopes, 1, C_HALF_WINDOW)
    sk = sink.astype(jnp.float32).reshape(C_KV_HEADS, R)[None, :, :, None]
    M = jnp.maximum(m, sk)
    e = jnp.exp(m - M)
    y = acc * e[..., None] / (l * e + jnp.exp(sk - M))[..., None]
    y = y.transpose(0, 3, 1, 2, 4).reshape(B, S, MIX_WIDTH).astype(h.dtype)
    return (y * jax.nn.silu(g)) @ w_out


def setup_inputs(seed: int = 0) -> dict:
    key = jax.random.key(seed)
    ks = jax.random.split(key, 16)
    n_even = (DEPTH + 1) // 2
    n_odd = DEPTH // 2

    def nrm(k, shape, scale):
        return jax.random.normal(k, shape, jnp.float32) * scale

    return {
        "x": nrm(ks[0], (BATCH, SEQ, D_MODEL), 1.0),
        "c": nrm(ks[1], (BATCH, D_MODEL), 1.0),
        "ada_w": nrm(ks[2], (DEPTH, D_MODEL, 3 * D_MODEL), 0.5 * D_MODEL ** -0.5),
        "ada_b": nrm(ks[3], (DEPTH, 3 * D_MODEL), 0.02),
        "norm_g": 1.0 + nrm(ks[4], (DEPTH, D_MODEL), 0.05),
        "ab_w_in": nrm(ks[5], (n_even, D_MODEL, EVEN_IN), D_MODEL ** -0.5),
        "ab_w_out": nrm(ks[6], (n_even, MIX_WIDTH, D_MODEL), MIX_WIDTH ** -0.5),
        "diff_lq1": nrm(ks[7], (n_even, HEAD_DIM), 0.1),
        "diff_lk1": nrm(ks[8], (n_even, HEAD_DIM), 0.1),
        "diff_lq2": nrm(ks[9], (n_even, HEAD_DIM), 0.1),
        "diff_lk2": nrm(ks[10], (n_even, HEAD_DIM), 0.1),
        "diff_subln_g": 1.0 + nrm(ks[11], (n_even, 2 * HEAD_DIM), 0.05),
        "c_w_in": nrm(ks[12], (n_odd, D_MODEL, ODD_IN), D_MODEL ** -0.5),
        "c_w_out": nrm(ks[13], (n_odd, MIX_WIDTH, D_MODEL), MIX_WIDTH ** -0.5),
        "c_sink": nrm(ks[14], (n_odd, C_HEADS), 1.0),
        "final_g": 1.0 + nrm(ks[15], (D_MODEL,), 0.05),
    }


def reference(x, c, ada_w, ada_b, norm_g, ab_w_in, ab_w_out, diff_lq1, diff_lk1,
              diff_lq2, diff_lk2, diff_subln_g, c_w_in, c_w_out, c_sink, final_g):
    cs = jax.nn.silu(c)
    for layer in range(DEPTH):
        mod = cs @ ada_w[layer] + ada_b[layer]
        shift, scale, gate = jnp.split(mod, 3, axis=-1)
        h = rms_norm(x, norm_g[layer]) * (1.0 + scale[:, None, :]) + shift[:, None, :]
        j = layer // 2
        if layer % 2 == 0:
            lam_init = 0.8 - 0.6 * math.exp(-0.3 * layer)
            y = even_mixer(h, ab_w_in[j], ab_w_out[j], diff_lq1[j], diff_lk1[j],
                           diff_lq2[j], diff_lk2[j], diff_subln_g[j], lam_init)
        else:
            y = odd_mixer(h, c_w_in[j], c_w_out[j], c_sink[j])
        x = x + gate[:, None, :] * y
    return rms_norm(x, final_g)
```

```cpp
#include <hip/hip_runtime.h>
#include <cstdio>
#include <cstdint>

namespace nv {
typedef unsigned short bf16;
constexpr int B_ = 8, S_ = 2048, D_ = 1024, M_ = B_ * S_;
constexpr float LOG2E = 1.4426950408889634f;
constexpr float QSCALE = 0.125f * LOG2E;
constexpr float EPS = 1e-6f;

__device__ __forceinline__ float bf2f(bf16 v) { return __uint_as_float(((unsigned)v) << 16); }
__device__ __forceinline__ bf16 f2bf(float f) { unsigned u = __float_as_uint(f); u += 0x7fffu + ((u >> 16) & 1u); return (bf16)(u >> 16); }
__device__ __forceinline__ float silu(float x) { return x / (1.f + __expf(-x)); }
__device__ __forceinline__ float wave_sum(float v) { for (int o = 32; o >= 1; o >>= 1) v += __shfl_xor(v, o); return v; }
__device__ __forceinline__ float wave_max(float v) { for (int o = 32; o >= 1; o >>= 1) v = fmaxf(v, __shfl_xor(v, o)); return v; }
__device__ __forceinline__ int pi16(int t) { return (t & 15) * 128 + (t >> 4); }

constexpr size_t MiB = 1u << 20;
constexpr size_t WS_MOD = 0;
constexpr size_t WS_LAM = 512 * 1024;
constexpr size_t WS_H = 1 * MiB;
constexpr size_t WS_YMIX = 33 * MiB;
constexpr size_t WS_SG = 65 * MiB;
constexpr size_t WS_P = 97 * MiB;
constexpr size_t WS_QA = WS_P, WS_KA = WS_P + 16 * MiB, WS_VA = WS_P + 32 * MiB, WS_QB = WS_P + 48 * MiB, WS_KB = WS_P + 64 * MiB, WS_VB = WS_P + 80 * MiB;
constexpr size_t WS_QC = WS_P, WS_KC = WS_P + 32 * MiB, WS_VC = WS_P + 40 * MiB;
constexpr size_t WS_END = WS_P + 96 * MiB;

__global__ void k_mod(const float* c, const float* ada_w, const float* ada_b, float* mod,
                      const float* lq1, const float* lk1, const float* lq2, const float* lk2, float* lam) {
    const int idx = blockIdx.x * blockDim.x + threadIdx.x;
    if (idx < 4 * 8 * 3072) {
        const int j = idx % 3072, b = (idx / 3072) % 8, l = idx / (3072 * 8);
        float acc = 0.f;
        for (int k = 0; k < 1024; ++k) acc += silu(c[b * 1024 + k]) * ada_w[((size_t)l * 1024 + k) * 3072 + j];
        mod[idx] = acc + ada_b[l * 3072 + j];
    }
    if (idx < 2) {
        float s1 = 0.f, s2 = 0.f;
        for (int d = 0; d < 64; ++d) { s1 += lq1[idx * 64 + d] * lk1[idx * 64 + d]; s2 += lq2[idx * 64 + d] * lk2[idx * 64 + d]; }
        const float lam_init = 0.8f - 0.6f * expf(-0.3f * (float)(2 * idx));
        lam[idx] = expf(s1) - expf(s2) + lam_init;
    }
}

__global__ void k_norm(const float* x, const float* g, const float* mod_l, bf16* h) {
    const int row = blockIdx.x * 4 + (threadIdx.x >> 6), lane = threadIdx.x & 63, b = row / S_;
    const float* xr = x + (size_t)row * D_;
    float ss = 0.f;
    for (int k = lane; k < D_; k += 64) ss += xr[k] * xr[k];
    ss = wave_sum(ss);
    const float rstd = rsqrtf(ss / D_ + EPS);
    const float* shift = mod_l + b * 3072, *scale = shift + 1024;
    for (int k = lane; k < D_; k += 64) h[(size_t)row * D_ + k] = f2bf(xr[k] * rstd * g[k] * (1.f + scale[k]) + shift[k]);
}

struct EpiEven { bf16* ws; __device__ void operator()(int row, int n, float v) const {
    const int b = row / S_, t = row % S_; unsigned char* w = (unsigned char*)ws;
    if (n < 1536) { const int which = n / 512, c = n % 512, h = c / 64, d = c % 64;
        bf16* dst = (bf16*)(w + (which == 0 ? WS_QA : which == 1 ? WS_KA : WS_VA));
        dst[((size_t)(b * 8 + h) * S_ + pi16(t)) * 64 + d] = f2bf(which == 0 ? v * QSCALE : v);
    } else if (n < 2560) { const int which = (n - 1536) / 512, c = (n - 1536) % 512, h = c / 128, w2 = (c % 128) / 64, d = c % 64;
        bf16* dst = (bf16*)(w + (which == 0 ? WS_QB : WS_KB));
        dst[((size_t)(b * 8 + h * 2 + w2) * S_ + t) * 64 + d] = f2bf(which == 0 ? v * QSCALE : v);
    } else if (n < 3072) { const int c = n - 2560, h = c / 128, dv = c % 128;
        ((bf16*)(w + WS_VB))[((size_t)(b * 4 + h) * S_ + t) * 128 + dv] = f2bf(v);
    } else { ((bf16*)(w + WS_SG))[(size_t)row * 1024 + (n - 3072)] = f2bf(silu(v)); }
} };
struct EpiOdd { bf16* ws; __device__ void operator()(int row, int n, float v) const {
    const int b = row / S_, t = row % S_; unsigned char* w = (unsigned char*)ws;
    if (n < 1024) { const int h = n / 64, d = n % 64; ((bf16*)(w + WS_QC))[((size_t)(b * 16 + h) * S_ + t) * 64 + d] = f2bf(v * QSCALE); }
    else if (n < 1280) { const int c = n - 1024, h = c / 64, d = c % 64; ((bf16*)(w + WS_KC))[((size_t)(b * 4 + h) * S_ + t) * 64 + d] = f2bf(v); }
    else if (n < 1536) { const int c = n - 1280, h = c / 64, d = c % 64; ((bf16*)(w + WS_VC))[((size_t)(b * 4 + h) * S_ + t) * 64 + d] = f2bf(v); }
    else { ((bf16*)(w + WS_SG))[(size_t)row * 1024 + (n - 1536)] = f2bf(silu(v)); }
} };
struct EpiOut { const float* xin; float* xout; const float* gate_l; __device__ void operator()(int row, int n, float v) const {
    const int b = row / S_; xout[(size_t)row * D_ + n] = xin[(size_t)row * D_ + n] + gate_l[b * 3072 + n] * v;
} };

template <class Epi>
__global__ void __launch_bounds__(256) k_gemm(const bf16* A, const float* W, int N, int K, Epi E) {
    __shared__ float As[16][65], Ws[16][65];
    const int tx = threadIdx.x & 15, ty = threadIdx.x >> 4, m0 = blockIdx.y * 64, n0 = blockIdx.x * 64;
    float acc[4][4] = {};
    for (int k0 = 0; k0 < K; k0 += 16) {
        for (int i = threadIdx.x; i < 1024; i += 256) { const int r = i >> 4, kk = i & 15; As[kk][r] = bf2f(A[(size_t)(m0 + r) * K + k0 + kk]); }
        for (int i = threadIdx.x; i < 1024; i += 256) { const int kk = i >> 6, cc = i & 63; Ws[kk][cc] = W[(size_t)(k0 + kk) * N + n0 + cc]; }
        __syncthreads();
#pragma unroll
        for (int kk = 0; kk < 16; ++kk) {
            float a[4], w[4];
#pragma unroll
            for (int i = 0; i < 4; ++i) { a[i] = As[kk][ty * 4 + i]; w[i] = Ws[kk][tx * 4 + i]; }
#pragma unroll
            for (int i = 0; i < 4; ++i)
#pragma unroll
                for (int j = 0; j < 4; ++j) acc[i][j] += a[i] * w[j];
        }
        __syncthreads();
    }
#pragma unroll
    for (int i = 0; i < 4; ++i)
#pragma unroll
        for (int j = 0; j < 4; ++j) E(m0 + ty * 4 + i, n0 + tx * 4 + j, acc[i][j]);
}

__global__ void __launch_bounds__(256) k_attn_dil(const bf16* QA, const bf16* KA, const bf16* VA, const bf16* SG, bf16* ymix) {
    __shared__ float ps[4][132]; __shared__ float qs[4][64];
    const int wid = threadIdx.x >> 6, lane = threadIdx.x & 63;
    const int gq = blockIdx.x * 4 + wid;
    const int t = gq % S_, bh = gq / S_, h = bh % 8, b = bh / 8;
    const float slope = exp2f(-(float)(h + 1)) * LOG2E;
    const bf16* Kh = KA + (size_t)bh * S_ * 64; const bf16* Vh = VA + (size_t)bh * S_ * 64;
    qs[wid][lane] = bf2f(QA[((size_t)bh * S_ + pi16(t)) * 64 + lane]);
    __syncthreads();
    float mP[3], lP[3], accP[3];
#pragma unroll
    for (int p = 0; p < 3; ++p) {
        const int dil = (p == 0) ? 1 : (p == 1) ? 4 : 16, L = S_ / dil, m = t / dil, r = t % dil;
        float sv[3]; float mx = -1e30f;
#pragma unroll
        for (int i = 0; i < 3; ++i) { const int kk = lane + 64 * i; sv[i] = -1e30f;
            if (kk < 129) { const int mk = m - 64 + kk;
                if (mk >= 0 && mk < L) { const int tk = mk * dil + r; const bf16* kr = Kh + (size_t)pi16(tk) * 64; float s = 0.f;
                    for (int d = 0; d < 64; ++d) s += qs[wid][d] * bf2f(kr[d]);
                    sv[i] = s - slope * fabsf((float)(tk - t)); } }
            mx = fmaxf(mx, sv[i]); }
        mx = wave_max(mx);
        float lsum = 0.f;
#pragma unroll
        for (int i = 0; i < 3; ++i) { const int kk = lane + 64 * i; if (kk < 129) { const float pv = (sv[i] > -1e29f) ? exp2f(sv[i] - mx) : 0.f; ps[wid][kk] = pv; lsum += pv; } }
        lsum = wave_sum(lsum);
        __syncthreads();
        float a = 0.f;
        for (int kk = 0; kk < 129; ++kk) { const int mk = m - 64 + kk; if (mk >= 0 && mk < L) { const int tk = mk * dil + r; a += ps[wid][kk] * bf2f(Vh[(size_t)pi16(tk) * 64 + lane]); } }
        __syncthreads();
        mP[p] = mx; lP[p] = lsum; accP[p] = a;
    }
    const float Mx = fmaxf(mP[0], fmaxf(mP[1], mP[2]));
    float num = 0.f, den = 0.f;
#pragma unroll
    for (int p = 0; p < 3; ++p) { const float w = exp2f(mP[p] - Mx); num += w * accP[p]; den += w * lP[p]; }
    const float y = num / den;
    const size_t row = (size_t)b * S_ + t, col = h * 64 + lane;
    ymix[row * 1024 + col] = f2bf(y * bf2f(SG[row * 1024 + col]));
}

__global__ void __launch_bounds__(256) k_attn_diff(const bf16* QB, const bf16* KB, const bf16* VB, const bf16* SG, const float* subln_g, const float* lam_p, float lam_init, bf16* ymix) {
    __shared__ float s1[2048], s2[2048], q1[64], q2[64], red[8], o2[128];
    const int tid = threadIdx.x, lane = tid & 63, wid = tid >> 6;
    const int gq = blockIdx.x, t = gq % S_, bh = gq / S_, h = bh % 4, b = bh / 4;
    const float slope = exp2f(-2.f * (float)(h + 1)) * LOG2E, lam = lam_p[0];
    const size_t hw1 = (size_t)(b * 8 + h * 2) * S_, hw2 = hw1 + S_;
    if (tid < 64) q1[tid] = bf2f(QB[(hw1 + t) * 64 + tid]); else if (tid < 128) q2[tid - 64] = bf2f(QB[(hw2 + t) * 64 + tid - 64]);
    __syncthreads();
    float m1 = -1e30f, m2 = -1e30f;
    for (int j = tid; j < S_; j += 256) { const bf16* k1 = KB + (hw1 + j) * 64; const bf16* k2 = KB + (hw2 + j) * 64; float a = 0.f, c = 0.f;
        for (int d = 0; d < 64; ++d) { a += q1[d] * bf2f(k1[d]); c += q2[d] * bf2f(k2[d]); }
        const float bias = slope * fabsf((float)(t - j)); a -= bias; c -= bias; s1[j] = a; s2[j] = c; m1 = fmaxf(m1, a); m2 = fmaxf(m2, c); }
    m1 = wave_max(m1); m2 = wave_max(m2);
    if (lane == 0) { red[wid] = m1; red[4 + wid] = m2; }
    __syncthreads();
    m1 = fmaxf(fmaxf(red[0], red[1]), fmaxf(red[2], red[3])); m2 = fmaxf(fmaxf(red[4], red[5]), fmaxf(red[6], red[7]));
    __syncthreads();
    float l1 = 0.f, l2 = 0.f;
    for (int j = tid; j < S_; j += 256) { const float a = exp2f(s1[j] - m1), c = exp2f(s2[j] - m2); s1[j] = a; s2[j] = c; l1 += a; l2 += c; }
    l1 = wave_sum(l1); l2 = wave_sum(l2);
    if (lane == 0) { red[wid] = l1; red[4 + wid] = l2; }
    __syncthreads();
    l1 = red[0] + red[1] + red[2] + red[3]; l2 = red[4] + red[5] + red[6] + red[7];
    const float i1 = 1.f / l1, i2 = lam / l2;
    const int dv = tid & 127, half = tid >> 7;
    const bf16* Vh = VB + (size_t)(b * 4 + h) * S_ * 128;
    float o = 0.f;
    for (int j = half; j < S_; j += 2) o += (s1[j] * i1 - s2[j] * i2) * bf2f(Vh[(size_t)j * 128 + dv]);
    __syncthreads();
    if (half == 1) o2[dv] = o;
    __syncthreads();
    if (half == 0) { o += o2[dv];
        float ss = wave_sum(o * o);
        if (lane == 0) red[wid] = ss; }
    __syncthreads();
    if (half == 0) { const float ss = red[0] + red[1]; const float rstd = rsqrtf(ss / 128.f + EPS);
        const float y = o * rstd * subln_g[dv] * (1.f - lam_init);
        const size_t row = (size_t)b * S_ + t, col = 512 + h * 128 + dv;
        ymix[row * 1024 + col] = f2bf(y * bf2f(SG[row * 1024 + col])); }
}

__global__ void __launch_bounds__(256) k_attn_band(const bf16* QC, const bf16* KC, const bf16* VC, const bf16* SG, const float* sink_l, bf16* ymix) {
    __shared__ float ps[4][260]; __shared__ float qs[4][64];
    const int wid = threadIdx.x >> 6, lane = threadIdx.x & 63;
    const int gq = blockIdx.x * 4 + wid; const int t = gq % S_, bh = gq / S_, h = bh % 16, b = bh / 16, g = h / 4;
    const float slope = exp2f(-0.5f * (float)(h + 1)) * LOG2E;
    const bf16* Kh = KC + (size_t)(b * 4 + g) * S_ * 64; const bf16* Vh = VC + (size_t)(b * 4 + g) * S_ * 64;
    qs[wid][lane] = bf2f(QC[((size_t)bh * S_ + t) * 64 + lane]);
    __syncthreads();
    float sv[5]; float mx = -1e30f;
#pragma unroll
    for (int i = 0; i < 5; ++i) { const int kk = lane + 64 * i; sv[i] = -1e30f;
        if (kk < 257) { const int tk = t - 128 + kk;
            if (tk >= 0 && tk < S_) { const bf16* kr = Kh + (size_t)tk * 64; float s = 0.f;
                for (int d = 0; d < 64; ++d) s += qs[wid][d] * bf2f(kr[d]);
                sv[i] = s - slope * fabsf((float)(tk - t)); } }
        mx = fmaxf(mx, sv[i]); }
    mx = wave_max(mx);
    float lsum = 0.f;
#pragma unroll
    for (int i = 0; i < 5; ++i) { const int kk = lane + 64 * i; if (kk < 257) { const float pv = (sv[i] > -1e29f) ? exp2f(sv[i] - mx) : 0.f; ps[wid][kk] = pv; lsum += pv; } }
    lsum = wave_sum(lsum);
    __syncthreads();
    float a = 0.f;
    for (int kk = 0; kk < 257; ++kk) { const int tk = t - 128 + kk; if (tk >= 0 && tk < S_) a += ps[wid][kk] * bf2f(Vh[(size_t)tk * 64 + lane]); }
    const float sk = sink_l[h] * LOG2E, Mx = fmaxf(mx, sk), e = exp2f(mx - Mx);
    const float y = a * e / (lsum * e + exp2f(sk - Mx));
    const size_t row = (size_t)b * S_ + t, col = h * 64 + lane;
    ymix[row * 1024 + col] = f2bf(y * bf2f(SG[row * 1024 + col]));
}

__global__ void k_final(float* x, const float* g) {
    const int row = blockIdx.x * 4 + (threadIdx.x >> 6), lane = threadIdx.x & 63;
    float* xr = x + (size_t)row * D_;
    float ss = 0.f;
    for (int k = lane; k < D_; k += 64) ss += xr[k] * xr[k];
    ss = wave_sum(ss);
    const float rstd = rsqrtf(ss / D_ + EPS);
    for (int k = lane; k < D_; k += 64) xr[k] = xr[k] * rstd * g[k];
}
}

extern "C" void kernel_launch(void* const* d_in, const int* in_sizes, int n_in, void* d_out, int out_size, void* d_ws, size_t ws_size, hipStream_t stream) {
    using namespace nv;
    const float* x = (const float*)d_in[0]; const float* c = (const float*)d_in[1]; const float* ada_w = (const float*)d_in[2]; const float* ada_b = (const float*)d_in[3];
    const float* norm_g = (const float*)d_in[4]; const float* ab_w_in = (const float*)d_in[5]; const float* ab_w_out = (const float*)d_in[6];
    const float* lq1 = (const float*)d_in[7]; const float* lk1 = (const float*)d_in[8]; const float* lq2 = (const float*)d_in[9]; const float* lk2 = (const float*)d_in[10];
    const float* subln = (const float*)d_in[11]; const float* c_w_in = (const float*)d_in[12]; const float* c_w_out = (const float*)d_in[13]; const float* c_sink = (const float*)d_in[14];
    const float* final_g = (const float*)d_in[15];
    float* out = (float*)d_out; unsigned char* ws = (unsigned char*)d_ws;
    if (ws_size < WS_END) { fprintf(stderr, "ws too small\n"); return; }
    float* mod = (float*)(ws + WS_MOD); float* lam = (float*)(ws + WS_LAM);
    bf16* H = (bf16*)(ws + WS_H); bf16* YM = (bf16*)(ws + WS_YMIX); bf16* SG = (bf16*)(ws + WS_SG);
    hipLaunchKernelGGL(k_mod, dim3(4 * 8 * 3072 / 256), dim3(256), 0, stream, c, ada_w, ada_b, mod, lq1, lk1, lq2, lk2, lam);
    for (int l = 0; l < 4; ++l) {
        const int j = l / 2; const float* xin = (l == 0) ? x : out; const float* mod_l = mod + (size_t)l * 8 * 3072;
        hipLaunchKernelGGL(k_norm, dim3(M_ / 4), dim3(256), 0, stream, xin, norm_g + l * 1024, mod_l, H);
        if (l % 2 == 0) {
            hipLaunchKernelGGL(k_gemm<EpiEven>, dim3(4096 / 64, M_ / 64), dim3(256), 0, stream, H, ab_w_in + (size_t)j * 1024 * 4096, 4096, 1024, EpiEven{(bf16*)ws});
            hipLaunchKernelGGL(k_attn_dil, dim3(M_ * 8 / 4), dim3(256), 0, stream, (const bf16*)(ws + WS_QA), (const bf16*)(ws + WS_KA), (const bf16*)(ws + WS_VA), SG, YM);
            const float lam_init = 0.8f - 0.6f * expf(-0.3f * (float)l);
            hipLaunchKernelGGL(k_attn_diff, dim3(M_ * 4), dim3(256), 0, stream, (const bf16*)(ws + WS_QB), (const bf16*)(ws + WS_KB), (const bf16*)(ws + WS_VB), SG, subln + j * 128, lam + j, lam_init, YM);
            hipLaunchKernelGGL(k_gemm<EpiOut>, dim3(1024 / 64, M_ / 64), dim3(256), 0, stream, YM, ab_w_out + (size_t)j * 1024 * 1024, 1024, 1024, EpiOut{xin, out, mod_l + 2048});
        } else {
            hipLaunchKernelGGL(k_gemm<EpiOdd>, dim3(2560 / 64, M_ / 64), dim3(256), 0, stream, H, c_w_in + (size_t)j * 1024 * 2560, 2560, 1024, EpiOdd{(bf16*)ws});
            hipLaunchKernelGGL(k_attn_band, dim3(M_ * 16 / 4), dim3(256), 0, stream, (const bf16*)(ws + WS_QC), (const bf16*)(ws + WS_KC), (const bf16*)(ws + WS_VC), SG, c_sink + j * 16, YM);
            hipLaunchKernelGGL(k_gemm<EpiOut>, dim3(1024 / 64, M_ / 64), dim3(256), 0, stream, YM, c_w_out + (size_t)j * 1024 * 1024, 1024, 1024, EpiOut{xin, out, mod_l + 2048});
        }
    }
    hipLaunchKernelGGL(k_final, dim3(M_ / 4), dim3(256), 0, stream, out, final_g);
}
```

```cpp
#include <hip/hip_runtime.h>
#include <cstdio>
#include <cstdint>

namespace lay {
constexpr size_t MiB = 1u << 20;
constexpr size_t WS_CTL = 0, CTL_ZERO_BYTES = 64 * 1024;
constexpr size_t WS_MOD = 1 * MiB;
constexpr size_t WS_SHW = WS_MOD + 512 * 1024;
constexpr size_t WS_SSQ = 2 * MiB;
constexpr size_t WS_LAM = WS_SSQ + 512 * 1024;
constexpr size_t WS_WIN_E = 3 * MiB;
constexpr size_t WS_WOUT_E = 19 * MiB;
constexpr size_t WS_WIN_O = 23 * MiB;
constexpr size_t WS_WOUT_O = 33 * MiB;
constexpr size_t WS_XS = 37 * MiB;
constexpr size_t WS_YMIX = 69 * MiB;
constexpr size_t WS_SG = 101 * MiB;
constexpr size_t WS_P = 133 * MiB;
constexpr size_t WS_QA = WS_P, WS_KA = WS_P + 16 * MiB, WS_VA = WS_P + 32 * MiB, WS_QB = WS_P + 48 * MiB, WS_KB = WS_P + 64 * MiB, WS_VB = WS_P + 80 * MiB;
constexpr size_t WS_QC = WS_P, WS_KC = WS_P + 32 * MiB, WS_VC = WS_P + 40 * MiB;
constexpr size_t WS_END = WS_P + 96 * MiB;
static_assert(WS_END <= 256 * MiB, "ws map");
constexpr int CW_BAR = 1024;
constexpr size_t WS_H = WS_XS;
}

namespace nv {
typedef unsigned short bf16;
constexpr int B_ = 8, S_ = 2048, D_ = 1024, M_ = B_ * S_;
constexpr float LOG2E = 1.4426950408889634f;
constexpr float QSCALE = 0.125f * LOG2E;
constexpr float EPS = 1e-6f;

__device__ __forceinline__ float bf2f(bf16 v) { return __uint_as_float(((unsigned)v) << 16); }
__device__ __forceinline__ bf16 f2bf(float f) { unsigned u = __float_as_uint(f); u += 0x7fffu + ((u >> 16) & 1u); return (bf16)(u >> 16); }
__device__ __forceinline__ float silu(float x) { return x / (1.f + __expf(-x)); }
__device__ __forceinline__ float wave_sum(float v) { for (int o = 32; o >= 1; o >>= 1) v += __shfl_xor(v, o); return v; }
__device__ __forceinline__ float wave_max(float v) { for (int o = 32; o >= 1; o >>= 1) v = fmaxf(v, __shfl_xor(v, o)); return v; }
__device__ __forceinline__ int pi16(int t) { return (t & 15) * 128 + (t >> 4); }

using namespace lay;

__global__ void k_mod(const float* c, const float* ada_w, const float* ada_b, float* mod,
                      const float* lq1, const float* lk1, const float* lq2, const float* lk2, float* lam) {
    const int idx = blockIdx.x * blockDim.x + threadIdx.x;
    if (idx < 4 * 8 * 3072) {
        const int j = idx % 3072, b = (idx / 3072) % 8, l = idx / (3072 * 8);
        float acc = 0.f;
        for (int k = 0; k < 1024; ++k) acc += silu(c[b * 1024 + k]) * ada_w[((size_t)l * 1024 + k) * 3072 + j];
        mod[idx] = acc + ada_b[l * 3072 + j];
    }
    if (idx < 2) {
        float s1 = 0.f, s2 = 0.f;
        for (int d = 0; d < 64; ++d) { s1 += lq1[idx * 64 + d] * lk1[idx * 64 + d]; s2 += lq2[idx * 64 + d] * lk2[idx * 64 + d]; }
        const float lam_init = 0.8f - 0.6f * expf(-0.3f * (float)(2 * idx));
        lam[idx] = expf(s1) - expf(s2) + lam_init;
    }
}

__global__ void k_norm(const float* x, const float* g, const float* mod_l, bf16* h) {
    const int row = blockIdx.x * 4 + (threadIdx.x >> 6), lane = threadIdx.x & 63, b = row / S_;
    const float* xr = x + (size_t)row * D_;
    float ss = 0.f;
    for (int k = lane; k < D_; k += 64) ss += xr[k] * xr[k];
    ss = wave_sum(ss);
    const float rstd = rsqrtf(ss / D_ + EPS);
    const float* shift = mod_l + b * 3072, *scale = shift + 1024;
    for (int k = lane; k < D_; k += 64) h[(size_t)row * D_ + k] = f2bf(xr[k] * rstd * g[k] * (1.f + scale[k]) + shift[k]);
}

struct EpiEven { bf16* ws; __device__ void operator()(int row, int n, float v) const {
    const int b = row / S_, t = row % S_; unsigned char* w = (unsigned char*)ws;
    if (n < 1536) { const int which = n / 512, c = n % 512, h = c / 64, d = c % 64;
        bf16* dst = (bf16*)(w + (which == 0 ? WS_QA : which == 1 ? WS_KA : WS_VA));
        dst[((size_t)(b * 8 + h) * S_ + pi16(t)) * 64 + d] = f2bf(which == 0 ? v * QSCALE : v);
    } else if (n < 2560) { const int which = (n - 1536) / 512, c = (n - 1536) % 512, h = c / 128, w2 = (c % 128) / 64, d = c % 64;
        bf16* dst = (bf16*)(w + (which == 0 ? WS_QB : WS_KB));
        dst[((size_t)(b * 8 + h * 2 + w2) * S_ + t) * 64 + d] = f2bf(which == 0 ? v * QSCALE : v);
    } else if (n < 3072) { const int c = n - 2560, h = c / 128, dv = c % 128;
        ((bf16*)(w + WS_VB))[((size_t)(b * 4 + h) * S_ + t) * 128 + dv] = f2bf(v);
    } else { ((bf16*)(w + WS_SG))[(size_t)row * 1024 + (n - 3072)] = f2bf(silu(v)); }
} };
struct EpiOdd { bf16* ws; __device__ void operator()(int row, int n, float v) const {
    const int b = row / S_, t = row % S_; unsigned char* w = (unsigned char*)ws;
    if (n < 1024) { const int h = n / 64, d = n % 64; ((bf16*)(w + WS_QC))[((size_t)(b * 16 + h) * S_ + t) * 64 + d] = f2bf(v * QSCALE); }
    else if (n < 1280) { const int c = n - 1024, h = c / 64, d = c % 64; ((bf16*)(w + WS_KC))[((size_t)(b * 4 + h) * S_ + t) * 64 + d] = f2bf(v); }
    else if (n < 1536) { const int c = n - 1280, h = c / 64, d = c % 64; ((bf16*)(w + WS_VC))[((size_t)(b * 4 + h) * S_ + t) * 64 + d] = f2bf(v); }
    else { ((bf16*)(w + WS_SG))[(size_t)row * 1024 + (n - 1536)] = f2bf(silu(v)); }
} };
struct EpiOut { const float* xin; float* xout; const float* gate_l; __device__ void operator()(int row, int n, float v) const {
    const int b = row / S_; xout[(size_t)row * D_ + n] = xin[(size_t)row * D_ + n] + gate_l[b * 3072 + n] * v;
} };

template <class Epi>
__global__ void __launch_bounds__(256) k_gemm(const bf16* A, const float* W, int N, int K, Epi E) {
    __shared__ float As[16][65], Ws[16][65];
    const int tx = threadIdx.x & 15, ty = threadIdx.x >> 4, m0 = blockIdx.y * 64, n0 = blockIdx.x * 64;
    float acc[4][4] = {};
    for (int k0 = 0; k0 < K; k0 += 16) {
        for (int i = threadIdx.x; i < 1024; i += 256) { const int r = i >> 4, kk = i & 15; As[kk][r] = bf2f(A[(size_t)(m0 + r) * K + k0 + kk]); }
        for (int i = threadIdx.x; i < 1024; i += 256) { const int kk = i >> 6, cc = i & 63; Ws[kk][cc] = W[(size_t)(k0 + kk) * N + n0 + cc]; }
        __syncthreads();
#pragma unroll
        for (int kk = 0; kk < 16; ++kk) {
            float a[4], w[4];
#pragma unroll
            for (int i = 0; i < 4; ++i) { a[i] = As[kk][ty * 4 + i]; w[i] = Ws[kk][tx * 4 + i]; }
#pragma unroll
            for (int i = 0; i < 4; ++i)
#pragma unroll
                for (int j = 0; j < 4; ++j) acc[i][j] += a[i] * w[j];
        }
        __syncthreads();
    }
#pragma unroll
    for (int i = 0; i < 4; ++i)
#pragma unroll
        for (int j = 0; j < 4; ++j) E(m0 + ty * 4 + i, n0 + tx * 4 + j, acc[i][j]);
}

__global__ void __launch_bounds__(256) k_attn_dil(const bf16* QA, const bf16* KA, const bf16* VA, const bf16* SG, bf16* ymix) {
    __shared__ float ps[4][132]; __shared__ float qs[4][64];
    const int wid = threadIdx.x >> 6, lane = threadIdx.x & 63;
    const int gq = blockIdx.x * 4 + wid;
    const int t = gq % S_, bh = gq / S_, h = bh % 8, b = bh / 8;
    const float slope = exp2f(-(float)(h + 1)) * LOG2E;
    const bf16* Kh = KA + (size_t)bh * S_ * 64; const bf16* Vh = VA + (size_t)bh * S_ * 64;
    qs[wid][lane] = bf2f(QA[((size_t)bh * S_ + pi16(t)) * 64 + lane]);
    __syncthreads();
    float mP[3], lP[3], accP[3];
#pragma unroll
    for (int p = 0; p < 3; ++p) {
        const int dil = (p == 0) ? 1 : (p == 1) ? 4 : 16, L = S_ / dil, m = t / dil, r = t % dil;
        float sv[3]; float mx = -1e30f;
#pragma unroll
        for (int i = 0; i < 3; ++i) { const int kk = lane + 64 * i; sv[i] = -1e30f;
            if (kk < 129) { const int mk = m - 64 + kk;
                if (mk >= 0 && mk < L) { const int tk = mk * dil + r; const bf16* kr = Kh + (size_t)pi16(tk) * 64; float s = 0.f;
                    for (int d = 0; d < 64; ++d) s += qs[wid][d] * bf2f(kr[d]);
                    sv[i] = s - slope * fabsf((float)(tk - t)); } }
            mx = fmaxf(mx, sv[i]); }
        mx = wave_max(mx);
        float lsum = 0.f;
#pragma unroll
        for (int i = 0; i < 3; ++i) { const int kk = lane + 64 * i; if (kk < 129) { const float pv = (sv[i] > -1e29f) ? exp2f(sv[i] - mx) : 0.f; ps[wid][kk] = pv; lsum += pv; } }
        lsum = wave_sum(lsum);
        __syncthreads();
        float a = 0.f;
        for (int kk = 0; kk < 129; ++kk) { const int mk = m - 64 + kk; if (mk >= 0 && mk < L) { const int tk = mk * dil + r; a += ps[wid][kk] * bf2f(Vh[(size_t)pi16(tk) * 64 + lane]); } }
        __syncthreads();
        mP[p] = mx; lP[p] = lsum; accP[p] = a;
    }
    const float Mx = fmaxf(mP[0], fmaxf(mP[1], mP[2]));
    float num = 0.f, den = 0.f;
#pragma unroll
    for (int p = 0; p < 3; ++p) { const float w = exp2f(mP[p] - Mx); num += w * accP[p]; den += w * lP[p]; }
    const float y = num / den;
    const size_t row = (size_t)b * S_ + t, col = h * 64 + lane;
    ymix[row * 1024 + col] = f2bf(y * bf2f(SG[row * 1024 + col]));
}

__global__ void __launch_bounds__(256) k_attn_diff(const bf16* QB, const bf16* KB, const bf16* VB, const bf16* SG, const float* subln_g, const float* lam_p, float lam_init, bf16* ymix) {
    __shared__ float s1[2048], s2[2048], q1[64], q2[64], red[8], o2[128];
    const int tid = threadIdx.x, lane = tid & 63, wid = tid >> 6;
    const int gq = blockIdx.x, t = gq % S_, bh = gq / S_, h = bh % 4, b = bh / 4;
    const float slope = exp2f(-2.f * (float)(h + 1)) * LOG2E, lam = lam_p[0];
    const size_t hw1 = (size_t)(b * 8 + h * 2) * S_, hw2 = hw1 + S_;
    if (tid < 64) q1[tid] = bf2f(QB[(hw1 + t) * 64 + tid]); else if (tid < 128) q2[tid - 64] = bf2f(QB[(hw2 + t) * 64 + tid - 64]);
    __syncthreads();
    float m1 = -1e30f, m2 = -1e30f;
    for (int j = tid; j < S_; j += 256) { const bf16* k1 = KB + (hw1 + j) * 64; const bf16* k2 = KB + (hw2 + j) * 64; float a = 0.f, c = 0.f;
        for (int d = 0; d < 64; ++d) { a += q1[d] * bf2f(k1[d]); c += q2[d] * bf2f(k2[d]); }
        const float bias = slope * fabsf((float)(t - j)); a -= bias; c -= bias; s1[j] = a; s2[j] = c; m1 = fmaxf(m1, a); m2 = fmaxf(m2, c); }
    m1 = wave_max(m1); m2 = wave_max(m2);
    if (lane == 0) { red[wid] = m1; red[4 + wid] = m2; }
    __syncthreads();
    m1 = fmaxf(fmaxf(red[0], red[1]), fmaxf(red[2], red[3])); m2 = fmaxf(fmaxf(red[4], red[5]), fmaxf(red[6], red[7]));
    __syncthreads();
    float l1 = 0.f, l2 = 0.f;
    for (int j = tid; j < S_; j += 256) { const float a = exp2f(s1[j] - m1), c = exp2f(s2[j] - m2); s1[j] = a; s2[j] = c; l1 += a; l2 += c; }
    l1 = wave_sum(l1); l2 = wave_sum(l2);
    if (lane == 0) { red[wid] = l1; red[4 + wid] = l2; }
    __syncthreads();
    l1 = red[0] + red[1] + red[2] + red[3]; l2 = red[4] + red[5] + red[6] + red[7];
    const float i1 = 1.f / l1, i2 = lam / l2;
    const int dv = tid & 127, half = tid >> 7;
    const bf16* Vh = VB + (size_t)(b * 4 + h) * S_ * 128;
    float o = 0.f;
    for (int j = half; j < S_; j += 2) o += (s1[j] * i1 - s2[j] * i2) * bf2f(Vh[(size_t)j * 128 + dv]);
    __syncthreads();
    if (half == 1) o2[dv] = o;
    __syncthreads();
    if (half == 0) { o += o2[dv];
        float ss = wave_sum(o * o);
        if (lane == 0) red[wid] = ss; }
    __syncthreads();
    if (half == 0) { const float ss = red[0] + red[1]; const float rstd = rsqrtf(ss / 128.f + EPS);
        const float y = o * rstd * subln_g[dv] * (1.f - lam_init);
        const size_t row = (size_t)b * S_ + t, col = 512 + h * 128 + dv;
        ymix[row * 1024 + col] = f2bf(y * bf2f(SG[row * 1024 + col])); }
}

__global__ void __launch_bounds__(256) k_attn_band(const bf16* QC, const bf16* KC, const bf16* VC, const bf16* SG, const float* sink_l, bf16* ymix) {
    __shared__ float ps[4][260]; __shared__ float qs[4][64];
    const int wid = threadIdx.x >> 6, lane = threadIdx.x & 63;
    const int gq = blockIdx.x * 4 + wid; const int t = gq % S_, bh = gq / S_, h = bh % 16, b = bh / 16, g = h / 4;
    const float slope = exp2f(-0.5f * (float)(h + 1)) * LOG2E;
    const bf16* Kh = KC + (size_t)(b * 4 + g) * S_ * 64; const bf16* Vh = VC + (size_t)(b * 4 + g) * S_ * 64;
    qs[wid][lane] = bf2f(QC[((size_t)bh * S_ + t) * 64 + lane]);
    __syncthreads();
    float sv[5]; float mx = -1e30f;
#pragma unroll
    for (int i = 0; i < 5; ++i) { const int kk = lane + 64 * i; sv[i] = -1e30f;
        if (kk < 257) { const int tk = t - 128 + kk;
            if (tk >= 0 && tk < S_) { const bf16* kr = Kh + (size_t)tk * 64; float s = 0.f;
                for (int d = 0; d < 64; ++d) s += qs[wid][d] * bf2f(kr[d]);
                sv[i] = s - slope * fabsf((float)(tk - t)); } }
        mx = fmaxf(mx, sv[i]); }
    mx = wave_max(mx);
    float lsum = 0.f;
#pragma unroll
    for (int i = 0; i < 5; ++i) { const int kk = lane + 64 * i; if (kk < 257) { const float pv = (sv[i] > -1e29f) ? exp2f(sv[i] - mx) : 0.f; ps[wid][kk] = pv; lsum += pv; } }
    lsum = wave_sum(lsum);
    __syncthreads();
    float a = 0.f;
    for (int kk = 0; kk < 257; ++kk) { const int tk = t - 128 + kk; if (tk >= 0 && tk < S_) a += ps[wid][kk] * bf2f(Vh[(size_t)tk * 64 + lane]); }
    const float sk = sink_l[h] * LOG2E, Mx = fmaxf(mx, sk), e = exp2f(mx - Mx);
    const float y = a * e / (lsum * e + exp2f(sk - Mx));
    const size_t row = (size_t)b * S_ + t, col = h * 64 + lane;
    ymix[row * 1024 + col] = f2bf(y * bf2f(SG[row * 1024 + col]));
}

__global__ void k_final(float* x, const float* g) {
    const int row = blockIdx.x * 4 + (threadIdx.x >> 6), lane = threadIdx.x & 63;
    float* xr = x + (size_t)row * D_;
    float ss = 0.f;
    for (int k = lane; k < D_; k += 64) ss += xr[k] * xr[k];
    ss = wave_sum(ss);
    const float rstd = rsqrtf(ss / D_ + EPS);
    for (int k = lane; k < D_; k += 64) xr[k] = xr[k] * rstd * g[k];
}
}


namespace pg8 {
#define PG8_LAS __attribute__((address_space(3)))
typedef unsigned short bf16_t;
typedef short bf16x8 __attribute__((ext_vector_type(8)));
typedef float f32x4 __attribute__((ext_vector_type(4)));
typedef unsigned u32x4 __attribute__((ext_vector_type(4)));
constexpr int BM = 256, BK = 64, HALF = 128, HTB = HALF * BK * 2  , STAGE_BYTES = 8 * HTB, NXCD = 8, WGM = 8;

__host__ __device__ __forceinline__ int lds_byte(int r, int c) { const int st = (r >> 4) * 2 + (c >> 5), rr = r & 15, cc = c & 31, ob = rr * 64 + cc * 2; return st * 1024 + (ob ^ (((ob >> 9) & 1) << 5)); }
__host__ __device__ __forceinline__ void stage_rc(int b, int& R, int& C) { const int st = b / 1024, sb = b % 1024, swz = sb ^ (((sb >> 9) & 1) << 5); R = (st >> 1) * 16 + swz / 64; C = (st & 1) * 32 + (swz % 64) / 2; }
__host__ __device__ __forceinline__ int perm32(int rho) { const int n = rho >> 4, i = rho & 15; return 8 * (i >> 2) + 4 * n + (i & 3); }

struct Unit { int pm, pn; };
struct Gemm { const bf16_t* A; const bf16_t* Bt; int M, N, K; };

struct StaticOrder {
    int nM, nN, nwg, G, c;
    __host__ __device__ void init(int M, int N, int G_, int c_) { nM = M / BM; nN = N / BM; nwg = nM * nN; G = G_; c = c_; }
    __host__ __device__ bool next(int i, Unit& u) const {
        const long L = (long)i * G + c; if (L >= nwg) return false;
        int wgid = (int)L; { const int q = nwg / NXCD, r = nwg % NXCD, xcd = wgid % NXCD, off = wgid / NXCD; wgid = (xcd < r ? xcd * (q + 1) : r * (q + 1) + (xcd - r) * q) + off; }
        const int nig = WGM * nN, gid = wgid / nig, fm = gid * WGM, gsz = (nM - fm) < WGM ? (nM - fm) : WGM;
        u.pm = fm + ((wgid % nig) % gsz); u.pn = (wgid % nig) / gsz; return true;
    }
    __device__ __forceinline__ void a_ready(const Unit&) const {}
    __device__ __forceinline__ void done(const Unit&) const {}
};

__device__ __forceinline__ unsigned cvt_pk_bf16(float lo, float hi) { unsigned r; asm volatile("v_cvt_pk_bf16_f32 %0, %1, %2" : "=v"(r) : "v"(lo), "v"(hi)); return r; }

struct EpiProj {
    static constexpr bool PERM = true, AFTER_DRAIN = false;
    int odd; const float* ssq; const float* shw; unsigned char* ws;
    __device__ __forceinline__ void operator()(const f32x4 (&acc)[2][2][4][2], const Unit& u, int wr, int wc, int fr, int fq) const {
        using namespace nv;
        const int row0 = u.pm * BM + wr * 64 + fr, b = u.pm >> 3, pn = u.pn;
        size_t base; int cb, lg, nh, perm, kind;
        if (!odd) {
            if (pn < 6)       { base = lay::WS_QA + (size_t)(pn >> 1) * (16u << 20); cb = (pn & 1) * 256; lg = 6; nh = 8; perm = 1; kind = 0; }
            else if (pn < 10) { base = lay::WS_QB + (size_t)((pn - 6) >> 1) * (16u << 20); cb = ((pn - 6) & 1) * 256; lg = 6; nh = 8; perm = 0; kind = 0; }
            else if (pn < 12) { base = lay::WS_VB; cb = (pn - 10) * 256; lg = 7; nh = 4; perm = 0; kind = 0; }
            else              { base = lay::WS_SG; cb = (pn - 12) * 256; lg = 0; nh = 0; perm = 0; kind = 1; }
        } else {
            if (pn < 4)       { base = lay::WS_QC; cb = pn * 256; lg = 6; nh = 16; perm = 0; kind = 0; }
            else if (pn == 4) { base = lay::WS_KC; cb = 0; lg = 6; nh = 4; perm = 0; kind = 0; }
            else if (pn == 5) { base = lay::WS_VC; cb = 0; lg = 6; nh = 4; perm = 0; kind = 0; }
            else              { base = lay::WS_SG; cb = (pn - 6) * 256; lg = 0; nh = 0; perm = 0; kind = 1; }
        }
        const bool isq = (!odd && (pn < 2 || pn == 6 || pn == 7)) || (odd && pn < 4);
        const float qs = isq ? QSCALE : 1.f;
        bf16_t* dst = (bf16_t*)(ws + base);
        const int cl0 = wc * 32 + 8 * fq;
        f32x4 bv[2][2];
#pragma unroll
        for (int bj = 0; bj < 2; ++bj)
#pragma unroll
            for (int n = 0; n < 2; ++n) bv[bj][n] = *(const f32x4*)(shw + (size_t)b * 4096 + pn * BM + cl0 + bj * HALF + 4 * n);
#pragma unroll
        for (int ai = 0; ai < 2; ++ai)
#pragma unroll
            for (int m = 0; m < 4; ++m) {
                const int row = row0 + ai * HALF + m * 16, t = row & 2047;
                const float rs = rsqrtf(ssq[row] * (1.f / 1024.f) + EPS);
                const int tt = perm ? pi16(t) : t;
#pragma unroll
                for (int bj = 0; bj < 2; ++bj) {
                    f32x4 v0 = acc[ai][bj][m][0] * rs + bv[bj][0], v1 = acc[ai][bj][m][1] * rs + bv[bj][1];
                    const int cc = cb + cl0 + bj * HALF;
                    size_t off;
                    if (kind == 1) { off = (size_t)row * 1024 + cc;
#pragma unroll
                        for (int q = 0; q < 4; ++q) { v0[q] = v0[q] * __builtin_amdgcn_rcpf(1.f + __builtin_amdgcn_exp2f(-v0[q] * LOG2E)); v1[q] = v1[q] * __builtin_amdgcn_rcpf(1.f + __builtin_amdgcn_exp2f(-v1[q] * LOG2E)); } }
                    else { off = ((((size_t)(b * nh + (cc >> lg)) << 11) + tt) << lg) + (cc & ((1 << lg) - 1)); v0 = v0 * qs; v1 = v1 * qs; }
                    u32x4 w; w.x = cvt_pk_bf16(v0[0], v0[1]); w.y = cvt_pk_bf16(v0[2], v0[3]); w.z = cvt_pk_bf16(v1[0], v1[1]); w.w = cvt_pk_bf16(v1[2], v1[3]);
                    *(u32x4*)(dst + off) = w;
                }
            }
    }
};
struct EpiOutR {
    static constexpr bool PERM = true, AFTER_DRAIN = false;
    const float* xin; float* xout; const float* gate; int has_next; const float* g_next; const float* scale_next; bf16_t* xs; float* ssq_next;
    __device__ __forceinline__ void operator()(const f32x4 (&acc)[2][2][4][2], const Unit& u, int wr, int wc, int fr, int fq) const {
        const int row0 = u.pm * BM + wr * 64 + fr, b = u.pm >> 3;
        const int c0 = u.pn * BM + wc * 32 + 8 * fq;
        f32x4 gt[2][2], gs[2][2];
#pragma unroll
        for (int bj = 0; bj < 2; ++bj)
#pragma unroll
            for (int n = 0; n < 2; ++n) { const int c = c0 + bj * HALF + 4 * n; gt[bj][n] = *(const f32x4*)(gate + (size_t)b * 3072 + c);
                if (has_next) { const f32x4 g = *(const f32x4*)(g_next + c), s = *(const f32x4*)(scale_next + (size_t)b * 3072 + c); gs[bj][n] = g * (1.f + s); } else gs[bj][n] = (f32x4){0.f, 0.f, 0.f, 0.f}; }
#pragma unroll
        for (int ai = 0; ai < 2; ++ai)
#pragma unroll
            for (int m = 0; m < 4; ++m) {
                const int row = row0 + ai * HALF + m * 16; float ss = 0.f;
#pragma unroll
                for (int bj = 0; bj < 2; ++bj) {
                    const size_t off = (size_t)row * 1024 + c0 + bj * HALF;
                    const f32x4 x0 = *(const f32x4*)(xin + off), x1 = *(const f32x4*)(xin + off + 4);
                    const f32x4 n0 = x0 + gt[bj][0] * acc[ai][bj][m][0], n1 = x1 + gt[bj][1] * acc[ai][bj][m][1];
                    *(f32x4*)(xout + off) = n0; *(f32x4*)(xout + off + 4) = n1;
                    if (has_next) {
                        ss += (n0[0] * n0[0] + n0[1] * n0[1]) + (n0[2] * n0[2] + n0[3] * n0[3]) + (n1[0] * n1[0] + n1[1] * n1[1]) + (n1[2] * n1[2] + n1[3] * n1[3]);
                        const f32x4 a = n0 * gs[bj][0], c = n1 * gs[bj][1];
                        u32x4 w; w.x = cvt_pk_bf16(a[0], a[1]); w.y = cvt_pk_bf16(a[2], a[3]); w.z = cvt_pk_bf16(c[0], c[1]); w.w = cvt_pk_bf16(c[2], c[3]);
                        *(u32x4*)(xs + off) = w; }
                }
                if (has_next) { ss += __shfl_xor(ss, 16); ss += __shfl_xor(ss, 32); if (fq == 0) atomicAdd(ssq_next + row, ss); }
            }
    }
};

template <class Epi, class Sched, bool ALIGN_EPI = false, bool SP2 = false>
__device__ __forceinline__ void gemm_phase(PG8_LAS unsigned char* lds, const Gemm g, const Sched& S, const Epi& E) {
    const int tid = threadIdx.x, wid = __builtin_amdgcn_readfirstlane(tid >> 6), lane = tid & 63, wr = wid >> 2, wc = wid & 3, fr = lane & 15, fq = lane >> 4;
    const int K = g.K, nt = K / BK;
    unsigned voffA[2], voffB[2];
#pragma unroll
    for (int i = 0; i < 2; ++i) { int R, C; stage_rc(tid * 16 + i * 8192, R, C); const int Rb = Epi::PERM ? ((R & ~31) + perm32(R & 31)) : R;
        voffA[i] = (unsigned)(R * K + C) * 2u; voffB[i] = (unsigned)(Rb * K + C) * 2u; }
    const size_t kstep = (size_t)(BK * 2);
    const size_t hstep = (size_t)HALF * K * 2;
    const size_t tstep = 2 * hstep;
    const unsigned ldsw = (unsigned)wid * 1024u;
    const int aoff = lds_byte(wr * 64 + fr, fq * 8), boff = lds_byte(wc * 32 + fr, fq * 8);
#define PG8_SA(b, h) (((b) * 2 + (h)) * HTB)
#define PG8_SB(b, h) ((4 + (b) * 2 + (h)) * HTB)
#define PG8_STAGE(bufoff, gbase, voff) do { _Pragma("unroll") for (int _i = 0; _i < 2; ++_i) \
        __builtin_amdgcn_global_load_lds((const unsigned*)((const char*)(gbase) + (voff)[_i]), (PG8_LAS unsigned*)(lds + (bufoff) + ldsw + _i * 8192), 16, 0, 0); } while (0)
#define PG8_LDA(dst, b, h) do { _Pragma("unroll") for (int m = 0; m < 4; ++m) _Pragma("unroll") for (int k = 0; k < 2; ++k) dst[m][k] = *(const PG8_LAS bf16x8*)(lds + PG8_SA(b, h) + aoff + m * 2048 + k * 1024); } while (0)
#define PG8_LDB(dst, b, h) do { _Pragma("unroll") for (int n = 0; n < 2; ++n) _Pragma("unroll") for (int k = 0; k < 2; ++k) dst[n][k] = *(const PG8_LAS bf16x8*)(lds + PG8_SB(b, h) + boff + n * 2048 + k * 1024); } while (0)
#define PG8_MMA(ai, bj, At, Bt) do { __builtin_amdgcn_s_setprio(1); _Pragma("unroll") for (int m = 0; m < 4; ++m) _Pragma("unroll") for (int n = 0; n < 2; ++n) _Pragma("unroll") for (int k = 0; k < 2; ++k) \
        acc[ai][bj][m][n] = __builtin_amdgcn_mfma_f32_16x16x32_bf16(Bt[n][k], At[m][k], acc[ai][bj][m][n], 0, 0, 0); __builtin_amdgcn_s_setprio(0); } while (0)
#define PG8_WAIT_V(n) asm volatile("s_waitcnt vmcnt(" #n ")" ::: "memory")
#define PG8_WAIT_L(n) asm volatile("s_waitcnt lgkmcnt(" #n ")" ::: "memory")
#define PG8_BAR __builtin_amdgcn_s_barrier()
#define PG8_SCHED __builtin_amdgcn_sched_barrier(0)
    Unit cur, nxt; int ui = 0;
    if (!S.next(0, cur)) return;
    f32x4 acc[2][2][4][2];
#pragma unroll
    for (int a = 0; a < 2; ++a)
#pragma unroll
        for (int b = 0; b < 2; ++b)
#pragma unroll
            for (int m = 0; m < 4; ++m)
#pragma unroll
                for (int n = 0; n < 2; ++n) acc[a][b][m][n] = (f32x4){0.f, 0.f, 0.f, 0.f};
    bf16x8 At[4][2], B0[2][2], B1[2][2];
    const char* cA = (const char*)g.A + (size_t)cur.pm * tstep; const char* cB = (const char*)g.Bt + (size_t)cur.pn * tstep;
    S.a_ready(cur);
    if constexpr (SP2) {
        PG8_STAGE(PG8_SB(0, 0), cB, voffB); PG8_STAGE(PG8_SB(0, 1), cB + hstep, voffB); PG8_STAGE(PG8_SA(0, 0), cA, voffA); PG8_STAGE(PG8_SA(0, 1), cA + hstep, voffA);
        if (wr == 1) PG8_BAR;
        PG8_WAIT_V(2); PG8_BAR;
        PG8_STAGE(PG8_SB(1, 0), cB + kstep, voffB); PG8_STAGE(PG8_SA(1, 0), cA + kstep, voffA); PG8_STAGE(PG8_SB(1, 1), cB + hstep + kstep, voffB);
        PG8_WAIT_V(6); PG8_BAR;
    } else {
        PG8_STAGE(PG8_SB(0, 0), cB, voffB); PG8_STAGE(PG8_SA(0, 0), cA, voffA); PG8_STAGE(PG8_SB(0, 1), cB + hstep, voffB); PG8_STAGE(PG8_SA(0, 1), cA + hstep, voffA);
        if (wr == 1) PG8_BAR;
        PG8_WAIT_V(4); PG8_BAR;
        PG8_STAGE(PG8_SB(1, 0), cB + kstep, voffB); PG8_STAGE(PG8_SA(1, 0), cA + kstep, voffA); PG8_STAGE(PG8_SB(1, 1), cB + hstep + kstep, voffB);
        PG8_WAIT_V(6); PG8_BAR;
    }
    for (;;) {
        const bool has_next = S.next(ui + 1, nxt);
        const char* nA = has_next ? (const char*)g.A + (size_t)nxt.pm * tstep : cA; const char* nB = has_next ? (const char*)g.Bt + (size_t)nxt.pn * tstep : cB;
        for (int t = 0; t < nt; t += 2) {
            const bool last = (t == nt - 2);
            const char* a1 = cA + (size_t)(t + 1) * kstep;
            const char* a2 = last ? nA : cA + (size_t)(t + 2) * kstep; const char* b2 = last ? nB : cB + (size_t)(t + 2) * kstep;
            const char* a3 = a2 + kstep; const char* b3 = b2 + kstep;
            if (last && has_next) S.a_ready(nxt);
            if constexpr (SP2) {
            PG8_LDB(B0, 0, 0); PG8_LDB(B1, 0, 1); PG8_SCHED; PG8_LDA(At, 0, 0); PG8_STAGE(PG8_SA(1, 1), a1 + hstep, voffA);
            PG8_WAIT_V(8); PG8_WAIT_L(0); PG8_BAR; PG8_MMA(0, 0, At, B0); PG8_MMA(0, 1, At, B1); PG8_BAR; PG8_SCHED;
            PG8_LDA(At, 0, 1); PG8_STAGE(PG8_SB(0, 0), b2, voffB); PG8_STAGE(PG8_SB(0, 1), b2 + hstep, voffB); PG8_STAGE(PG8_SA(0, 0), a2, voffA);
            PG8_WAIT_V(8); PG8_WAIT_L(0); PG8_BAR; PG8_MMA(1, 0, At, B0); PG8_MMA(1, 1, At, B1); PG8_BAR; PG8_SCHED;
            PG8_LDB(B0, 1, 0); PG8_LDB(B1, 1, 1); PG8_SCHED; PG8_LDA(At, 1, 0); PG8_STAGE(PG8_SA(0, 1), a2 + hstep, voffA);
            PG8_WAIT_V(8); PG8_WAIT_L(0); PG8_BAR; PG8_MMA(0, 0, At, B0); PG8_MMA(0, 1, At, B1); PG8_BAR; PG8_SCHED;
            PG8_LDA(At, 1, 1); PG8_STAGE(PG8_SB(1, 0), b3, voffB); PG8_STAGE(PG8_SB(1, 1), b3 + hstep, voffB); PG8_STAGE(PG8_SA(1, 0), a3, voffA);
            PG8_WAIT_V(8); PG8_WAIT_L(0); PG8_BAR; PG8_MMA(1, 0, At, B0); PG8_MMA(1, 1, At, B1); PG8_BAR; PG8_SCHED;
            } else {
            PG8_LDB(B0, 0, 0); PG8_SCHED; PG8_LDA(At, 0, 0); PG8_STAGE(PG8_SA(1, 1), a1 + hstep, voffA);
            PG8_WAIT_L(8); PG8_BAR; PG8_WAIT_L(0); PG8_MMA(0, 0, At, B0); PG8_BAR; PG8_SCHED;
            PG8_LDB(B1, 0, 1); PG8_STAGE(PG8_SB(0, 0), b2, voffB);
            PG8_BAR; PG8_WAIT_L(0); PG8_MMA(0, 1, At, B1); PG8_BAR;
            PG8_LDA(At, 0, 1); PG8_STAGE(PG8_SA(0, 0), a2, voffA);
            PG8_BAR; PG8_WAIT_L(0); PG8_MMA(1, 0, At, B0); PG8_BAR; PG8_SCHED;
            PG8_STAGE(PG8_SB(0, 1), b2 + hstep, voffB);
            PG8_WAIT_V(6); PG8_BAR; PG8_MMA(1, 1, At, B1); PG8_BAR;
            PG8_LDB(B0, 1, 0); PG8_SCHED; PG8_LDA(At, 1, 0); PG8_STAGE(PG8_SA(0, 1), a2 + hstep, voffA);
            PG8_WAIT_L(8); PG8_BAR; PG8_WAIT_L(0); PG8_MMA(0, 0, At, B0); PG8_BAR; PG8_SCHED;
            PG8_LDB(B1, 1, 1); PG8_STAGE(PG8_SB(1, 0), b3, voffB);
            PG8_BAR; PG8_WAIT_L(0); PG8_MMA(0, 1, At, B1); PG8_BAR;
            PG8_LDA(At, 1, 1); PG8_STAGE(PG8_SA(1, 0), a3, voffA);
            PG8_BAR; PG8_WAIT_L(0); PG8_MMA(1, 0, At, B0); PG8_BAR; PG8_SCHED;
            PG8_STAGE(PG8_SB(1, 1), b3 + hstep, voffB);
            PG8_WAIT_V(6); PG8_BAR; PG8_MMA(1, 1, At, B1); PG8_BAR;
            }
        }
        if constexpr (ALIGN_EPI) { if (wr == 0) PG8_BAR; }
        if constexpr (!Epi::AFTER_DRAIN) { E(acc, cur, wr, wc, fr, fq); S.done(cur); }
        if (!has_next) break;
#pragma unroll
        for (int a = 0; a < 2; ++a)
#pragma unroll
            for (int b = 0; b < 2; ++b)
#pragma unroll
                for (int m = 0; m < 4; ++m)
#pragma unroll
                    for (int n = 0; n < 2; ++n) acc[a][b][m][n] = (f32x4){0.f, 0.f, 0.f, 0.f};
        cur = nxt; cA = nA; cB = nB; ++ui;
        if constexpr (ALIGN_EPI) { if (wr == 1) PG8_BAR; }
    }
    PG8_WAIT_V(0);
    if constexpr (!ALIGN_EPI) { if (wr == 0) PG8_BAR; }
    PG8_BAR;
    if constexpr (Epi::AFTER_DRAIN) { E.fused(acc, cur, wr, wc, fr, fq, lds, wid, lane); S.done(cur); }
#undef PG8_SA
#undef PG8_SB
#undef PG8_STAGE
#undef PG8_LDA
#undef PG8_LDB
#undef PG8_MMA
#undef PG8_WAIT_V
#undef PG8_WAIT_L
#undef PG8_BAR
#undef PG8_SCHED
}
}

namespace mk {
using nv::bf16; using nv::S_; using nv::D_; using nv::M_; using nv::LOG2E; using nv::QSCALE; using nv::EPS;
#define GAS __attribute__((address_space(1)))
#define LAS __attribute__((address_space(3)))
typedef unsigned v4u __attribute__((ext_vector_type(4)));
typedef unsigned v2u __attribute__((ext_vector_type(2)));
typedef float f32x4 __attribute__((ext_vector_type(4)));
constexpr int NWAVES = 8;
using namespace lay;
constexpr int RING_BYTES = 131072, LDSCTL_OFF = RING_BYTES, MISC_OFF = LDSCTL_OFF + 320, LDS_BYTES = 147456;

#define RLX_AGENT __ATOMIC_RELAXED, __HIP_MEMORY_SCOPE_AGENT
#define LDS_WAIT() asm volatile("s_waitcnt lgkmcnt(0)" ::: "memory")
#define VM_WAIT() asm volatile("s_waitcnt vmcnt(0)" ::: "memory")
__device__ __forceinline__ unsigned f2bfu(float f) { unsigned u = __builtin_bit_cast(unsigned, f); return (u + 0x7fffu + ((u >> 16) & 1u)) >> 16; }
__device__ __forceinline__ unsigned pk2(float lo, float hi) { return f2bfu(lo) | (f2bfu(hi) << 16); }
__device__ __forceinline__ float wsum(float v) {
#pragma unroll
    for (int o = 1; o < 64; o <<= 1) v += __shfl_xor(v, o);
    return v; }
__device__ __forceinline__ float silu_f(float x) { return x * __builtin_amdgcn_rcpf(1.f + __builtin_amdgcn_exp2f(-x * LOG2E)); }

#define XB_TMO      128
#define XB_XCNT(j)  (256  + 64 * (j))
#define XB_XSUB(j)  (1280 + 64 * (j))
#define XB_XGEN(j)  (2304 + 64 * (j))
#define XB_TOP      3328
#define XB_TOPGEN   3392
#define XCD_BAR_WORDS 3456
#define XB_SPIN_CAP (1u << 18)

__device__ __forceinline__ unsigned xb_ld(unsigned* p)              { return __hip_atomic_load(p, __ATOMIC_RELAXED, __HIP_MEMORY_SCOPE_AGENT); }
__device__ __forceinline__ unsigned xb_add(unsigned* p, unsigned v) { return __hip_atomic_fetch_add(p, v, __ATOMIC_RELAXED, __HIP_MEMORY_SCOPE_AGENT); }
__device__ __forceinline__ unsigned xb_xcc_id() { return (unsigned)__builtin_amdgcn_s_getreg((3 << 11) | 20) & 0xFu; }
#define XB_SPIN(cond, bar) do { unsigned _sp = 0; while (cond) { __builtin_amdgcn_s_sleep(1); \
    if ((++_sp & 255u) == 0u) { if (xb_ld(&(bar)[XB_TMO])) break; if (_sp > XB_SPIN_CAP) { atomicAdd(&(bar)[XB_TMO], 1u); break; } } } } while (0)

struct XcdBarrier {
    unsigned* bar; unsigned x;
    volatile LAS unsigned* st;
};

__device__ __forceinline__ XcdBarrier xcd_barrier_post(unsigned* bar, volatile LAS unsigned* st) {
    XcdBarrier b; b.bar = bar; b.x = xb_xcc_id(); b.st = st;
    if (threadIdx.x == 0) (void)xb_add(&bar[XB_XCNT(b.x)], 1u);
    return b;
}
__device__ __forceinline__ void xcd_barrier_complete(unsigned* bar, unsigned x, unsigned& nloc, unsigned& nx) {
    const unsigned G = gridDim.x * gridDim.y * gridDim.z;
    unsigned sum, cnt, mine, sp = 0u;
    for (;;) {
        sum = 0u; cnt = 0u; mine = 0u;
#pragma unroll
        for (unsigned j = 0; j < 16; ++j) { const unsigned c = xb_ld(&bar[XB_XCNT(j)]); sum += c; cnt += (c > 0u) ? 1u : 0u; mine = (j == x) ? c : mine; }
        if (sum == G) break;
        __builtin_amdgcn_s_sleep(1);
        if ((++sp & 255u) == 0u) { if (xb_ld(&bar[XB_TMO])) break; if (sp > XB_SPIN_CAP) { atomicAdd(&bar[XB_TMO], 1u); break; } }
    }
    nloc = mine > 0u ? mine : 1u; nx = cnt > 0u ? cnt : 1u;
}

__device__ __forceinline__ void xcd_barrier(const XcdBarrier& b) {
    asm volatile("s_waitcnt vmcnt(0)" ::: "memory");
    __syncthreads();
    if (threadIdx.x == 0) {
        unsigned* bar = b.bar;
        __builtin_amdgcn_s_waitcnt(0);
        unsigned nloc = b.st[0], nx = b.st[1];
        if (nloc == 0u) { xcd_barrier_complete(bar, b.x, nloc, nx); b.st[0] = nloc; b.st[1] = nx; }
        const unsigned old = xb_add(&bar[XB_XSUB(b.x)], 1u);
        const unsigned gen = old / nloc;
        if (old + 1u == (gen + 1u) * nloc) {
            __builtin_amdgcn_fence(__ATOMIC_RELEASE, "agent");
            asm volatile("s_waitcnt vmcnt(0)" ::: "memory");
            const unsigned og = xb_add(&bar[XB_TOP], 1u);
            const unsigned tg = og / nx;
            if (og + 1u == (tg + 1u) * nx) xb_add(&bar[XB_TOPGEN], 1u);
            else XB_SPIN(xb_ld(&bar[XB_TOPGEN]) == tg, bar);
            __builtin_amdgcn_fence(__ATOMIC_ACQUIRE, "agent");
            xb_add(&bar[XB_XGEN(b.x)], 1u);
            asm volatile("s_waitcnt vmcnt(0)" ::: "memory");
        } else {
            XB_SPIN(xb_ld(&bar[XB_XGEN(b.x)]) == gen, bar);
            __builtin_amdgcn_fence(__ATOMIC_ACQUIRE, "agent");
            asm volatile("s_waitcnt vmcnt(0)" ::: "memory");
        }
    }
    __syncthreads();
}


__device__ __forceinline__ void p0_transpose_item(const float* W, int K, int N, bf16* WT, LAS float* scr, int item, int lane) {
    const int nblk = N / 32, kb = item / nblk, nb = item % nblk, k0 = 64 * kb, n0 = 32 * nb;
#pragma unroll 8
    for (int i = 0; i < 32; ++i) { const int kk = 2 * i + (lane >> 5); scr[kk * 33 + (lane & 31)] = W[(size_t)(k0 + kk) * N + n0 + (lane & 31)]; }
    LDS_WAIT(); asm volatile("" ::: "memory");
    const int c = lane & 7;
#pragma unroll
    for (int j = 0; j < 4; ++j) { const int n = (lane >> 3) + 8 * j; const LAS float* s = scr + (8 * c) * 33 + n;
        v4u o; o.x = pk2(s[0 * 33], s[1 * 33]); o.y = pk2(s[2 * 33], s[3 * 33]); o.z = pk2(s[4 * 33], s[5 * 33]); o.w = pk2(s[6 * 33], s[7 * 33]);
        *(GAS v4u*)(WT + (size_t)(n0 + n) * K + k0 + 8 * c) = o; }
    LDS_WAIT(); asm volatile("" ::: "memory");
}
__device__ __forceinline__ void gemv8_item(const float* W, int ldw, int n0, const LAS float* vec, LAS float* red, const float* bias, float* out, int ldo, int wave, int lane) {
    float acc[8];
#pragma unroll
    for (int b = 0; b < 8; ++b) acc[b] = 0.f;
    const float* wp = W + (size_t)(wave * 128) * ldw + n0 + lane;
#pragma unroll 8
    for (int kk = 0; kk < 128; ++kk) { const float w = wp[(size_t)kk * ldw]; const int k = wave * 128 + kk;
#pragma unroll
        for (int b = 0; b < 8; ++b) acc[b] += vec[b * 1024 + k] * w; }
#pragma unroll
    for (int b = 0; b < 8; ++b) red[(wave * 8 + b) * 64 + lane] = acc[b];
    __syncthreads();
    { float s = 0.f;
#pragma unroll
      for (int w = 0; w < 8; ++w) s += red[(w * 8 + wave) * 64 + lane];
      out[(size_t)wave * ldo + n0 + lane] = s + (bias ? bias[n0 + lane] : 0.f); }
    __syncthreads();
}

typedef short bf16x8 __attribute__((ext_vector_type(8)));
typedef short s16x4 __attribute__((ext_vector_type(4)));
typedef short v4i16_t __attribute__((ext_vector_type(4)));
typedef float f32x16 __attribute__((ext_vector_type(16)));
constexpr float NEGBIG = -1e30f;
__device__ __forceinline__ int crow(int r, int hi) { return (r & 3) + 8 * (r >> 2) + 4 * hi; }
__device__ __forceinline__ unsigned cvtpk(float lo, float hi) { unsigned r; asm volatile("v_cvt_pk_bf16_f32 %0, %1, %2" : "=v"(r) : "v"(lo), "v"(hi)); return r; }
__device__ __forceinline__ float swapmax(float v) { auto rr = __builtin_amdgcn_permlane32_swap(__float_as_uint(v), __float_as_uint(v), false, false); return fmaxf(__uint_as_float(rr[0]), __uint_as_float(rr[1])); }
__device__ __forceinline__ float swapsum(float v) { auto rr = __builtin_amdgcn_permlane32_swap(__float_as_uint(v), __float_as_uint(v), false, false); return __uint_as_float(rr[0]) + __uint_as_float(rr[1]); }
__device__ __forceinline__ s16x4 vtr(const LAS char* p) { return __builtin_bit_cast(s16x4, __builtin_amdgcn_ds_read_tr16_b64_v4i16((LAS v4i16_t*)p)); }

template <int DV> struct WState { bf16x8 qr[4]; f32x16 o[DV / 32]; float m, l; };
template <int DV> __device__ __forceinline__ void wstate_init(WState<DV>& w, const bf16* qrow  ) {
#pragma unroll
    for (int d0 = 0; d0 < 4; ++d0) w.qr[d0] = *(const bf16x8*)(qrow + d0 * 16);
#pragma unroll
    for (int d = 0; d < DV / 32; ++d)
#pragma unroll
        for (int r = 0; r < 16; ++r) w.o[d][r] = 0.f;
    w.m = NEGBIG; w.l = 0.f;
}
__device__ __forceinline__ int k_lds_off(int kk, int c) { return kk * 128 + ((c ^ ((kk >> 1) & 7)) << 4); }
__device__ __forceinline__ int v_lds_off(int kk, int c8) { return (c8 >> 2) * 2048 + kk * 64 + (c8 & 3) * 16; }
__device__ __forceinline__ int v_rd_base(int lane) { return ((lane >> 4) & 1) * 32 + (lane & 3) * 8 + (8 * (lane >> 5) + ((lane & 15) >> 2)) * 64; }

template <int DV, class MaskF>
__device__ __forceinline__ void step32(WState<DV>& w, const LAS char* kb, const LAS char* vb, const f32x16& cinit, float shift, MaskF mf, int lane) {
    const int r32 = lane & 31, hi = lane >> 5;
    f32x16 p = cinit;
    { const LAS char* krow = kb + r32 * 128; const int ksw = (r32 >> 1) & 7;
#pragma unroll
      for (int d0 = 0; d0 < 4; ++d0) { const bf16x8 kf = *(const LAS bf16x8*)(krow + (((2 * d0 + hi) ^ ksw) << 4)); p = __builtin_amdgcn_mfma_f32_32x32x16_bf16(kf, w.qr[d0], p, 0, 0, 0); } }
    mf(p);
    float pmax = fmaxf(p[0], p[1]);
#pragma unroll
    for (int r = 2; r < 16; ++r) pmax = fmaxf(pmax, p[r]);
    pmax = swapmax(pmax);
    const float mnew = fmaxf(w.m, pmax + shift), alpha = __builtin_amdgcn_exp2f(w.m - mnew), ms = mnew - shift;
    float ps = 0.f;
#pragma unroll
    for (int r = 0; r < 16; ++r) { p[r] = __builtin_amdgcn_exp2f(p[r] - ms); ps += p[r]; }
    ps = swapsum(ps);
    w.l = w.l * alpha + ps; w.m = mnew;
    if (__any(alpha != 1.f)) {
#pragma unroll
        for (int d = 0; d < DV / 32; ++d)
#pragma unroll
            for (int r = 0; r < 16; ++r) w.o[d][r] *= alpha; }
    bf16x8 pa0, pa1;
#define PK4(P, BASE, OUT) do { unsigned a0 = cvtpk(P[BASE + 0], P[BASE + 1]), a1 = cvtpk(P[BASE + 2], P[BASE + 3]);   \
    unsigned b0 = cvtpk(P[BASE + 4], P[BASE + 5]), b1 = cvtpk(P[BASE + 6], P[BASE + 7]);                              \
    auto r0 = __builtin_amdgcn_permlane32_swap(a0, b0, false, false); auto r1 = __builtin_amdgcn_permlane32_swap(a1, b1, false, false); \
    v4u wv = {r0[0], r1[0], r0[1], r1[1]}; OUT = __builtin_bit_cast(bf16x8, wv); } while (0)
    PK4(p, 0, pa0); PK4(p, 8, pa1);
#undef PK4
    const LAS char* vbase = vb + v_rd_base(lane);
#pragma unroll
    for (int d = 0; d < DV / 32; ++d) {
        const s16x4 l0 = vtr(vbase + d * 2048), h0 = vtr(vbase + d * 2048 + 256), l1 = vtr(vbase + d * 2048 + 1024), h1 = vtr(vbase + d * 2048 + 1024 + 256);
        const bf16x8 v0 = (bf16x8){l0[0], l0[1], l0[2], l0[3], h0[0], h0[1], h0[2], h0[3]}, v1 = (bf16x8){l1[0], l1[1], l1[2], l1[3], h1[0], h1[1], h1[2], h1[3]};
        w.o[d] = __builtin_amdgcn_mfma_f32_32x32x16_bf16(v0, pa0, w.o[d], 0, 0, 0);
        w.o[d] = __builtin_amdgcn_mfma_f32_32x32x16_bf16(v1, pa1, w.o[d], 0, 0, 0);
    }
}
struct NoMask { __device__ __forceinline__ void operator()(f32x16&) const {} };

__device__ __forceinline__ void diff_unit(LAS unsigned char* lds, int b, int h, int qt, const bf16* QB, const bf16* KB, const bf16* VB, const bf16* SG,
                                          const float* subln_g, float lam, float lam_init, bf16* YM) {
    int tid = threadIdx.x; asm volatile("" : "+v"(tid));
    const int lane = tid & 63, wave = __builtin_amdgcn_readfirstlane(tid >> 6), r32 = lane & 31, hi = lane >> 5;
    const int which = wave >> 2, sub = wave & 3, q0 = qt * 128 + sub * 32;
    const float slope = __builtin_amdgcn_exp2f(-2.f * (float)(h + 1)) * LOG2E;
    WState<128> w;
    wstate_init<128>(w, QB + ((size_t)(b * 8 + h * 2 + which) * S_ + q0 + r32) * 64 + hi * 8);
    f32x16 Rpos;
#pragma unroll
    for (int r = 0; r < 16; ++r) Rpos[r] = slope * (float)(crow(r, hi) - r32);
    const bf16* K1 = KB + (size_t)(b * 8 + h * 2) * S_ * 64; const bf16* K2 = K1 + (size_t)S_ * 64; const bf16* Vh = VB + (size_t)(b * 4 + h) * S_ * 128;
    const int skey = tid >> 3, sc = tid & 7, sblk = skey >> 5, skk = skey & 31;
    const int kdst = sblk * 4096 + k_lds_off(skk, sc), vdst0 = 16384 + sblk * 8192 + v_lds_off(skk, sc), vdst1 = 16384 + sblk * 8192 + v_lds_off(skk, sc + 8);
    v4u s_k1, s_k2, s_v0, s_v1;
#define DLOAD(t) do { const size_t kr = (size_t)((t) * 64 + skey); s_k1 = *(const v4u*)(K1 + kr * 64 + sc * 8); s_k2 = *(const v4u*)(K2 + kr * 64 + sc * 8); \
        s_v0 = *(const v4u*)(Vh + kr * 128 + sc * 8); s_v1 = *(const v4u*)(Vh + kr * 128 + 64 + sc * 8); } while (0)
#define DWRITE(buf) do { LAS unsigned char* bb = lds + (buf) * 32768; *(LAS v4u*)(bb + kdst) = s_k1; *(LAS v4u*)(bb + 8192 + kdst) = s_k2; *(LAS v4u*)(bb + vdst0) = s_v0; *(LAS v4u*)(bb + vdst1) = s_v1; } while (0)
    DLOAD(0); DWRITE(0); __syncthreads();
#pragma unroll 1
    for (int t = 0; t < S_ / 64; ++t) {
        if (t + 1 < S_ / 64) DLOAD(t + 1);
        const LAS char* bb = (const LAS char*)(lds + (t & 1) * 32768);
#pragma unroll
        for (int kb2 = 0; kb2 < 2; ++kb2) {
            const int dk = t * 64 + kb2 * 32 - q0;
            f32x16 ci; const float sgn = dk > 0 ? -1.f : 1.f, shift = -slope * fabsf((float)dk);
            if (dk != 0) {
#pragma unroll
                for (int r = 0; r < 16; ++r) ci[r] = Rpos[r] * sgn;
            } else {
#pragma unroll
                for (int r = 0; r < 16; ++r) ci[r] = -fabsf(Rpos[r]); }
            step32<128>(w, bb + which * 8192 + kb2 * 4096, bb + 16384 + kb2 * 8192, ci, shift, NoMask(), lane);
        }
        if (t + 1 < S_ / 64) DWRITE((t + 1) & 1);
        __syncthreads();
    }
#undef DLOAD
#undef DWRITE
    LAS float* X = (LAS float*)lds + sub * 4096;
    if (which == 1) { const float sc2 = lam / w.l;
#pragma unroll
        for (int d = 0; d < 4; ++d)
#pragma unroll
            for (int r = 0; r < 16; ++r) X[(d * 16 + r) * 64 + lane] = w.o[d][r] * sc2; }
    __syncthreads();
    if (which == 0) { const float il = 1.f / w.l; float ss = 0.f;
#pragma unroll
        for (int d = 0; d < 4; ++d)
#pragma unroll
            for (int r = 0; r < 16; ++r) { const float v = w.o[d][r] * il - X[(d * 16 + r) * 64 + lane]; w.o[d][r] = v; ss += v * v; }
        ss = swapsum(ss);
        const float rs = rsqrtf(ss * (1.f / 128.f) + EPS) * (1.f - lam_init);
        const size_t rowoff = ((size_t)b * S_ + q0 + r32) * 1024 + 512 + h * 128;
#pragma unroll
        for (int d = 0; d < 4; ++d)
#pragma unroll
            for (int rr = 0; rr < 4; ++rr) { const int dv = 32 * d + 8 * rr + 4 * hi;
                const f32x4 g = *(const f32x4*)(subln_g + dv); const v2u sgv = *(const v2u*)(SG + rowoff + dv);
                const float s0 = __uint_as_float(sgv.x << 16), s1 = __uint_as_float(sgv.x & 0xffff0000u), s2 = __uint_as_float(sgv.y << 16), s3 = __uint_as_float(sgv.y & 0xffff0000u);
                v2u o2; o2.x = pk2(w.o[d][4 * rr] * rs * g.x * s0, w.o[d][4 * rr + 1] * rs * g.y * s1); o2.y = pk2(w.o[d][4 * rr + 2] * rs * g.z * s2, w.o[d][4 * rr + 3] * rs * g.w * s3);
                *(v2u*)(YM + rowoff + dv) = o2; } }
    __syncthreads();
}

struct Args { const float* in[16]; float* out; unsigned char* ws; int ph_lo, ph_hi; };
constexpr int PH_P0A = 0, PH_P0B = 1, PH_L0 = 2, PH_FINAL = 14, PH_END = 15;

__global__ void __launch_bounds__(NWAVES * 64, 2) mega(Args args) {
    extern __shared__ __attribute__((aligned(16))) unsigned char lds_raw[];
    LAS unsigned char* lds = (LAS unsigned char*)lds_raw;
    volatile LAS unsigned* MISC = (volatile LAS unsigned*)(lds + MISC_OFF);
    const int tid = threadIdx.x, lane = tid & 63, wave = __builtin_amdgcn_readfirstlane(tid >> 6);
    const int G = gridDim.x; const int bx = blockIdx.x; const int vcu = (G % 8 == 0) ? (bx % 8) * (G / 8) + bx / 8 : bx;
    unsigned char* ws = args.ws;
    unsigned* ctl = (unsigned*)(ws + WS_CTL);
    for (int u = tid; u < (LDS_BYTES - LDSCTL_OFF) / 4; u += NWAVES * 64) ((LAS unsigned*)(lds + LDSCTL_OFF))[u] = 0u;
    __syncthreads();
    const int lo = args.ph_lo, hi = args.ph_hi;
    const bool use_bar = (hi - lo) > 1;
    XcdBarrier bar; bar.bar = ctl + CW_BAR; bar.x = 0; bar.st = nullptr;
    if (use_bar) bar = xcd_barrier_post(ctl + CW_BAR, MISC + 8);
#define IN(k) (lo <= (k) && (k) < hi)
#define SEAM(k) do { if (IN(k) && IN((k) + 1)) xcd_barrier(bar); } while (0)
    const float* x_in = args.in[0]; const float* c_in = args.in[1]; const float* ada_w = args.in[2]; const float* ada_b = args.in[3]; const float* norm_g = args.in[4];
    const float* ab_w_in = args.in[5]; const float* ab_w_out = args.in[6]; const float* c_w_in = args.in[12]; const float* c_w_out = args.in[13]; const float* final_g = args.in[15];
    float* mod = (float*)(ws + WS_MOD); float* shw = (float*)(ws + WS_SHW); float* ssq = (float*)(ws + WS_SSQ); float* lam = (float*)(ws + WS_LAM);
    bf16* XS = (bf16*)(ws + WS_XS);
    const int gw = vcu * NWAVES + wave, NGW = G * NWAVES;

    if (IN(PH_P0A)) {
        LAS float* vec = (LAS float*)lds; LAS float* red = (LAS float*)(lds + 32768);
        for (int i = tid; i < 8 * 1024; i += NWAVES * 64) vec[i] = nv::silu(c_in[i]);
        __syncthreads();
        for (int it = bx; it < 4 * 48; it += G) { const int l = it / 48, jc = it % 48;
            gemv8_item(ada_w + (size_t)l * 1024 * 3072, 3072, jc * 64, vec, red, ada_b + l * 3072, mod + (size_t)l * 8 * 3072, 3072, wave, lane); }
        __syncthreads();
        LAS float* scr = (LAS float*)(lds + wave * 16384);
        constexpr int I_WE = 16 * 128, I_WO = 16 * 32, I_CE = 16 * 80;
        constexpr int NITEMS = 2 * I_WE + 2 * I_WO + 2 * I_CE + 2 * I_WO;
        for (int it = gw; it < NITEMS; it += NGW) { int r = it;
            if (r < 2 * I_WE) { const int j = r / I_WE; p0_transpose_item(ab_w_in + (size_t)j * 1024 * 4096, 1024, 4096, (bf16*)(ws + WS_WIN_E) + (size_t)j * 4096 * 1024, scr, r % I_WE, lane); continue; } r -= 2 * I_WE;
            if (r < 2 * I_WO) { const int j = r / I_WO; p0_transpose_item(ab_w_out + (size_t)j * 1024 * 1024, 1024, 1024, (bf16*)(ws + WS_WOUT_E) + (size_t)j * 1024 * 1024, scr, r % I_WO, lane); continue; } r -= 2 * I_WO;
            if (r < 2 * I_CE) { const int j = r / I_CE; p0_transpose_item(c_w_in + (size_t)j * 1024 * 2560, 1024, 2560, (bf16*)(ws + WS_WIN_O) + (size_t)j * 2560 * 1024, scr, r % I_CE, lane); continue; } r -= 2 * I_CE;
            { const int j = r / I_WO; p0_transpose_item(c_w_out + (size_t)j * 1024 * 1024, 1024, 1024, (bf16*)(ws + WS_WOUT_O) + (size_t)j * 1024 * 1024, scr, r % I_WO, lane); } }
        for (int i = bx * 512 + tid; i < 3 * M_; i += G * 512) ssq[M_ + i] = 0.f;
        if (bx == 0 && tid < 2) { const float* lq1 = args.in[7]; const float* lk1 = args.in[8]; const float* lq2 = args.in[9]; const float* lk2 = args.in[10];
            float s1 = 0.f, s2 = 0.f;
            for (int d = 0; d < 64; ++d) { s1 += lq1[tid * 64 + d] * lk1[tid * 64 + d]; s2 += lq2[tid * 64 + d] * lk2[tid * 64 + d]; }
            lam[tid] = expf(s1) - expf(s2) + (0.8f - 0.6f * expf(-0.3f * (float)(2 * tid))); }
        __syncthreads();
    }
    SEAM(PH_P0A);
    if (IN(PH_P0B)) {
        LAS float* vec = (LAS float*)lds; LAS float* red = (LAS float*)(lds + 32768);
        int cur_l = -1;
        for (int it = bx; it < 2 * 64 + 2 * 40; it += G) {
            int l, nc; if (it < 128) { l = (it / 64) * 2; nc = it % 64; } else { l = ((it - 128) / 40) * 2 + 1; nc = (it - 128) % 40; }
            if (l != cur_l) { __syncthreads(); for (int i = tid; i < 8 * 1024; i += NWAVES * 64) vec[i] = mod[(size_t)l * 8 * 3072 + (i >> 10) * 3072 + (i & 1023)]; cur_l = l; __syncthreads(); }
            const int j = l >> 1; const float* W = (l & 1) ? c_w_in + (size_t)j * 1024 * 2560 : ab_w_in + (size_t)j * 1024 * 4096; const int ldw = (l & 1) ? 2560 : 4096;
            gemv8_item(W, ldw, nc * 64, vec, red, nullptr, shw + (size_t)l * 8 * 4096, 4096, wave, lane); }
        for (int row = gw; row < M_; row += NGW) { const int b = row >> 11;
            const GAS f32x4* xr = (const GAS f32x4*)(x_in + (size_t)row * D_) + lane; const f32x4* gr = (const f32x4*)norm_g + lane; const f32x4* sr = (const f32x4*)(mod + (size_t)b * 3072 + 1024) + lane;
            GAS v2u* o8 = (GAS v2u*)(XS + (size_t)row * D_) + lane; float ss = 0.f;
#pragma unroll
            for (int j = 0; j < 4; ++j) { const f32x4 v = xr[64 * j], g = gr[64 * j], s = sr[64 * j]; ss += (v.x * v.x + v.y * v.y) + (v.z * v.z + v.w * v.w);
                v2u o; o.x = pk2(v.x * g.x * (1.f + s.x), v.y * g.y * (1.f + s.y)); o.y = pk2(v.z * g.z * (1.f + s.z), v.w * g.w * (1.f + s.w)); o8[64 * j] = o; }
            ss = wsum(ss); if (lane == 0) ssq[row] = ss; }
    }
    SEAM(PH_P0B);
#pragma unroll 1
    for (int l = 0; l < 4; ++l) {
        const int j = l >> 1, odd = l & 1; const int ph = PH_L0 + 3 * l;
        const float* mod_l = mod + (size_t)l * 8 * 3072;
        if (IN(ph)) {
            const int N = odd ? 2560 : 4096;
            const bf16* Wt = odd ? (const bf16*)(ws + WS_WIN_O) + (size_t)j * 2560 * 1024 : (const bf16*)(ws + WS_WIN_E) + (size_t)j * 4096 * 1024;
            pg8::Gemm g{XS, Wt, M_, N, 1024}; pg8::StaticOrder S; S.init(M_, N, G, bx);
            pg8::EpiProj E{odd, ssq + (size_t)l * M_, shw + (size_t)l * 8 * 4096, ws};
            pg8::gemm_phase<pg8::EpiProj, pg8::StaticOrder, true, true>(lds, g, S, E);
        }
        SEAM(ph);
        if (IN(ph + 1)) {
            if (!odd) {
                const float lam_init = 0.8f - 0.6f * __expf(-0.3f * (float)l); const float lam_v = lam[j];
                for (int u = vcu; u < 512; u += G) { const int bh = u >> 4, qt = u & 15;
                    diff_unit(lds, bh >> 2, bh & 3, qt, (const bf16*)(ws + WS_QB), (const bf16*)(ws + WS_KB), (const bf16*)(ws + WS_VB), (const bf16*)(ws + WS_SG), args.in[11] + j * 128, lam_v, lam_init, (bf16*)(ws + WS_YMIX)); }
            }
        }
        SEAM(ph + 1);
        if (IN(ph + 2)) {
            const bf16* Wt = odd ? (const bf16*)(ws + WS_WOUT_O) + (size_t)j * 1024 * 1024 : (const bf16*)(ws + WS_WOUT_E) + (size_t)j * 1024 * 1024;
            pg8::Gemm g{(const bf16*)(ws + WS_YMIX), Wt, M_, 1024, 1024}; pg8::StaticOrder S; S.init(M_, 1024, G, bx);
            const int has_next = (l < 3);
            pg8::EpiOutR E{l == 0 ? x_in : args.out, args.out, mod_l + 2048, has_next, norm_g + (l + 1) * 1024, mod_l + 8 * 3072 + 1024, XS, ssq + (size_t)(l + 1) * M_};
            pg8::gemm_phase<pg8::EpiOutR, pg8::StaticOrder, true, true>(lds, g, S, E);
        }
        SEAM(ph + 2);
    }
    if (IN(PH_FINAL)) {
        for (int row = gw; row < M_; row += NGW) {
            GAS f32x4* xr = (GAS f32x4*)(args.out + (size_t)row * D_) + lane; const f32x4* gr = (const f32x4*)final_g + lane;
            f32x4 v[4]; float ss = 0.f;
#pragma unroll
            for (int q = 0; q < 4; ++q) { v[q] = xr[64 * q]; ss += (v[q].x * v[q].x + v[q].y * v[q].y) + (v[q].z * v[q].z + v[q].w * v[q].w); }
            ss = wsum(ss); const float rstd = rsqrtf(ss * (1.f / D_) + EPS);
#pragma unroll
            for (int q = 0; q < 4; ++q) { const f32x4 g = gr[64 * q]; xr[64 * q] = v[q] * rstd * g; } }
    }
#undef IN
#undef SEAM
}
}

static void launch_mega(const mk::Args& base, int lo, int hi, int grid, hipStream_t stream) {
    mk::Args a = base; a.ph_lo = lo; a.ph_hi = hi;
    hipLaunchKernelGGL(mk::mega, dim3(grid), dim3(mk::NWAVES * 64), mk::LDS_BYTES, stream, a);
}
extern "C" void kernel_launch(void* const* d_in, const int* in_sizes, int n_in, void* d_out, int out_size, void* d_ws, size_t ws_size, hipStream_t stream) {
    using namespace nv;
    static int grid = 0;
    if (grid == 0) {
        if (n_in != 16 || in_sizes[0] != M_ * D_ || out_size != M_ * D_ || ws_size < lay::WS_END) { fprintf(stderr, "kernel_launch: unexpected shapes / workspace (%d inputs, ws %zu)\n", n_in, ws_size); grid = -1; return; }
        int dev = 0, cus = 0, per_cu = 0;
        if (hipGetDevice(&dev) != hipSuccess || hipDeviceGetAttribute(&cus, hipDeviceAttributeMultiprocessorCount, dev) != hipSuccess) { grid = -1; return; }
        if (hipFuncSetAttribute((const void*)mk::mega, hipFuncAttributeMaxDynamicSharedMemorySize, mk::LDS_BYTES) != hipSuccess) { fprintf(stderr, "kernel_launch: hipFuncSetAttribute failed\n"); grid = -1; return; }
        if (hipOccupancyMaxActiveBlocksPerMultiprocessor(&per_cu, (const void*)mk::mega, mk::NWAVES * 64, mk::LDS_BYTES) != hipSuccess || per_cu < 1) { fprintf(stderr, "kernel_launch: occupancy query says %d blocks/CU\n", per_cu); per_cu = 1; }
        (void)hipGetLastError();
        grid = cus;
        if (grid != 256) fprintf(stderr, "kernel_launch: note: %d CUs\n", grid);
    }
    if (grid < 0) return;
    (void)hipMemsetAsync((char*)d_ws + lay::WS_CTL, 0, lay::CTL_ZERO_BYTES, stream);
    mk::Args a{};
    for (int i = 0; i < 16; ++i) a.in[i] = (const float*)d_in[i];
    a.out = (float*)d_out; a.ws = (unsigned char*)d_ws;
    unsigned char* ws = (unsigned char*)d_ws; float* out = (float*)d_out;
    const float* subln = (const float*)d_in[11]; const float* c_sink = (const float*)d_in[14];
    bf16* YM = (bf16*)(ws + lay::WS_YMIX); bf16* SG = (bf16*)(ws + lay::WS_SG); float* lam = (float*)(ws + lay::WS_LAM);
    launch_mega(a, mk::PH_P0A, mk::PH_P0B + 1, grid, stream);
    for (int l = 0; l < 4; ++l) {
        const int j = l / 2, ph = mk::PH_L0 + 3 * l;
        launch_mega(a, ph, ph + 1, grid, stream);
        if (l % 2 == 0) {
            hipLaunchKernelGGL(k_attn_dil, dim3(M_ * 8 / 4), dim3(256), 0, stream, (const bf16*)(ws + lay::WS_QA), (const bf16*)(ws + lay::WS_KA), (const bf16*)(ws + lay::WS_VA), SG, YM);
            launch_mega(a, ph + 1, ph + 2, grid, stream);
        } else {
            hipLaunchKernelGGL(k_attn_band, dim3(M_ * 16 / 4), dim3(256), 0, stream, (const bf16*)(ws + lay::WS_QC), (const bf16*)(ws + lay::WS_KC), (const bf16*)(ws + lay::WS_VC), SG, c_sink + j * 16, YM);
        }
        launch_mega(a, ph + 2, ph + 3, grid, stream);
    }
    launch_mega(a, mk::PH_FINAL, mk::PH_END, grid, stream);
    const hipError_t le = hipPeekAtLastError();
    if (le != hipSuccess) fprintf(stderr, "kernel_launch: launch failed: %s\n", hipGetErrorName(le));
}
```

```cpp
#include <hip/hip_runtime.h>
#include <cstdio>
#include <cstdint>

namespace lay {
constexpr size_t MiB = 1u << 20;
constexpr size_t WS_CTL = 0, CTL_ZERO_BYTES = 64 * 1024;
constexpr size_t WS_MOD = 1 * MiB;
constexpr size_t WS_SHW = WS_MOD + 512 * 1024;
constexpr size_t WS_SSQ = 2 * MiB;
constexpr size_t WS_LAM = WS_SSQ + 512 * 1024;
constexpr size_t WS_WIN_E = 3 * MiB;
constexpr size_t WS_WOUT_E = 19 * MiB;
constexpr size_t WS_WIN_O = 23 * MiB;
constexpr size_t WS_WOUT_O = 33 * MiB;
constexpr size_t WS_XS = 37 * MiB;
constexpr size_t WS_YMIX = 69 * MiB;
constexpr size_t WS_SG = 101 * MiB;
constexpr size_t WS_P = 133 * MiB;
constexpr size_t WS_QA = WS_P, WS_KA = WS_P + 16 * MiB, WS_VA = WS_P + 32 * MiB, WS_QB = WS_P + 48 * MiB, WS_KB = WS_P + 64 * MiB, WS_VB = WS_P + 80 * MiB;
constexpr size_t WS_QC = WS_P, WS_KC = WS_P + 32 * MiB, WS_VC = WS_P + 40 * MiB;
constexpr size_t WS_STO = WS_XS;
constexpr size_t WS_STML = WS_P + 96 * MiB;
constexpr size_t WS_END = WS_STML + 1 * MiB;
static_assert(WS_END <= 256 * MiB, "ws map");
constexpr int CW_BAR = 1024;
constexpr size_t WS_H = WS_XS;
}

namespace nv {
typedef unsigned short bf16;
constexpr int B_ = 8, S_ = 2048, D_ = 1024, M_ = B_ * S_;
constexpr float LOG2E = 1.4426950408889634f;
constexpr float QSCALE = 0.125f * LOG2E;
constexpr float EPS = 1e-6f;

__device__ __forceinline__ float bf2f(bf16 v) { return __uint_as_float(((unsigned)v) << 16); }
__device__ __forceinline__ bf16 f2bf(float f) { unsigned u = __float_as_uint(f); u += 0x7fffu + ((u >> 16) & 1u); return (bf16)(u >> 16); }
__device__ __forceinline__ float silu(float x) { return x / (1.f + __expf(-x)); }
__device__ __forceinline__ float wave_sum(float v) { for (int o = 32; o >= 1; o >>= 1) v += __shfl_xor(v, o); return v; }
__device__ __forceinline__ float wave_max(float v) { for (int o = 32; o >= 1; o >>= 1) v = fmaxf(v, __shfl_xor(v, o)); return v; }
__device__ __forceinline__ int pi16(int t) { return (t & 15) * 128 + (t >> 4); }

using namespace lay;

__global__ void k_mod(const float* c, const float* ada_w, const float* ada_b, float* mod,
                      const float* lq1, const float* lk1, const float* lq2, const float* lk2, float* lam) {
    const int idx = blockIdx.x * blockDim.x + threadIdx.x;
    if (idx < 4 * 8 * 3072) {
        const int j = idx % 3072, b = (idx / 3072) % 8, l = idx / (3072 * 8);
        float acc = 0.f;
        for (int k = 0; k < 1024; ++k) acc += silu(c[b * 1024 + k]) * ada_w[((size_t)l * 1024 + k) * 3072 + j];
        mod[idx] = acc + ada_b[l * 3072 + j];
    }
    if (idx < 2) {
        float s1 = 0.f, s2 = 0.f;
        for (int d = 0; d < 64; ++d) { s1 += lq1[idx * 64 + d] * lk1[idx * 64 + d]; s2 += lq2[idx * 64 + d] * lk2[idx * 64 + d]; }
        const float lam_init = 0.8f - 0.6f * expf(-0.3f * (float)(2 * idx));
        lam[idx] = expf(s1) - expf(s2) + lam_init;
    }
}

__global__ void k_norm(const float* x, const float* g, const float* mod_l, bf16* h) {
    const int row = blockIdx.x * 4 + (threadIdx.x >> 6), lane = threadIdx.x & 63, b = row / S_;
    const float* xr = x + (size_t)row * D_;
    float ss = 0.f;
    for (int k = lane; k < D_; k += 64) ss += xr[k] * xr[k];
    ss = wave_sum(ss);
    const float rstd = rsqrtf(ss / D_ + EPS);
    const float* shift = mod_l + b * 3072, *scale = shift + 1024;
    for (int k = lane; k < D_; k += 64) h[(size_t)row * D_ + k] = f2bf(xr[k] * rstd * g[k] * (1.f + scale[k]) + shift[k]);
}

struct EpiEven { bf16* ws; __device__ void operator()(int row, int n, float v) const {
    const int b = row / S_, t = row % S_; unsigned char* w = (unsigned char*)ws;
    if (n < 1536) { const int which = n / 512, c = n % 512, h = c / 64, d = c % 64;
        bf16* dst = (bf16*)(w + (which == 0 ? WS_QA : which == 1 ? WS_KA : WS_VA));
        dst[((size_t)(b * 8 + h) * S_ + pi16(t)) * 64 + d] = f2bf(which == 0 ? v * QSCALE : v);
    } else if (n < 2560) { const int which = (n - 1536) / 512, c = (n - 1536) % 512, h = c / 128, w2 = (c % 128) / 64, d = c % 64;
        bf16* dst = (bf16*)(w + (which == 0 ? WS_QB : WS_KB));
        dst[((size_t)(b * 8 + h * 2 + w2) * S_ + t) * 64 + d] = f2bf(which == 0 ? v * QSCALE : v);
    } else if (n < 3072) { const int c = n - 2560, h = c / 128, dv = c % 128;
        ((bf16*)(w + WS_VB))[((size_t)(b * 4 + h) * S_ + t) * 128 + dv] = f2bf(v);
    } else { ((bf16*)(w + WS_SG))[(size_t)row * 1024 + (n - 3072)] = f2bf(silu(v)); }
} };
struct EpiOdd { bf16* ws; __device__ void operator()(int row, int n, float v) const {
    const int b = row / S_, t = row % S_; unsigned char* w = (unsigned char*)ws;
    if (n < 1024) { const int h = n / 64, d = n % 64; ((bf16*)(w + WS_QC))[((size_t)(b * 16 + h) * S_ + t) * 64 + d] = f2bf(v * QSCALE); }
    else if (n < 1280) { const int c = n - 1024, h = c / 64, d = c % 64; ((bf16*)(w + WS_KC))[((size_t)(b * 4 + h) * S_ + t) * 64 + d] = f2bf(v); }
    else if (n < 1536) { const int c = n - 1280, h = c / 64, d = c % 64; ((bf16*)(w + WS_VC))[((size_t)(b * 4 + h) * S_ + t) * 64 + d] = f2bf(v); }
    else { ((bf16*)(w + WS_SG))[(size_t)row * 1024 + (n - 1536)] = f2bf(silu(v)); }
} };
struct EpiOut { const float* xin; float* xout; const float* gate_l; __device__ void operator()(int row, int n, float v) const {
    const int b = row / S_; xout[(size_t)row * D_ + n] = xin[(size_t)row * D_ + n] + gate_l[b * 3072 + n] * v;
} };

template <class Epi>
__global__ void __launch_bounds__(256) k_gemm(const bf16* A, const float* W, int N, int K, Epi E) {
    __shared__ float As[16][65], Ws[16][65];
    const int tx = threadIdx.x & 15, ty = threadIdx.x >> 4, m0 = blockIdx.y * 64, n0 = blockIdx.x * 64;
    float acc[4][4] = {};
    for (int k0 = 0; k0 < K; k0 += 16) {
        for (int i = threadIdx.x; i < 1024; i += 256) { const int r = i >> 4, kk = i & 15; As[kk][r] = bf2f(A[(size_t)(m0 + r) * K + k0 + kk]); }
        for (int i = threadIdx.x; i < 1024; i += 256) { const int kk = i >> 6, cc = i & 63; Ws[kk][cc] = W[(size_t)(k0 + kk) * N + n0 + cc]; }
        __syncthreads();
#pragma unroll
        for (int kk = 0; kk < 16; ++kk) {
            float a[4], w[4];
#pragma unroll
            for (int i = 0; i < 4; ++i) { a[i] = As[kk][ty * 4 + i]; w[i] = Ws[kk][tx * 4 + i]; }
#pragma unroll
            for (int i = 0; i < 4; ++i)
#pragma unroll
                for (int j = 0; j < 4; ++j) acc[i][j] += a[i] * w[j];
        }
        __syncthreads();
    }
#pragma unroll
    for (int i = 0; i < 4; ++i)
#pragma unroll
        for (int j = 0; j < 4; ++j) E(m0 + ty * 4 + i, n0 + tx * 4 + j, acc[i][j]);
}

__global__ void __launch_bounds__(256) k_attn_dil(const bf16* QA, const bf16* KA, const bf16* VA, const bf16* SG, bf16* ymix) {
    __shared__ float ps[4][132]; __shared__ float qs[4][64];
    const int wid = threadIdx.x >> 6, lane = threadIdx.x & 63;
    const int gq = blockIdx.x * 4 + wid;
    const int t = gq % S_, bh = gq / S_, h = bh % 8, b = bh / 8;
    const float slope = exp2f(-(float)(h + 1)) * LOG2E;
    const bf16* Kh = KA + (size_t)bh * S_ * 64; const bf16* Vh = VA + (size_t)bh * S_ * 64;
    qs[wid][lane] = bf2f(QA[((size_t)bh * S_ + pi16(t)) * 64 + lane]);
    __syncthreads();
    float mP[3], lP[3], accP[3];
#pragma unroll
    for (int p = 0; p < 3; ++p) {
        const int dil = (p == 0) ? 1 : (p == 1) ? 4 : 16, L = S_ / dil, m = t / dil, r = t % dil;
        float sv[3]; float mx = -1e30f;
#pragma unroll
        for (int i = 0; i < 3; ++i) { const int kk = lane + 64 * i; sv[i] = -1e30f;
            if (kk < 129) { const int mk = m - 64 + kk;
                if (mk >= 0 && mk < L) { const int tk = mk * dil + r; const bf16* kr = Kh + (size_t)pi16(tk) * 64; float s = 0.f;
                    for (int d = 0; d < 64; ++d) s += qs[wid][d] * bf2f(kr[d]);
                    sv[i] = s - slope * fabsf((float)(tk - t)); } }
            mx = fmaxf(mx, sv[i]); }
        mx = wave_max(mx);
        float lsum = 0.f;
#pragma unroll
        for (int i = 0; i < 3; ++i) { const int kk = lane + 64 * i; if (kk < 129) { const float pv = (sv[i] > -1e29f) ? exp2f(sv[i] - mx) : 0.f; ps[wid][kk] = pv; lsum += pv; } }
        lsum = wave_sum(lsum);
        __syncthreads();
        float a = 0.f;
        for (int kk = 0; kk < 129; ++kk) { const int mk = m - 64 + kk; if (mk >= 0 && mk < L) { const int tk = mk * dil + r; a += ps[wid][kk] * bf2f(Vh[(size_t)pi16(tk) * 64 + lane]); } }
        __syncthreads();
        mP[p] = mx; lP[p] = lsum; accP[p] = a;
    }
    const float Mx = fmaxf(mP[0], fmaxf(mP[1], mP[2]));
    float num = 0.f, den = 0.f;
#pragma unroll
    for (int p = 0; p < 3; ++p) { const float w = exp2f(mP[p] - Mx); num += w * accP[p]; den += w * lP[p]; }
    const float y = num / den;
    const size_t row = (size_t)b * S_ + t, col = h * 64 + lane;
    ymix[row * 1024 + col] = f2bf(y * bf2f(SG[row * 1024 + col]));
}

__global__ void __launch_bounds__(256) k_attn_diff(const bf16* QB, const bf16* KB, const bf16* VB, const bf16* SG, const float* subln_g, const float* lam_p, float lam_init, bf16* ymix) {
    __shared__ float s1[2048], s2[2048], q1[64], q2[64], red[8], o2[128];
    const int tid = threadIdx.x, lane = tid & 63, wid = tid >> 6;
    const int gq = blockIdx.x, t = gq % S_, bh = gq / S_, h = bh % 4, b = bh / 4;
    const float slope = exp2f(-2.f * (float)(h + 1)) * LOG2E, lam = lam_p[0];
    const size_t hw1 = (size_t)(b * 8 + h * 2) * S_, hw2 = hw1 + S_;
    if (tid < 64) q1[tid] = bf2f(QB[(hw1 + t) * 64 + tid]); else if (tid < 128) q2[tid - 64] = bf2f(QB[(hw2 + t) * 64 + tid - 64]);
    __syncthreads();
    float m1 = -1e30f, m2 = -1e30f;
    for (int j = tid; j < S_; j += 256) { const bf16* k1 = KB + (hw1 + j) * 64; const bf16* k2 = KB + (hw2 + j) * 64; float a = 0.f, c = 0.f;
        for (int d = 0; d < 64; ++d) { a += q1[d] * bf2f(k1[d]); c += q2[d] * bf2f(k2[d]); }
        const float bias = slope * fabsf((float)(t - j)); a -= bias; c -= bias; s1[j] = a; s2[j] = c; m1 = fmaxf(m1, a); m2 = fmaxf(m2, c); }
    m1 = wave_max(m1); m2 = wave_max(m2);
    if (lane == 0) { red[wid] = m1; red[4 + wid] = m2; }
    __syncthreads();
    m1 = fmaxf(fmaxf(red[0], red[1]), fmaxf(red[2], red[3])); m2 = fmaxf(fmaxf(red[4], red[5]), fmaxf(red[6], red[7]));
    __syncthreads();
    float l1 = 0.f, l2 = 0.f;
    for (int j = tid; j < S_; j += 256) { const float a = exp2f(s1[j] - m1), c = exp2f(s2[j] - m2); s1[j] = a; s2[j] = c; l1 += a; l2 += c; }
    l1 = wave_sum(l1); l2 = wave_sum(l2);
    if (lane == 0) { red[wid] = l1; red[4 + wid] = l2; }
    __syncthreads();
    l1 = red[0] + red[1] + red[2] + red[3]; l2 = red[4] + red[5] + red[6] + red[7];
    const float i1 = 1.f / l1, i2 = lam / l2;
    const int dv = tid & 127, half = tid >> 7;
    const bf16* Vh = VB + (size_t)(b * 4 + h) * S_ * 128;
    float o = 0.f;
    for (int j = half; j < S_; j += 2) o += (s1[j] * i1 - s2[j] * i2) * bf2f(Vh[(size_t)j * 128 + dv]);
    __syncthreads();
    if (half == 1) o2[dv] = o;
    __syncthreads();
    if (half == 0) { o += o2[dv];
        float ss = wave_sum(o * o);
        if (lane == 0) red[wid] = ss; }
    __syncthreads();
    if (half == 0) { const float ss = red[0] + red[1]; const float rstd = rsqrtf(ss / 128.f + EPS);
        const float y = o * rstd * subln_g[dv] * (1.f - lam_init);
        const size_t row = (size_t)b * S_ + t, col = 512 + h * 128 + dv;
        ymix[row * 1024 + col] = f2bf(y * bf2f(SG[row * 1024 + col])); }
}

__global__ void __launch_bounds__(256) k_attn_band(const bf16* QC, const bf16* KC, const bf16* VC, const bf16* SG, const float* sink_l, bf16* ymix) {
    __shared__ float ps[4][260]; __shared__ float qs[4][64];
    const int wid = threadIdx.x >> 6, lane = threadIdx.x & 63;
    const int gq = blockIdx.x * 4 + wid; const int t = gq % S_, bh = gq / S_, h = bh % 16, b = bh / 16, g = h / 4;
    const float slope = exp2f(-0.5f * (float)(h + 1)) * LOG2E;
    const bf16* Kh = KC + (size_t)(b * 4 + g) * S_ * 64; const bf16* Vh = VC + (size_t)(b * 4 + g) * S_ * 64;
    qs[wid][lane] = bf2f(QC[((size_t)bh * S_ + t) * 64 + lane]);
    __syncthreads();
    float sv[5]; float mx = -1e30f;
#pragma unroll
    for (int i = 0; i < 5; ++i) { const int kk = lane + 64 * i; sv[i] = -1e30f;
        if (kk < 257) { const int tk = t - 128 + kk;
            if (tk >= 0 && tk < S_) { const bf16* kr = Kh + (size_t)tk * 64; float s = 0.f;
                for (int d = 0; d < 64; ++d) s += qs[wid][d] * bf2f(kr[d]);
                sv[i] = s - slope * fabsf((float)(tk - t)); } }
        mx = fmaxf(mx, sv[i]); }
    mx = wave_max(mx);
    float lsum = 0.f;
#pragma unroll
    for (int i = 0; i < 5; ++i) { const int kk = lane + 64 * i; if (kk < 257) { const float pv = (sv[i] > -1e29f) ? exp2f(sv[i] - mx) : 0.f; ps[wid][kk] = pv; lsum += pv; } }
    lsum = wave_sum(lsum);
    __syncthreads();
    float a = 0.f;
    for (int kk = 0; kk < 257; ++kk) { const int tk = t - 128 + kk; if (tk >= 0 && tk < S_) a += ps[wid][kk] * bf2f(Vh[(size_t)tk * 64 + lane]); }
    const float sk = sink_l[h] * LOG2E, Mx = fmaxf(mx, sk), e = exp2f(mx - Mx);
    const float y = a * e / (lsum * e + exp2f(sk - Mx));
    const size_t row = (size_t)b * S_ + t, col = h * 64 + lane;
    ymix[row * 1024 + col] = f2bf(y * bf2f(SG[row * 1024 + col]));
}

__global__ void k_final(float* x, const float* g) {
    const int row = blockIdx.x * 4 + (threadIdx.x >> 6), lane = threadIdx.x & 63;
    float* xr = x + (size_t)row * D_;
    float ss = 0.f;
    for (int k = lane; k < D_; k += 64) ss += xr[k] * xr[k];
    ss = wave_sum(ss);
    const float rstd = rsqrtf(ss / D_ + EPS);
    for (int k = lane; k < D_; k += 64) xr[k] = xr[k] * rstd * g[k];
}
}


namespace pg8 {
#define PG8_LAS __attribute__((address_space(3)))
typedef unsigned short bf16_t;
typedef short bf16x8 __attribute__((ext_vector_type(8)));
typedef float f32x4 __attribute__((ext_vector_type(4)));
typedef unsigned u32x4 __attribute__((ext_vector_type(4)));
constexpr int BM = 256, BK = 64, HALF = 128, HTB = HALF * BK * 2  , STAGE_BYTES = 8 * HTB, NXCD = 8, WGM = 8;

__host__ __device__ __forceinline__ int lds_byte(int r, int c) { const int st = (r >> 4) * 2 + (c >> 5), rr = r & 15, cc = c & 31, ob = rr * 64 + cc * 2; return st * 1024 + (ob ^ (((ob >> 9) & 1) << 5)); }
__host__ __device__ __forceinline__ void stage_rc(int b, int& R, int& C) { const int st = b / 1024, sb = b % 1024, swz = sb ^ (((sb >> 9) & 1) << 5); R = (st >> 1) * 16 + swz / 64; C = (st & 1) * 32 + (swz % 64) / 2; }
__host__ __device__ __forceinline__ int perm32(int rho) { const int n = rho >> 4, i = rho & 15; return 8 * (i >> 2) + 4 * n + (i & 3); }

struct Unit { int pm, pn; };
struct Gemm { const bf16_t* A; const bf16_t* Bt; int M, N, K; };

struct StaticOrder {
    int nM, nN, nwg, G, c;
    __host__ __device__ void init(int M, int N, int G_, int c_) { nM = M / BM; nN = N / BM; nwg = nM * nN; G = G_; c = c_; }
    __host__ __device__ bool next(int i, Unit& u) const {
        const long L = (long)i * G + c; if (L >= nwg) return false;
        int wgid = (int)L; { const int q = nwg / NXCD, r = nwg % NXCD, xcd = wgid % NXCD, off = wgid / NXCD; wgid = (xcd < r ? xcd * (q + 1) : r * (q + 1) + (xcd - r) * q) + off; }
        const int nig = WGM * nN, gid = wgid / nig, fm = gid * WGM, gsz = (nM - fm) < WGM ? (nM - fm) : WGM;
        u.pm = fm + ((wgid % nig) % gsz); u.pn = (wgid % nig) / gsz; return true;
    }
    __device__ __forceinline__ void a_ready(const Unit&) const {}
    __device__ __forceinline__ void done(const Unit&) const {}
};

__device__ __forceinline__ unsigned cvt_pk_bf16(float lo, float hi) { unsigned r; asm volatile("v_cvt_pk_bf16_f32 %0, %1, %2" : "=v"(r) : "v"(lo), "v"(hi)); return r; }

struct EpiProj {
    static constexpr bool PERM = true, AFTER_DRAIN = false;
    int odd; const float* ssq; const float* shw; unsigned char* ws;
    __device__ __forceinline__ void operator()(const f32x4 (&acc)[2][2][4][2], const Unit& u, int wr, int wc, int fr, int fq) const {
        using namespace nv;
        const int row0 = u.pm * BM + wr * 64 + fr, b = u.pm >> 3, pn = u.pn;
        size_t base; int cb, lg, nh, perm, kind;
        if (!odd) {
            if (pn < 6)       { base = lay::WS_QA + (size_t)(pn >> 1) * (16u << 20); cb = (pn & 1) * 256; lg = 6; nh = 8; perm = 1; kind = 0; }
            else if (pn < 10) { base = lay::WS_QB + (size_t)((pn - 6) >> 1) * (16u << 20); cb = ((pn - 6) & 1) * 256; lg = 6; nh = 8; perm = 0; kind = 0; }
            else if (pn < 12) { base = lay::WS_VB; cb = (pn - 10) * 256; lg = 7; nh = 4; perm = 0; kind = 0; }
            else              { base = lay::WS_SG; cb = (pn - 12) * 256; lg = 0; nh = 0; perm = 0; kind = 1; }
        } else {
            if (pn < 4)       { base = lay::WS_QC; cb = pn * 256; lg = 6; nh = 16; perm = 0; kind = 0; }
            else if (pn == 4) { base = lay::WS_KC; cb = 0; lg = 6; nh = 4; perm = 0; kind = 0; }
            else if (pn == 5) { base = lay::WS_VC; cb = 0; lg = 6; nh = 4; perm = 0; kind = 0; }
            else              { base = lay::WS_SG; cb = (pn - 6) * 256; lg = 0; nh = 0; perm = 0; kind = 1; }
        }
        const bool isq = (!odd && (pn < 2 || pn == 6 || pn == 7)) || (odd && pn < 4);
        const float qs = isq ? QSCALE : 1.f;
        bf16_t* dst = (bf16_t*)(ws + base);
        const int cl0 = wc * 32 + 8 * fq;
        f32x4 bv[2][2];
#pragma unroll
        for (int bj = 0; bj < 2; ++bj)
#pragma unroll
            for (int n = 0; n < 2; ++n) bv[bj][n] = *(const f32x4*)(shw + (size_t)b * 4096 + pn * BM + cl0 + bj * HALF + 4 * n);
#pragma unroll
        for (int ai = 0; ai < 2; ++ai)
#pragma unroll
            for (int m = 0; m < 4; ++m) {
                const int row = row0 + ai * HALF + m * 16, t = row & 2047;
                const float rs = rsqrtf(ssq[row] * (1.f / 1024.f) + EPS);
                const int tt = perm ? pi16(t) : t;
#pragma unroll
                for (int bj = 0; bj < 2; ++bj) {
                    f32x4 v0 = acc[ai][bj][m][0] * rs + bv[bj][0], v1 = acc[ai][bj][m][1] * rs + bv[bj][1];
                    const int cc = cb + cl0 + bj * HALF;
                    size_t off;
                    if (kind == 1) { off = (size_t)row * 1024 + cc;
#pragma unroll
                        for (int q = 0; q < 4; ++q) { v0[q] = v0[q] * __builtin_amdgcn_rcpf(1.f + __builtin_amdgcn_exp2f(-v0[q] * LOG2E)); v1[q] = v1[q] * __builtin_amdgcn_rcpf(1.f + __builtin_amdgcn_exp2f(-v1[q] * LOG2E)); } }
                    else { off = ((((size_t)(b * nh + (cc >> lg)) << 11) + tt) << lg) + (cc & ((1 << lg) - 1)); v0 = v0 * qs; v1 = v1 * qs; }
                    u32x4 w; w.x = cvt_pk_bf16(v0[0], v0[1]); w.y = cvt_pk_bf16(v0[2], v0[3]); w.z = cvt_pk_bf16(v1[0], v1[1]); w.w = cvt_pk_bf16(v1[2], v1[3]);
                    *(u32x4*)(dst + off) = w;
                }
            }
    }
};
struct EpiOutR {
    static constexpr bool PERM = true, AFTER_DRAIN = false;
    const float* xin; float* xout; const float* gate; int has_next; const float* g_next; const float* scale_next; bf16_t* xs; float* ssq_next;
    __device__ __forceinline__ void operator()(const f32x4 (&acc)[2][2][4][2], const Unit& u, int wr, int wc, int fr, int fq) const {
        const int row0 = u.pm * BM + wr * 64 + fr, b = u.pm >> 3;
        const int c0 = u.pn * BM + wc * 32 + 8 * fq;
        f32x4 gt[2][2], gs[2][2];
#pragma unroll
        for (int bj = 0; bj < 2; ++bj)
#pragma unroll
            for (int n = 0; n < 2; ++n) { const int c = c0 + bj * HALF + 4 * n; gt[bj][n] = *(const f32x4*)(gate + (size_t)b * 3072 + c);
                if (has_next) { const f32x4 g = *(const f32x4*)(g_next + c), s = *(const f32x4*)(scale_next + (size_t)b * 3072 + c); gs[bj][n] = g * (1.f + s); } else gs[bj][n] = (f32x4){0.f, 0.f, 0.f, 0.f}; }
#pragma unroll
        for (int ai = 0; ai < 2; ++ai)
#pragma unroll
            for (int m = 0; m < 4; ++m) {
                const int row = row0 + ai * HALF + m * 16; float ss = 0.f;
#pragma unroll
                for (int bj = 0; bj < 2; ++bj) {
                    const size_t off = (size_t)row * 1024 + c0 + bj * HALF;
                    const f32x4 x0 = *(const f32x4*)(xin + off), x1 = *(const f32x4*)(xin + off + 4);
                    const f32x4 n0 = x0 + gt[bj][0] * acc[ai][bj][m][0], n1 = x1 + gt[bj][1] * acc[ai][bj][m][1];
                    *(f32x4*)(xout + off) = n0; *(f32x4*)(xout + off + 4) = n1;
                    if (has_next) {
                        ss += (n0[0] * n0[0] + n0[1] * n0[1]) + (n0[2] * n0[2] + n0[3] * n0[3]) + (n1[0] * n1[0] + n1[1] * n1[1]) + (n1[2] * n1[2] + n1[3] * n1[3]);
                        const f32x4 a = n0 * gs[bj][0], c = n1 * gs[bj][1];
                        u32x4 w; w.x = cvt_pk_bf16(a[0], a[1]); w.y = cvt_pk_bf16(a[2], a[3]); w.z = cvt_pk_bf16(c[0], c[1]); w.w = cvt_pk_bf16(c[2], c[3]);
                        *(u32x4*)(xs + off) = w; }
                }
                if (has_next) { ss += __shfl_xor(ss, 16); ss += __shfl_xor(ss, 32); if (fq == 0) atomicAdd(ssq_next + row, ss); }
            }
    }
};

template <class Epi, class Sched, bool ALIGN_EPI = false, bool SP2 = false>
__device__ __forceinline__ void gemm_phase(PG8_LAS unsigned char* lds, const Gemm g, const Sched& S, const Epi& E) {
    const int tid = threadIdx.x, wid = __builtin_amdgcn_readfirstlane(tid >> 6), lane = tid & 63, wr = wid >> 2, wc = wid & 3, fr = lane & 15, fq = lane >> 4;
    const int K = g.K, nt = K / BK;
    unsigned voffA[2], voffB[2];
#pragma unroll
    for (int i = 0; i < 2; ++i) { int R, C; stage_rc(tid * 16 + i * 8192, R, C); const int Rb = Epi::PERM ? ((R & ~31) + perm32(R & 31)) : R;
        voffA[i] = (unsigned)(R * K + C) * 2u; voffB[i] = (unsigned)(Rb * K + C) * 2u; }
    const size_t kstep = (size_t)(BK * 2);
    const size_t hstep = (size_t)HALF * K * 2;
    const size_t tstep = 2 * hstep;
    const unsigned ldsw = (unsigned)wid * 1024u;
    const int aoff = lds_byte(wr * 64 + fr, fq * 8), boff = lds_byte(wc * 32 + fr, fq * 8);
#define PG8_SA(b, h) (((b) * 2 + (h)) * HTB)
#define PG8_SB(b, h) ((4 + (b) * 2 + (h)) * HTB)
#define PG8_STAGE(bufoff, gbase, voff) do { _Pragma("unroll") for (int _i = 0; _i < 2; ++_i) \
        __builtin_amdgcn_global_load_lds((const unsigned*)((const char*)(gbase) + (voff)[_i]), (PG8_LAS unsigned*)(lds + (bufoff) + ldsw + _i * 8192), 16, 0, 0); } while (0)
#define PG8_LDA(dst, b, h) do { _Pragma("unroll") for (int m = 0; m < 4; ++m) _Pragma("unroll") for (int k = 0; k < 2; ++k) dst[m][k] = *(const PG8_LAS bf16x8*)(lds + PG8_SA(b, h) + aoff + m * 2048 + k * 1024); } while (0)
#define PG8_LDB(dst, b, h) do { _Pragma("unroll") for (int n = 0; n < 2; ++n) _Pragma("unroll") for (int k = 0; k < 2; ++k) dst[n][k] = *(const PG8_LAS bf16x8*)(lds + PG8_SB(b, h) + boff + n * 2048 + k * 1024); } while (0)
#define PG8_MMA(ai, bj, At, Bt) do { __builtin_amdgcn_s_setprio(1); _Pragma("unroll") for (int m = 0; m < 4; ++m) _Pragma("unroll") for (int n = 0; n < 2; ++n) _Pragma("unroll") for (int k = 0; k < 2; ++k) \
        acc[ai][bj][m][n] = __builtin_amdgcn_mfma_f32_16x16x32_bf16(Bt[n][k], At[m][k], acc[ai][bj][m][n], 0, 0, 0); __builtin_amdgcn_s_setprio(0); } while (0)
#define PG8_WAIT_V(n) asm volatile("s_waitcnt vmcnt(" #n ")" ::: "memory")
#define PG8_WAIT_L(n) asm volatile("s_waitcnt lgkmcnt(" #n ")" ::: "memory")
#define PG8_BAR __builtin_amdgcn_s_barrier()
#define PG8_SCHED __builtin_amdgcn_sched_barrier(0)
    Unit cur, nxt; int ui = 0;
    if (!S.next(0, cur)) return;
    f32x4 acc[2][2][4][2];
#pragma unroll
    for (int a = 0; a < 2; ++a)
#pragma unroll
        for (int b = 0; b < 2; ++b)
#pragma unroll
            for (int m = 0; m < 4; ++m)
#pragma unroll
                for (int n = 0; n < 2; ++n) acc[a][b][m][n] = (f32x4){0.f, 0.f, 0.f, 0.f};
    bf16x8 At[4][2], B0[2][2], B1[2][2];
    const char* cA = (const char*)g.A + (size_t)cur.pm * tstep; const char* cB = (const char*)g.Bt + (size_t)cur.pn * tstep;
    S.a_ready(cur);
    if constexpr (SP2) {
        PG8_STAGE(PG8_SB(0, 0), cB, voffB); PG8_STAGE(PG8_SB(0, 1), cB + hstep, voffB); PG8_STAGE(PG8_SA(0, 0), cA, voffA); PG8_STAGE(PG8_SA(0, 1), cA + hstep, voffA);
        if (wr == 1) PG8_BAR;
        PG8_WAIT_V(2); PG8_BAR;
        PG8_STAGE(PG8_SB(1, 0), cB + kstep, voffB); PG8_STAGE(PG8_SA(1, 0), cA + kstep, voffA); PG8_STAGE(PG8_SB(1, 1), cB + hstep + kstep, voffB);
        PG8_WAIT_V(6); PG8_BAR;
    } else {
        PG8_STAGE(PG8_SB(0, 0), cB, voffB); PG8_STAGE(PG8_SA(0, 0), cA, voffA); PG8_STAGE(PG8_SB(0, 1), cB + hstep, voffB); PG8_STAGE(PG8_SA(0, 1), cA + hstep, voffA);
        if (wr == 1) PG8_BAR;
        PG8_WAIT_V(4); PG8_BAR;
        PG8_STAGE(PG8_SB(1, 0), cB + kstep, voffB); PG8_STAGE(PG8_SA(1, 0), cA + kstep, voffA); PG8_STAGE(PG8_SB(1, 1), cB + hstep + kstep, voffB);
        PG8_WAIT_V(6); PG8_BAR;
    }
    for (;;) {
        const bool has_next = S.next(ui + 1, nxt);
        const char* nA = has_next ? (const char*)g.A + (size_t)nxt.pm * tstep : cA; const char* nB = has_next ? (const char*)g.Bt + (size_t)nxt.pn * tstep : cB;
        for (int t = 0; t < nt; t += 2) {
            const bool last = (t == nt - 2);
            const char* a1 = cA + (size_t)(t + 1) * kstep;
            const char* a2 = last ? nA : cA + (size_t)(t + 2) * kstep; const char* b2 = last ? nB : cB + (size_t)(t + 2) * kstep;
            const char* a3 = a2 + kstep; const char* b3 = b2 + kstep;
            if (last && has_next) S.a_ready(nxt);
            if constexpr (SP2) {
            PG8_LDB(B0, 0, 0); PG8_LDB(B1, 0, 1); PG8_SCHED; PG8_LDA(At, 0, 0); PG8_STAGE(PG8_SA(1, 1), a1 + hstep, voffA);
            PG8_WAIT_V(8); PG8_WAIT_L(0); PG8_BAR; PG8_MMA(0, 0, At, B0); PG8_MMA(0, 1, At, B1); PG8_BAR; PG8_SCHED;
            PG8_LDA(At, 0, 1); PG8_STAGE(PG8_SB(0, 0), b2, voffB); PG8_STAGE(PG8_SB(0, 1), b2 + hstep, voffB); PG8_STAGE(PG8_SA(0, 0), a2, voffA);
            PG8_WAIT_V(8); PG8_WAIT_L(0); PG8_BAR; PG8_MMA(1, 0, At, B0); PG8_MMA(1, 1, At, B1); PG8_BAR; PG8_SCHED;
            PG8_LDB(B0, 1, 0); PG8_LDB(B1, 1, 1); PG8_SCHED; PG8_LDA(At, 1, 0); PG8_STAGE(PG8_SA(0, 1), a2 + hstep, voffA);
            PG8_WAIT_V(8); PG8_WAIT_L(0); PG8_BAR; PG8_MMA(0, 0, At, B0); PG8_MMA(0, 1, At, B1); PG8_BAR; PG8_SCHED;
            PG8_LDA(At, 1, 1); PG8_STAGE(PG8_SB(1, 0), b3, voffB); PG8_STAGE(PG8_SB(1, 1), b3 + hstep, voffB); PG8_STAGE(PG8_SA(1, 0), a3, voffA);
            PG8_WAIT_V(8); PG8_WAIT_L(0); PG8_BAR; PG8_MMA(1, 0, At, B0); PG8_MMA(1, 1, At, B1); PG8_BAR; PG8_SCHED;
            } else {
            PG8_LDB(B0, 0, 0); PG8_SCHED; PG8_LDA(At, 0, 0); PG8_STAGE(PG8_SA(1, 1), a1 + hstep, voffA);
            PG8_WAIT_L(8); PG8_BAR; PG8_WAIT_L(0); PG8_MMA(0, 0, At, B0); PG8_BAR; PG8_SCHED;
            PG8_LDB(B1, 0, 1); PG8_STAGE(PG8_SB(0, 0), b2, voffB);
            PG8_BAR; PG8_WAIT_L(0); PG8_MMA(0, 1, At, B1); PG8_BAR;
            PG8_LDA(At, 0, 1); PG8_STAGE(PG8_SA(0, 0), a2, voffA);
            PG8_BAR; PG8_WAIT_L(0); PG8_MMA(1, 0, At, B0); PG8_BAR; PG8_SCHED;
            PG8_STAGE(PG8_SB(0, 1), b2 + hstep, voffB);
            PG8_WAIT_V(6); PG8_BAR; PG8_MMA(1, 1, At, B1); PG8_BAR;
            PG8_LDB(B0, 1, 0); PG8_SCHED; PG8_LDA(At, 1, 0); PG8_STAGE(PG8_SA(0, 1), a2 + hstep, voffA);
            PG8_WAIT_L(8); PG8_BAR; PG8_WAIT_L(0); PG8_MMA(0, 0, At, B0); PG8_BAR; PG8_SCHED;
            PG8_LDB(B1, 1, 1); PG8_STAGE(PG8_SB(1, 0), b3, voffB);
            PG8_BAR; PG8_WAIT_L(0); PG8_MMA(0, 1, At, B1); PG8_BAR;
            PG8_LDA(At, 1, 1); PG8_STAGE(PG8_SA(1, 0), a3, voffA);
            PG8_BAR; PG8_WAIT_L(0); PG8_MMA(1, 0, At, B0); PG8_BAR; PG8_SCHED;
            PG8_STAGE(PG8_SB(1, 1), b3 + hstep, voffB);
            PG8_WAIT_V(6); PG8_BAR; PG8_MMA(1, 1, At, B1); PG8_BAR;
            }
        }
        if constexpr (ALIGN_EPI) { if (wr == 0) PG8_BAR; }
        if constexpr (!Epi::AFTER_DRAIN) { E(acc, cur, wr, wc, fr, fq); S.done(cur); }
        if (!has_next) break;
#pragma unroll
        for (int a = 0; a < 2; ++a)
#pragma unroll
            for (int b = 0; b < 2; ++b)
#pragma unroll
                for (int m = 0; m < 4; ++m)
#pragma unroll
                    for (int n = 0; n < 2; ++n) acc[a][b][m][n] = (f32x4){0.f, 0.f, 0.f, 0.f};
        cur = nxt; cA = nA; cB = nB; ++ui;
        if constexpr (ALIGN_EPI) { if (wr == 1) PG8_BAR; }
    }
    PG8_WAIT_V(0);
    if constexpr (!ALIGN_EPI) { if (wr == 0) PG8_BAR; }
    PG8_BAR;
    if constexpr (Epi::AFTER_DRAIN) { E.fused(acc, cur, wr, wc, fr, fq, lds, wid, lane); S.done(cur); }
#undef PG8_SA
#undef PG8_SB
#undef PG8_STAGE
#undef PG8_LDA
#undef PG8_LDB
#undef PG8_MMA
#undef PG8_WAIT_V
#undef PG8_WAIT_L
#undef PG8_BAR
#undef PG8_SCHED
}
}

namespace mk {
using nv::pi16; using nv::bf16; using nv::S_; using nv::D_; using nv::M_; using nv::LOG2E; using nv::QSCALE; using nv::EPS;
#define GAS __attribute__((address_space(1)))
#define LAS __attribute__((address_space(3)))
typedef unsigned v4u __attribute__((ext_vector_type(4)));
typedef unsigned v2u __attribute__((ext_vector_type(2)));
typedef float f32x4 __attribute__((ext_vector_type(4)));
constexpr int NWAVES = 8;
using namespace lay;
constexpr int RING_BYTES = 131072, LDSCTL_OFF = RING_BYTES, MISC_OFF = LDSCTL_OFF + 320, LDS_BYTES = 147456;

#define RLX_AGENT __ATOMIC_RELAXED, __HIP_MEMORY_SCOPE_AGENT
#define LDS_WAIT() asm volatile("s_waitcnt lgkmcnt(0)" ::: "memory")
#define VM_WAIT() asm volatile("s_waitcnt vmcnt(0)" ::: "memory")
__device__ __forceinline__ unsigned f2bfu(float f) { unsigned u = __builtin_bit_cast(unsigned, f); return (u + 0x7fffu + ((u >> 16) & 1u)) >> 16; }
__device__ __forceinline__ unsigned pk2(float lo, float hi) { return f2bfu(lo) | (f2bfu(hi) << 16); }
__device__ __forceinline__ float wsum(float v) {
#pragma unroll
    for (int o = 1; o < 64; o <<= 1) v += __shfl_xor(v, o);
    return v; }
__device__ __forceinline__ float silu_f(float x) { return x * __builtin_amdgcn_rcpf(1.f + __builtin_amdgcn_exp2f(-x * LOG2E)); }

#define XB_TMO      128
#define XB_XCNT(j)  (256  + 64 * (j))
#define XB_XSUB(j)  (1280 + 64 * (j))
#define XB_XGEN(j)  (2304 + 64 * (j))
#define XB_TOP      3328
#define XB_TOPGEN   3392
#define XCD_BAR_WORDS 3456
#define XB_SPIN_CAP (1u << 18)

__device__ __forceinline__ unsigned xb_ld(unsigned* p)              { return __hip_atomic_load(p, __ATOMIC_RELAXED, __HIP_MEMORY_SCOPE_AGENT); }
__device__ __forceinline__ unsigned xb_add(unsigned* p, unsigned v) { return __hip_atomic_fetch_add(p, v, __ATOMIC_RELAXED, __HIP_MEMORY_SCOPE_AGENT); }
__device__ __forceinline__ unsigned xb_xcc_id() { return (unsigned)__builtin_amdgcn_s_getreg((3 << 11) | 20) & 0xFu; }
#define XB_SPIN(cond, bar) do { unsigned _sp = 0; while (cond) { __builtin_amdgcn_s_sleep(1); \
    if ((++_sp & 255u) == 0u) { if (xb_ld(&(bar)[XB_TMO])) break; if (_sp > XB_SPIN_CAP) { atomicAdd(&(bar)[XB_TMO], 1u); break; } } } } while (0)

struct XcdBarrier {
    unsigned* bar; unsigned x;
    volatile LAS unsigned* st;
};

__device__ __forceinline__ XcdBarrier xcd_barrier_post(unsigned* bar, volatile LAS unsigned* st) {
    XcdBarrier b; b.bar = bar; b.x = xb_xcc_id(); b.st = st;
    if (threadIdx.x == 0) (void)xb_add(&bar[XB_XCNT(b.x)], 1u);
    return b;
}
__device__ __forceinline__ void xcd_barrier_complete(unsigned* bar, unsigned x, unsigned& nloc, unsigned& nx) {
    const unsigned G = gridDim.x * gridDim.y * gridDim.z;
    unsigned sum, cnt, mine, sp = 0u;
    for (;;) {
        sum = 0u; cnt = 0u; mine = 0u;
#pragma unroll
        for (unsigned j = 0; j < 16; ++j) { const unsigned c = xb_ld(&bar[XB_XCNT(j)]); sum += c; cnt += (c > 0u) ? 1u : 0u; mine = (j == x) ? c : mine; }
        if (sum == G) break;
        __builtin_amdgcn_s_sleep(1);
        if ((++sp & 255u) == 0u) { if (xb_ld(&bar[XB_TMO])) break; if (sp > XB_SPIN_CAP) { atomicAdd(&bar[XB_TMO], 1u); break; } }
    }
    nloc = mine > 0u ? mine : 1u; nx = cnt > 0u ? cnt : 1u;
}

__device__ __forceinline__ void xcd_barrier(const XcdBarrier& b) {
    asm volatile("s_waitcnt vmcnt(0)" ::: "memory");
    __syncthreads();
    if (threadIdx.x == 0) {
        unsigned* bar = b.bar;
        __builtin_amdgcn_s_waitcnt(0);
        unsigned nloc = b.st[0], nx = b.st[1];
        if (nloc == 0u) { xcd_barrier_complete(bar, b.x, nloc, nx); b.st[0] = nloc; b.st[1] = nx; }
        const unsigned old = xb_add(&bar[XB_XSUB(b.x)], 1u);
        const unsigned gen = old / nloc;
        if (old + 1u == (gen + 1u) * nloc) {
            __builtin_amdgcn_fence(__ATOMIC_RELEASE, "agent");
            asm volatile("s_waitcnt vmcnt(0)" ::: "memory");
            const unsigned og = xb_add(&bar[XB_TOP], 1u);
            const unsigned tg = og / nx;
            if (og + 1u == (tg + 1u) * nx) xb_add(&bar[XB_TOPGEN], 1u);
            else XB_SPIN(xb_ld(&bar[XB_TOPGEN]) == tg, bar);
            __builtin_amdgcn_fence(__ATOMIC_ACQUIRE, "agent");
            xb_add(&bar[XB_XGEN(b.x)], 1u);
            asm volatile("s_waitcnt vmcnt(0)" ::: "memory");
        } else {
            XB_SPIN(xb_ld(&bar[XB_XGEN(b.x)]) == gen, bar);
            __builtin_amdgcn_fence(__ATOMIC_ACQUIRE, "agent");
            asm volatile("s_waitcnt vmcnt(0)" ::: "memory");
        }
    }
    __syncthreads();
}


__device__ __forceinline__ void p0_transpose_item(const float* W, int K, int N, bf16* WT, LAS float* scr, int item, int lane) {
    const int nblk = N / 32, kb = item / nblk, nb = item % nblk, k0 = 64 * kb, n0 = 32 * nb;
#pragma unroll 8
    for (int i = 0; i < 32; ++i) { const int kk = 2 * i + (lane >> 5); scr[kk * 33 + (lane & 31)] = W[(size_t)(k0 + kk) * N + n0 + (lane & 31)]; }
    LDS_WAIT(); asm volatile("" ::: "memory");
    const int c = lane & 7;
#pragma unroll
    for (int j = 0; j < 4; ++j) { const int n = (lane >> 3) + 8 * j; const LAS float* s = scr + (8 * c) * 33 + n;
        v4u o; o.x = pk2(s[0 * 33], s[1 * 33]); o.y = pk2(s[2 * 33], s[3 * 33]); o.z = pk2(s[4 * 33], s[5 * 33]); o.w = pk2(s[6 * 33], s[7 * 33]);
        *(GAS v4u*)(WT + (size_t)(n0 + n) * K + k0 + 8 * c) = o; }
    LDS_WAIT(); asm volatile("" ::: "memory");
}
__device__ __forceinline__ void gemv8_item(const float* W, int ldw, int n0, const LAS float* vec, LAS float* red, const float* bias, float* out, int ldo, int wave, int lane) {
    float acc[8];
#pragma unroll
    for (int b = 0; b < 8; ++b) acc[b] = 0.f;
    const float* wp = W + (size_t)(wave * 128) * ldw + n0 + lane;
#pragma unroll 8
    for (int kk = 0; kk < 128; ++kk) { const float w = wp[(size_t)kk * ldw]; const int k = wave * 128 + kk;
#pragma unroll
        for (int b = 0; b < 8; ++b) acc[b] += vec[b * 1024 + k] * w; }
#pragma unroll
    for (int b = 0; b < 8; ++b) red[(wave * 8 + b) * 64 + lane] = acc[b];
    __syncthreads();
    { float s = 0.f;
#pragma unroll
      for (int w = 0; w < 8; ++w) s += red[(w * 8 + wave) * 64 + lane];
      out[(size_t)wave * ldo + n0 + lane] = s + (bias ? bias[n0 + lane] : 0.f); }
    __syncthreads();
}

typedef short bf16x8 __attribute__((ext_vector_type(8)));
typedef short s16x4 __attribute__((ext_vector_type(4)));
typedef short v4i16_t __attribute__((ext_vector_type(4)));
typedef float f32x16 __attribute__((ext_vector_type(16)));
constexpr float NEGBIG = -1e30f;
__device__ __forceinline__ int crow(int r, int hi) { return (r & 3) + 8 * (r >> 2) + 4 * hi; }
__device__ __forceinline__ unsigned cvtpk(float lo, float hi) { unsigned r; asm volatile("v_cvt_pk_bf16_f32 %0, %1, %2" : "=v"(r) : "v"(lo), "v"(hi)); return r; }
__device__ __forceinline__ float swapmax(float v) { auto rr = __builtin_amdgcn_permlane32_swap(__float_as_uint(v), __float_as_uint(v), false, false); return fmaxf(__uint_as_float(rr[0]), __uint_as_float(rr[1])); }
__device__ __forceinline__ float swapsum(float v) { auto rr = __builtin_amdgcn_permlane32_swap(__float_as_uint(v), __float_as_uint(v), false, false); return __uint_as_float(rr[0]) + __uint_as_float(rr[1]); }
__device__ __forceinline__ s16x4 vtr(const LAS char* p) { return __builtin_bit_cast(s16x4, __builtin_amdgcn_ds_read_tr16_b64_v4i16((LAS v4i16_t*)p)); }

template <int DV> struct WState { bf16x8 qr[4]; f32x16 o[DV / 32]; float m, l; };
template <int DV> __device__ __forceinline__ void wstate_init(WState<DV>& w, const bf16* qrow  ) {
#pragma unroll
    for (int d0 = 0; d0 < 4; ++d0) w.qr[d0] = *(const bf16x8*)(qrow + d0 * 16);
#pragma unroll
    for (int d = 0; d < DV / 32; ++d)
#pragma unroll
        for (int r = 0; r < 16; ++r) w.o[d][r] = 0.f;
    w.m = NEGBIG; w.l = 0.f;
}
__device__ __forceinline__ int k_lds_off(int kk, int c) { return kk * 128 + ((c ^ ((kk >> 1) & 7)) << 4); }
__device__ __forceinline__ int v_lds_off(int kk, int c8) { return (c8 >> 2) * 2048 + kk * 64 + (c8 & 3) * 16; }
__device__ __forceinline__ int v_rd_base(int lane) { return ((lane >> 4) & 1) * 32 + (lane & 3) * 8 + (8 * (lane >> 5) + ((lane & 15) >> 2)) * 64; }

template <int DV, class MaskF>
__device__ __forceinline__ void step32(WState<DV>& w, const LAS char* kb, const LAS char* vb, const f32x16& cinit, float shift, MaskF mf, int lane) {
    const int r32 = lane & 31, hi = lane >> 5;
    f32x16 p = cinit;
    { const LAS char* krow = kb + r32 * 128; const int ksw = (r32 >> 1) & 7;
#pragma unroll
      for (int d0 = 0; d0 < 4; ++d0) { const bf16x8 kf = *(const LAS bf16x8*)(krow + (((2 * d0 + hi) ^ ksw) << 4)); p = __builtin_amdgcn_mfma_f32_32x32x16_bf16(kf, w.qr[d0], p, 0, 0, 0); } }
    mf(p);
    float pmax = fmaxf(p[0], p[1]);
#pragma unroll
    for (int r = 2; r < 16; ++r) pmax = fmaxf(pmax, p[r]);
    pmax = swapmax(pmax);
    const float mnew = fmaxf(w.m, pmax + shift), alpha = __builtin_amdgcn_exp2f(w.m - mnew), ms = mnew - shift;
    float ps = 0.f;
#pragma unroll
    for (int r = 0; r < 16; ++r) { p[r] = __builtin_amdgcn_exp2f(p[r] - ms); ps += p[r]; }
    ps = swapsum(ps);
    w.l = w.l * alpha + ps; w.m = mnew;
    if (__any(alpha != 1.f)) {
#pragma unroll
        for (int d = 0; d < DV / 32; ++d)
#pragma unroll
            for (int r = 0; r < 16; ++r) w.o[d][r] *= alpha; }
    bf16x8 pa0, pa1;
#define PK4(P, BASE, OUT) do { unsigned a0 = cvtpk(P[BASE + 0], P[BASE + 1]), a1 = cvtpk(P[BASE + 2], P[BASE + 3]);   \
    unsigned b0 = cvtpk(P[BASE + 4], P[BASE + 5]), b1 = cvtpk(P[BASE + 6], P[BASE + 7]);                              \
    auto r0 = __builtin_amdgcn_permlane32_swap(a0, b0, false, false); auto r1 = __builtin_amdgcn_permlane32_swap(a1, b1, false, false); \
    v4u wv = {r0[0], r1[0], r0[1], r1[1]}; OUT = __builtin_bit_cast(bf16x8, wv); } while (0)
    PK4(p, 0, pa0); PK4(p, 8, pa1);
#undef PK4
    const LAS char* vbase = vb + v_rd_base(lane);
#pragma unroll
    for (int d = 0; d < DV / 32; ++d) {
        const s16x4 l0 = vtr(vbase + d * 2048), h0 = vtr(vbase + d * 2048 + 256), l1 = vtr(vbase + d * 2048 + 1024), h1 = vtr(vbase + d * 2048 + 1024 + 256);
        const bf16x8 v0 = (bf16x8){l0[0], l0[1], l0[2], l0[3], h0[0], h0[1], h0[2], h0[3]}, v1 = (bf16x8){l1[0], l1[1], l1[2], l1[3], h1[0], h1[1], h1[2], h1[3]};
        w.o[d] = __builtin_amdgcn_mfma_f32_32x32x16_bf16(v0, pa0, w.o[d], 0, 0, 0);
        w.o[d] = __builtin_amdgcn_mfma_f32_32x32x16_bf16(v1, pa1, w.o[d], 0, 0, 0);
    }
}
struct NoMask { __device__ __forceinline__ void operator()(f32x16&) const {} };

__device__ __forceinline__ void diff_unit(LAS unsigned char* lds, int b, int h, int qt, const bf16* QB, const bf16* KB, const bf16* VB, const bf16* SG,
                                          const float* subln_g, float lam, float lam_init, bf16* YM) {
    int tid = threadIdx.x; asm volatile("" : "+v"(tid));
    const int lane = tid & 63, wave = __builtin_amdgcn_readfirstlane(tid >> 6), r32 = lane & 31, hi = lane >> 5;
    const int which = wave >> 2, sub = wave & 3, q0 = qt * 128 + sub * 32;
    const float slope = __builtin_amdgcn_exp2f(-2.f * (float)(h + 1)) * LOG2E;
    WState<128> w;
    wstate_init<128>(w, QB + ((size_t)(b * 8 + h * 2 + which) * S_ + q0 + r32) * 64 + hi * 8);
    f32x16 Rpos;
#pragma unroll
    for (int r = 0; r < 16; ++r) Rpos[r] = slope * (float)(crow(r, hi) - r32);
    const bf16* K1 = KB + (size_t)(b * 8 + h * 2) * S_ * 64; const bf16* K2 = K1 + (size_t)S_ * 64; const bf16* Vh = VB + (size_t)(b * 4 + h) * S_ * 128;
    const int skey = tid >> 3, sc = tid & 7, sblk = skey >> 5, skk = skey & 31;
    const int kdst = sblk * 4096 + k_lds_off(skk, sc), vdst0 = 16384 + sblk * 8192 + v_lds_off(skk, sc), vdst1 = 16384 + sblk * 8192 + v_lds_off(skk, sc + 8);
    v4u s_k1, s_k2, s_v0, s_v1;
#define DLOAD(t) do { const size_t kr = (size_t)((t) * 64 + skey); s_k1 = *(const v4u*)(K1 + kr * 64 + sc * 8); s_k2 = *(const v4u*)(K2 + kr * 64 + sc * 8); \
        s_v0 = *(const v4u*)(Vh + kr * 128 + sc * 8); s_v1 = *(const v4u*)(Vh + kr * 128 + 64 + sc * 8); } while (0)
#define DWRITE(buf) do { LAS unsigned char* bb = lds + (buf) * 32768; *(LAS v4u*)(bb + kdst) = s_k1; *(LAS v4u*)(bb + 8192 + kdst) = s_k2; *(LAS v4u*)(bb + vdst0) = s_v0; *(LAS v4u*)(bb + vdst1) = s_v1; } while (0)
    DLOAD(0); DWRITE(0); __syncthreads();
#pragma unroll 1
    for (int t = 0; t < S_ / 64; ++t) {
        if (t + 1 < S_ / 64) DLOAD(t + 1);
        const LAS char* bb = (const LAS char*)(lds + (t & 1) * 32768);
#pragma unroll
        for (int kb2 = 0; kb2 < 2; ++kb2) {
            const int dk = t * 64 + kb2 * 32 - q0;
            f32x16 ci; const float sgn = dk > 0 ? -1.f : 1.f, shift = -slope * fabsf((float)dk);
            if (dk != 0) {
#pragma unroll
                for (int r = 0; r < 16; ++r) ci[r] = Rpos[r] * sgn;
            } else {
#pragma unroll
                for (int r = 0; r < 16; ++r) ci[r] = -fabsf(Rpos[r]); }
            step32<128>(w, bb + which * 8192 + kb2 * 4096, bb + 16384 + kb2 * 8192, ci, shift, NoMask(), lane);
        }
        if (t + 1 < S_ / 64) DWRITE((t + 1) & 1);
        __syncthreads();
    }
#undef DLOAD
#undef DWRITE
    LAS float* X = (LAS float*)lds + sub * 4096;
    if (which == 1) { const float sc2 = lam / w.l;
#pragma unroll
        for (int d = 0; d < 4; ++d)
#pragma unroll
            for (int r = 0; r < 16; ++r) X[(d * 16 + r) * 64 + lane] = w.o[d][r] * sc2; }
    __syncthreads();
    if (which == 0) { const float il = 1.f / w.l; float ss = 0.f;
#pragma unroll
        for (int d = 0; d < 4; ++d)
#pragma unroll
            for (int r = 0; r < 16; ++r) { const float v = w.o[d][r] * il - X[(d * 16 + r) * 64 + lane]; w.o[d][r] = v; ss += v * v; }
        ss = swapsum(ss);
        const float rs = rsqrtf(ss * (1.f / 128.f) + EPS) * (1.f - lam_init);
        const size_t rowoff = ((size_t)b * S_ + q0 + r32) * 1024 + 512 + h * 128;
#pragma unroll
        for (int d = 0; d < 4; ++d)
#pragma unroll
            for (int rr = 0; rr < 4; ++rr) { const int dv = 32 * d + 8 * rr + 4 * hi;
                const f32x4 g = *(const f32x4*)(subln_g + dv); const v2u sgv = *(const v2u*)(SG + rowoff + dv);
                const float s0 = __uint_as_float(sgv.x << 16), s1 = __uint_as_float(sgv.x & 0xffff0000u), s2 = __uint_as_float(sgv.y << 16), s3 = __uint_as_float(sgv.y & 0xffff0000u);
                v2u o2; o2.x = pk2(w.o[d][4 * rr] * rs * g.x * s0, w.o[d][4 * rr + 1] * rs * g.y * s1); o2.y = pk2(w.o[d][4 * rr + 2] * rs * g.z * s2, w.o[d][4 * rr + 3] * rs * g.w * s3);
                *(v2u*)(YM + rowoff + dv) = o2; } }
    __syncthreads();
}

__device__ __forceinline__ void glds16(const void* gsrc, LAS unsigned char* dst_uniform) {
    __builtin_amdgcn_global_load_lds((const unsigned*)gsrc, (LAS unsigned*)dst_uniform, 16, 0, 0);
}
template <class RowFn>
__device__ __forceinline__ void stage_blocks(LAS unsigned char* lds, int nblk, const bf16* Kh, const bf16* Vh, RowFn rowfn, int wave, int lane) {
    for (int pc = wave; pc < nblk * 8; pc += NWAVES) {
        const int blk = pc >> 3, j = pc & 7;
        if (j < 4) { const int kk = 8 * j + (lane >> 3), c = (lane & 7) ^ ((kk >> 1) & 7); const long ro = rowfn(blk, kk);
            if (ro >= 0) glds16(Kh + ro + c * 8, lds + blk * 4096 + j * 1024); }
        else { const int vp = j - 4, kk = 16 * (vp & 1) + (lane >> 2); const long ro = rowfn(blk, kk);
            if (ro >= 0) glds16(Vh + ro + (vp >> 1) * 32 + (lane & 3) * 8, lds + 65536 + blk * 4096 + (vp >> 1) * 2048 + (vp & 1) * 1024); }
    }
}
__device__ __forceinline__ void bias_tile(f32x16& ci, float& shift, const f32x16& R, float doff, bool mixed) {
    if (!mixed) { const float sgn = doff > 0.f ? -1.f : 1.f; shift = -fabsf(doff);
#pragma unroll
        for (int r = 0; r < 16; ++r) ci[r] = R[r] * sgn; }
    else { shift = 0.f;
#pragma unroll
        for (int r = 0; r < 16; ++r) ci[r] = -fabsf(R[r] + doff); }
}
struct BandMask { int dk, W, r32, hi; __device__ __forceinline__ void operator()(f32x16& p) const {
#pragma unroll
    for (int r = 0; r < 16; ++r) { const int dist = crow(r, hi) - r32 + dk; if (dist > W || dist < -W) p[r] = NEGBIG; } } };

__device__ __forceinline__ void band_unit(LAS unsigned char* lds, int b, int g, int qt, const bf16* QC, const bf16* KC, const bf16* VC, const bf16* SG, const float* sink, bf16* YM) {
    int tid = threadIdx.x; asm volatile("" : "+v"(tid));
    const int lane = tid & 63, wave = __builtin_amdgcn_readfirstlane(tid >> 6), r32 = lane & 31, hi = lane >> 5;
    const int head = g * 4 + (wave >> 1), sub = wave & 1, q0 = qt * 64 + sub * 32, ks = qt * 64 - 128;
    const bf16* Kh = KC + (size_t)(b * 4 + g) * S_ * 64; const bf16* Vh = VC + (size_t)(b * 4 + g) * S_ * 64;
    stage_blocks(lds, 10, Kh, Vh, [&](int blk, int kk) -> long { const int t = ks + blk * 32 + kk; return (t >= 0 && t < S_) ? (long)t * 64 : -1L; }, wave, lane);
    const float slope = __builtin_amdgcn_exp2f(-0.5f * (float)(head + 1)) * LOG2E;
    WState<64> w;
    wstate_init<64>(w, QC + ((size_t)(b * 16 + head) * S_ + q0 + r32) * 64 + hi * 8);
    f32x16 R;
#pragma unroll
    for (int r = 0; r < 16; ++r) R[r] = slope * (float)(crow(r, hi) - r32);
    __syncthreads();
#pragma unroll 1
    for (int i = 0; i < 9; ++i) {
        const int dk = (i == 0) ? 0 : ((i & 1) ? -32 * ((i + 1) >> 1) : 32 * (i >> 1));
        const int kb0 = q0 + dk; if (kb0 < 0 || kb0 >= S_) continue;
        const int j = (kb0 - ks) >> 5;
        f32x16 ci; float shift; bias_tile(ci, shift, R, slope * (float)dk, dk == 0);
        const LAS char* kb = (const LAS char*)(lds + j * 4096); const LAS char* vb = (const LAS char*)(lds + 65536 + j * 4096);
        if (dk == 128 || dk == -128) step32<64>(w, kb, vb, ci, shift, BandMask{dk, 128, r32, hi}, lane);
        else step32<64>(w, kb, vb, ci, shift, NoMask(), lane);
    }
    const float sk = sink[head] * LOG2E, Mx = fmaxf(w.m, sk), e = __builtin_amdgcn_exp2f(w.m - Mx);
    const float sc = e / (w.l * e + __builtin_amdgcn_exp2f(sk - Mx));
    const size_t rowoff = ((size_t)b * S_ + q0 + r32) * 1024 + head * 64;
#pragma unroll
    for (int d = 0; d < 2; ++d)
#pragma unroll
        for (int rr = 0; rr < 4; ++rr) { const int dv = 32 * d + 8 * rr + 4 * hi; const v2u sgv = *(const v2u*)(SG + rowoff + dv);
            const float s0 = __uint_as_float(sgv.x << 16), s1 = __uint_as_float(sgv.x & 0xffff0000u), s2 = __uint_as_float(sgv.y << 16), s3 = __uint_as_float(sgv.y & 0xffff0000u);
            v2u o2; o2.x = pk2(w.o[d][4 * rr] * sc * s0, w.o[d][4 * rr + 1] * sc * s1); o2.y = pk2(w.o[d][4 * rr + 2] * sc * s2, w.o[d][4 * rr + 3] * sc * s3);
            *(v2u*)(YM + rowoff + dv) = o2; }
    __syncthreads();
}

struct DilMask { int dm0, dr, own, r32, hi; __device__ __forceinline__ void operator()(f32x16& p) const {
#pragma unroll
    for (int r = 0; r < 16; ++r) { int dd = 16 * (dm0 + crow(r, hi) - r32) + dr; dd = dd < 0 ? -dd : dd;
        if (own) p[r] = (dd <= 1024) ? ((dd <= 256) ? p[r] + 1.f : p[r]) : NEGBIG; else p[r] = (dd <= 256) ? p[r] : NEGBIG; } } };
__device__ __forceinline__ void dilB_unit(LAS unsigned char* lds, int b, int h, int r4, const bf16* QA, const bf16* KA, const bf16* VA, float* STO, float* STML) {
    int tid = threadIdx.x; asm volatile("" : "+v"(tid));
    const int lane = tid & 63, wave = __builtin_amdgcn_readfirstlane(tid >> 6), r32 = lane & 31, hi = lane >> 5;
    const size_t hb = (size_t)(b * 8 + h) * S_;
    const bf16* Kh = KA + hb * 64; const bf16* Vh = VA + hb * 64;
    stage_blocks(lds, 16, Kh, Vh, [&](int blk, int kk) -> long { return (long)(((r4 + 4 * (blk >> 2)) * 128) + (blk & 3) * 32 + kk) * 64; }, wave, lane);
    const float slope = __builtin_amdgcn_exp2f(-(float)(h + 1)) * LOG2E;
    f32x16 R;
#pragma unroll
    for (int r = 0; r < 16; ++r) R[r] = 16.f * slope * (float)(crow(r, hi) - r32);
    __syncthreads();
#pragma unroll 1
    for (int tk = wave; tk < 16; tk += NWAVES) {
        const int qi = tk >> 2, qmb = tk & 3, cq = r4 + 4 * qi, m0 = 32 * qmb;
        WState<64> w;
        wstate_init<64>(w, QA + (hb + cq * 128 + m0 + r32) * 64 + hi * 8);
#pragma unroll 1
        for (int s = 0; s < 16; ++s) {
            const int ki = (qi + (s >> 2)) & 3, kmb = (qmb + (s & 3)) & 3;
            const int dm0 = 32 * (kmb - qmb), dr = 4 * (ki - qi), own = (ki == qi);
            if (own ? (dm0 >= 96 || dm0 <= -96) : (dm0 >= 64 || dm0 <= -64)) continue;
            f32x16 ci; float shift; bias_tile(ci, shift, R, slope * (float)(16 * dm0 + dr), dm0 == 0);
            const int blk = ki * 4 + kmb;
            step32<64>(w, (const LAS char*)(lds + blk * 4096), (const LAS char*)(lds + 65536 + blk * 4096), ci, shift, DilMask{dm0, dr, own, r32, hi}, lane);
        }
        const int t = 16 * (m0 + r32) + cq;
        float* so = STO + (hb + t) * 64;
#pragma unroll
        for (int d = 0; d < 2; ++d)
#pragma unroll
            for (int rr = 0; rr < 4; ++rr) *(f32x4*)(so + 32 * d + 8 * rr + 4 * hi) = (f32x4){w.o[d][4 * rr], w.o[d][4 * rr + 1], w.o[d][4 * rr + 2], w.o[d][4 * rr + 3]};
        if (hi == 0) { float2 ml; ml.x = w.m; ml.y = w.l; *(float2*)(STML + (hb + t) * 2) = ml; }
    }
    __syncthreads();
}
__device__ __forceinline__ void dilA_unit(LAS unsigned char* lds, int b, int h, int qt, const bf16* QA, const bf16* KA, const bf16* VA, const float* STO, const float* STML, const bf16* SG, bf16* YM) {
    int tid = threadIdx.x; asm volatile("" : "+v"(tid));
    const int lane = tid & 63, wave = __builtin_amdgcn_readfirstlane(tid >> 6), r32 = lane & 31, hi = lane >> 5;
    const size_t hb = (size_t)(b * 8 + h) * S_;
    const bf16* Kh = KA + hb * 64; const bf16* Vh = VA + hb * 64;
    const int q0 = qt * 256 + wave * 32, ks = qt * 256 - 64, tq = q0 + r32;
    stage_blocks(lds, 12, Kh, Vh, [&](int blk, int kk) -> long { const int t = ks + blk * 32 + kk; return (t >= 0 && t < S_) ? (long)pi16(t) * 64 : -1L; }, wave, lane);
    const float slope = __builtin_amdgcn_exp2f(-(float)(h + 1)) * LOG2E;
    WState<64> w;
    wstate_init<64>(w, QA + (hb + pi16(tq)) * 64 + hi * 8);
    { const float* so = STO + (hb + tq) * 64;
#pragma unroll
      for (int d = 0; d < 2; ++d)
#pragma unroll
          for (int rr = 0; rr < 4; ++rr) { const f32x4 v = *(const f32x4*)(so + 32 * d + 8 * rr + 4 * hi); w.o[d][4 * rr] = v.x; w.o[d][4 * rr + 1] = v.y; w.o[d][4 * rr + 2] = v.z; w.o[d][4 * rr + 3] = v.w; }
      const float2 ml = *(const float2*)(STML + (hb + tq) * 2); w.m = ml.x; w.l = ml.y; }
    f32x16 R;
#pragma unroll
    for (int r = 0; r < 16; ++r) R[r] = slope * (float)(crow(r, hi) - r32);
    __syncthreads();
#pragma unroll 1
    for (int i = 0; i < 5; ++i) {
        const int dk = 32 * (i - 2), kb0 = q0 + dk; if (kb0 < 0 || kb0 >= S_) continue;
        const int j = (kb0 - ks) >> 5;
        f32x16 ci; float shift; bias_tile(ci, shift, R, slope * (float)dk, dk == 0);
        const LAS char* kb = (const LAS char*)(lds + j * 4096); const LAS char* vb = (const LAS char*)(lds + 65536 + j * 4096);
        if (dk == 64 || dk == -64) step32<64>(w, kb, vb, ci, shift, BandMask{dk, 64, r32, hi}, lane);
        else step32<64>(w, kb, vb, ci, shift, NoMask(), lane);
    }
    const float sc = 1.f / w.l;
    const size_t rowoff = ((size_t)b * S_ + tq) * 1024 + h * 64;
#pragma unroll
    for (int d = 0; d < 2; ++d)
#pragma unroll
        for (int rr = 0; rr < 4; ++rr) { const int dv = 32 * d + 8 * rr + 4 * hi; const v2u sgv = *(const v2u*)(SG + rowoff + dv);
            const float s0 = __uint_as_float(sgv.x << 16), s1 = __uint_as_float(sgv.x & 0xffff0000u), s2 = __uint_as_float(sgv.y << 16), s3 = __uint_as_float(sgv.y & 0xffff0000u);
            v2u o2; o2.x = pk2(w.o[d][4 * rr] * sc * s0, w.o[d][4 * rr + 1] * sc * s1); o2.y = pk2(w.o[d][4 * rr + 2] * sc * s2, w.o[d][4 * rr + 3] * sc * s3);
            *(v2u*)(YM + rowoff + dv) = o2; }
    __syncthreads();
}

struct Args { const float* in[16]; float* out; unsigned char* ws; int ph_lo, ph_hi; };
constexpr int PH_P0A = 0, PH_P0B = 1, PH_L0 = 2, PH_FINAL = 18, PH_END = 19;

__global__ void __launch_bounds__(NWAVES * 64, 2) mega(Args args) {
    extern __shared__ __attribute__((aligned(16))) unsigned char lds_raw[];
    LAS unsigned char* lds = (LAS unsigned char*)lds_raw;
    volatile LAS unsigned* MISC = (volatile LAS unsigned*)(lds + MISC_OFF);
    const int tid = threadIdx.x, lane = tid & 63, wave = __builtin_amdgcn_readfirstlane(tid >> 6);
    const int G = gridDim.x; const int bx = blockIdx.x; const int vcu = (G % 8 == 0) ? (bx % 8) * (G / 8) + bx / 8 : bx;
    unsigned char* ws = args.ws;
    unsigned* ctl = (unsigned*)(ws + WS_CTL);
    for (int u = tid; u < (LDS_BYTES - LDSCTL_OFF) / 4; u += NWAVES * 64) ((LAS unsigned*)(lds + LDSCTL_OFF))[u] = 0u;
    __syncthreads();
    const int lo = args.ph_lo, hi = args.ph_hi;
    const bool use_bar = (hi - lo) > 1;
    XcdBarrier bar; bar.bar = ctl + CW_BAR; bar.x = 0; bar.st = nullptr;
    if (use_bar) bar = xcd_barrier_post(ctl + CW_BAR, MISC + 8);
#define IN(k) (lo <= (k) && (k) < hi)
#define SEAM(k) do { if (IN(k) && IN((k) + 1)) xcd_barrier(bar); } while (0)
    const float* x_in = args.in[0]; const float* c_in = args.in[1]; const float* ada_w = args.in[2]; const float* ada_b = args.in[3]; const float* norm_g = args.in[4];
    const float* ab_w_in = args.in[5]; const float* ab_w_out = args.in[6]; const float* c_w_in = args.in[12]; const float* c_w_out = args.in[13]; const float* final_g = args.in[15];
    float* mod = (float*)(ws + WS_MOD); float* shw = (float*)(ws + WS_SHW); float* ssq = (float*)(ws + WS_SSQ); float* lam = (float*)(ws + WS_LAM);
    bf16* XS = (bf16*)(ws + WS_XS);
    const int gw = vcu * NWAVES + wave, NGW = G * NWAVES;

    if (IN(PH_P0A)) {
        LAS float* vec = (LAS float*)lds; LAS float* red = (LAS float*)(lds + 32768);
        for (int i = tid; i < 8 * 1024; i += NWAVES * 64) vec[i] = nv::silu(c_in[i]);
        __syncthreads();
        for (int it = bx; it < 4 * 48; it += G) { const int l = it / 48, jc = it % 48;
            gemv8_item(ada_w + (size_t)l * 1024 * 3072, 3072, jc * 64, vec, red, ada_b + l * 3072, mod + (size_t)l * 8 * 3072, 3072, wave, lane); }
        __syncthreads();
        LAS float* scr = (LAS float*)(lds + wave * 16384);
        constexpr int I_WE = 16 * 128, I_WO = 16 * 32, I_CE = 16 * 80;
        constexpr int NITEMS = 2 * I_WE + 2 * I_WO + 2 * I_CE + 2 * I_WO;
        for (int it = gw; it < NITEMS; it += NGW) { int r = it;
            if (r < 2 * I_WE) { const int j = r / I_WE; p0_transpose_item(ab_w_in + (size_t)j * 1024 * 4096, 1024, 4096, (bf16*)(ws + WS_WIN_E) + (size_t)j * 4096 * 1024, scr, r % I_WE, lane); continue; } r -= 2 * I_WE;
            if (r < 2 * I_WO) { const int j = r / I_WO; p0_transpose_item(ab_w_out + (size_t)j * 1024 * 1024, 1024, 1024, (bf16*)(ws + WS_WOUT_E) + (size_t)j * 1024 * 1024, scr, r % I_WO, lane); continue; } r -= 2 * I_WO;
            if (r < 2 * I_CE) { const int j = r / I_CE; p0_transpose_item(c_w_in + (size_t)j * 1024 * 2560, 1024, 2560, (bf16*)(ws + WS_WIN_O) + (size_t)j * 2560 * 1024, scr, r % I_CE, lane); continue; } r -= 2 * I_CE;
            { const int j = r / I_WO; p0_transpose_item(c_w_out + (size_t)j * 1024 * 1024, 1024, 1024, (bf16*)(ws + WS_WOUT_O) + (size_t)j * 1024 * 1024, scr, r % I_WO, lane); } }
        for (int i = bx * 512 + tid; i < 3 * M_; i += G * 512) ssq[M_ + i] = 0.f;
        if (bx == 0 && tid < 2) { const float* lq1 = args.in[7]; const float* lk1 = args.in[8]; const float* lq2 = args.in[9]; const float* lk2 = args.in[10];
            float s1 = 0.f, s2 = 0.f;
            for (int d = 0; d < 64; ++d) { s1 += lq1[tid * 64 + d] * lk1[tid * 64 + d]; s2 += lq2[tid * 64 + d] * lk2[tid * 64 + d]; }
            lam[tid] = expf(s1) - expf(s2) + (0.8f - 0.6f * expf(-0.3f * (float)(2 * tid))); }
        __syncthreads();
    }
    SEAM(PH_P0A);
    if (IN(PH_P0B)) {
        LAS float* vec = (LAS float*)lds; LAS float* red = (LAS float*)(lds + 32768);
        int cur_l = -1;
        for (int it = bx; it < 2 * 64 + 2 * 40; it += G) {
            int l, nc; if (it < 128) { l = (it / 64) * 2; nc = it % 64; } else { l = ((it - 128) / 40) * 2 + 1; nc = (it - 128) % 40; }
            if (l != cur_l) { __syncthreads(); for (int i = tid; i < 8 * 1024; i += NWAVES * 64) vec[i] = mod[(size_t)l * 8 * 3072 + (i >> 10) * 3072 + (i & 1023)]; cur_l = l; __syncthreads(); }
            const int j = l >> 1; const float* W = (l & 1) ? c_w_in + (size_t)j * 1024 * 2560 : ab_w_in + (size_t)j * 1024 * 4096; const int ldw = (l & 1) ? 2560 : 4096;
            gemv8_item(W, ldw, nc * 64, vec, red, nullptr, shw + (size_t)l * 8 * 4096, 4096, wave, lane); }
        for (int row = gw; row < M_; row += NGW) { const int b = row >> 11;
            const GAS f32x4* xr = (const GAS f32x4*)(x_in + (size_t)row * D_) + lane; const f32x4* gr = (const f32x4*)norm_g + lane; const f32x4* sr = (const f32x4*)(mod + (size_t)b * 3072 + 1024) + lane;
            GAS v2u* o8 = (GAS v2u*)(XS + (size_t)row * D_) + lane; float ss = 0.f;
#pragma unroll
            for (int j = 0; j < 4; ++j) { const f32x4 v = xr[64 * j], g = gr[64 * j], s = sr[64 * j]; ss += (v.x * v.x + v.y * v.y) + (v.z * v.z + v.w * v.w);
                v2u o; o.x = pk2(v.x * g.x * (1.f + s.x), v.y * g.y * (1.f + s.y)); o.y = pk2(v.z * g.z * (1.f + s.z), v.w * g.w * (1.f + s.w)); o8[64 * j] = o; }
            ss = wsum(ss); if (lane == 0) ssq[row] = ss; }
    }
    SEAM(PH_P0B);
#pragma unroll 1
    for (int l = 0; l < 4; ++l) {
        const int j = l >> 1, odd = l & 1; const int ph = PH_L0 + 4 * l;
        const float* mod_l = mod + (size_t)l * 8 * 3072;
        if (IN(ph)) {
            const int N = odd ? 2560 : 4096;
            const bf16* Wt = odd ? (const bf16*)(ws + WS_WIN_O) + (size_t)j * 2560 * 1024 : (const bf16*)(ws + WS_WIN_E) + (size_t)j * 4096 * 1024;
            pg8::Gemm g{XS, Wt, M_, N, 1024}; pg8::StaticOrder S; S.init(M_, N, G, bx);
            pg8::EpiProj E{odd, ssq + (size_t)l * M_, shw + (size_t)l * 8 * 4096, ws};
            pg8::gemm_phase<pg8::EpiProj, pg8::StaticOrder, true, true>(lds, g, S, E);
        }
        SEAM(ph);
        if (IN(ph + 1)) {
            const bf16* SGp = (const bf16*)(ws + WS_SG); bf16* YMp = (bf16*)(ws + WS_YMIX);
            if (!odd) {
                for (int u = vcu; u < 256; u += G) dilB_unit(lds, u >> 5, (u >> 2) & 7, u & 3, (const bf16*)(ws + WS_QA), (const bf16*)(ws + WS_KA), (const bf16*)(ws + WS_VA), (float*)(ws + WS_STO), (float*)(ws + WS_STML));
                const float lam_init = 0.8f - 0.6f * __expf(-0.3f * (float)l); const float lam_v = lam[j];
                for (int u = vcu; u < 512; u += G) { const int bh = u >> 4, qt = u & 15;
                    diff_unit(lds, bh >> 2, bh & 3, qt, (const bf16*)(ws + WS_QB), (const bf16*)(ws + WS_KB), (const bf16*)(ws + WS_VB), SGp, args.in[11] + j * 128, lam_v, lam_init, YMp); }
            } else {
                for (int u = vcu; u < 1024; u += G) band_unit(lds, u >> 7, (u >> 5) & 3, u & 31, (const bf16*)(ws + WS_QC), (const bf16*)(ws + WS_KC), (const bf16*)(ws + WS_VC), SGp, args.in[14] + j * 16, YMp);
            }
        }
        if (!odd) SEAM(ph + 1);
        if (IN(ph + 2)) {
            if (!odd) {
                for (int u = vcu; u < 512; u += G) dilA_unit(lds, u >> 6, (u >> 3) & 7, u & 7, (const bf16*)(ws + WS_QA), (const bf16*)(ws + WS_KA), (const bf16*)(ws + WS_VA), (const float*)(ws + WS_STO), (const float*)(ws + WS_STML), (const bf16*)(ws + WS_SG), (bf16*)(ws + WS_YMIX));
            }
        }
        SEAM(ph + 2);
        if (IN(ph + 3)) {
            const bf16* Wt = odd ? (const bf16*)(ws + WS_WOUT_O) + (size_t)j * 1024 * 1024 : (const bf16*)(ws + WS_WOUT_E) + (size_t)j * 1024 * 1024;
            pg8::Gemm g{(const bf16*)(ws + WS_YMIX), Wt, M_, 1024, 1024}; pg8::StaticOrder S; S.init(M_, 1024, G, bx);
            const int has_next = (l < 3);
            pg8::EpiOutR E{l == 0 ? x_in : args.out, args.out, mod_l + 2048, has_next, norm_g + (l + 1) * 1024, mod_l + 8 * 3072 + 1024, XS, ssq + (size_t)(l + 1) * M_};
            pg8::gemm_phase<pg8::EpiOutR, pg8::StaticOrder, true, true>(lds, g, S, E);
        }
        SEAM(ph + 3);
    }
    if (IN(PH_FINAL)) {
        for (int row = gw; row < M_; row += NGW) {
            GAS f32x4* xr = (GAS f32x4*)(args.out + (size_t)row * D_) + lane; const f32x4* gr = (const f32x4*)final_g + lane;
            f32x4 v[4]; float ss = 0.f;
#pragma unroll
            for (int q = 0; q < 4; ++q) { v[q] = xr[64 * q]; ss += (v[q].x * v[q].x + v[q].y * v[q].y) + (v[q].z * v[q].z + v[q].w * v[q].w); }
            ss = wsum(ss); const float rstd = rsqrtf(ss * (1.f / D_) + EPS);
#pragma unroll
            for (int q = 0; q < 4; ++q) { const f32x4 g = gr[64 * q]; xr[64 * q] = v[q] * rstd * g; } }
    }
#undef IN
#undef SEAM
}
}

static void launch_mega(const mk::Args& base, int lo, int hi, int grid, hipStream_t stream) {
    mk::Args a = base; a.ph_lo = lo; a.ph_hi = hi;
    hipLaunchKernelGGL(mk::mega, dim3(grid), dim3(mk::NWAVES * 64), mk::LDS_BYTES, stream, a);
}
extern "C" void kernel_launch(void* const* d_in, const int* in_sizes, int n_in, void* d_out, int out_size, void* d_ws, size_t ws_size, hipStream_t stream) {
    using namespace nv;
    static int grid = 0;
    if (grid == 0) {
        if (n_in != 16 || in_sizes[0] != M_ * D_ || out_size != M_ * D_ || ws_size < lay::WS_END) { fprintf(stderr, "kernel_launch: unexpected shapes / workspace (%d inputs, ws %zu)\n", n_in, ws_size); grid = -1; return; }
        int dev = 0, cus = 0, per_cu = 0;
        if (hipGetDevice(&dev) != hipSuccess || hipDeviceGetAttribute(&cus, hipDeviceAttributeMultiprocessorCount, dev) != hipSuccess) { grid = -1; return; }
        if (hipFuncSetAttribute((const void*)mk::mega, hipFuncAttributeMaxDynamicSharedMemorySize, mk::LDS_BYTES) != hipSuccess) { fprintf(stderr, "kernel_launch: hipFuncSetAttribute failed\n"); grid = -1; return; }
        if (hipOccupancyMaxActiveBlocksPerMultiprocessor(&per_cu, (const void*)mk::mega, mk::NWAVES * 64, mk::LDS_BYTES) != hipSuccess || per_cu < 1) { fprintf(stderr, "kernel_launch: occupancy query says %d blocks/CU\n", per_cu); per_cu = 1; }
        (void)hipGetLastError();
        grid = cus;
        if (grid != 256) fprintf(stderr, "kernel_launch: note: %d CUs\n", grid);
    }
    if (grid < 0) return;
    (void)hipMemsetAsync((char*)d_ws + lay::WS_CTL, 0, lay::CTL_ZERO_BYTES, stream);
    mk::Args a{};
    for (int i = 0; i < 16; ++i) a.in[i] = (const float*)d_in[i];
    a.out = (float*)d_out; a.ws = (unsigned char*)d_ws;
    launch_mega(a, mk::PH_P0A, mk::PH_END, grid, stream);
    const hipError_t le = hipPeekAtLastError();
    if (le != hipSuccess) fprintf(stderr, "kernel_launch: launch failed: %s\n", hipGetErrorName(le));
}
```

```cpp
#include <hip/hip_runtime.h>
#include <cstdio>
#include <cstdint>

namespace lay {
constexpr size_t MiB = 1u << 20;
constexpr size_t WS_CTL = 0, CTL_ZERO_BYTES = 64 * 1024;
constexpr size_t WS_MOD = 1 * MiB;
constexpr size_t WS_SHW = WS_MOD + 512 * 1024;
constexpr size_t WS_SSQ = 2 * MiB;
constexpr size_t WS_LAM = WS_SSQ + 512 * 1024;
constexpr size_t WS_WIN_E = 3 * MiB;
constexpr size_t WS_WOUT_E = 19 * MiB;
constexpr size_t WS_WIN_O = 23 * MiB;
constexpr size_t WS_WOUT_O = 33 * MiB;
constexpr size_t WS_XS = 37 * MiB;
constexpr size_t WS_YMIX = 69 * MiB;
constexpr size_t WS_SG = 101 * MiB;
constexpr size_t WS_P = 133 * MiB;
constexpr size_t WS_QA = WS_P, WS_KA = WS_P + 16 * MiB, WS_VA = WS_P + 32 * MiB, WS_QB = WS_P + 48 * MiB, WS_KB = WS_P + 64 * MiB, WS_VB = WS_P + 80 * MiB;
constexpr size_t WS_QC = WS_P, WS_KC = WS_P + 32 * MiB, WS_VC = WS_P + 40 * MiB;
constexpr size_t WS_STO = WS_XS;
constexpr size_t WS_STML = WS_P + 96 * MiB;
constexpr size_t WS_END = WS_STML + 1 * MiB;
static_assert(WS_END <= 256 * MiB, "ws map");
constexpr size_t WS_XCH = WS_LAM + 64 * 1024;
constexpr int CW_RANK = 13312, CW_LB = 14336;
constexpr int CW_SYN = 12288;
constexpr int CW_GRP = 15360;
constexpr int CW_BAR = 1024, CW_PANEL = 8192;
static_assert(CW_PANEL + 64 * 64 <= CW_SYN && CW_SYN + 4 * 8 * 32 <= CW_RANK && CW_RANK + 8 * 64 <= CW_LB && CW_LB + 1024 <= CW_GRP && (CW_GRP + 512) * 4 <= (int)CTL_ZERO_BYTES, "control words inside the memset region");
}

namespace nv {
typedef unsigned short bf16;
constexpr int B_ = 8, S_ = 2048, D_ = 1024, M_ = B_ * S_;
constexpr float LOG2E = 1.4426950408889634f;
constexpr float QSCALE = 0.125f * LOG2E;
constexpr float EPS = 1e-6f;
__device__ __forceinline__ float silu(float x) { return x / (1.f + __expf(-x)); }
__device__ __forceinline__ int pi16(int t) { return (t & 15) * 128 + (t >> 4); }
using namespace lay;
}

namespace pg8 {
#define PG8_LAS __attribute__((address_space(3)))
typedef unsigned short bf16_t;
typedef short bf16x8 __attribute__((ext_vector_type(8)));
typedef float f32x4 __attribute__((ext_vector_type(4)));
typedef unsigned u32x4 __attribute__((ext_vector_type(4)));
constexpr int BM = 256, BK = 64, HALF = 128, HTB = HALF * BK * 2  , STAGE_BYTES = 8 * HTB, NXCD = 8, WGM = 8;

__host__ __device__ __forceinline__ int lds_byte(int r, int c) { const int st = (r >> 4) * 2 + (c >> 5), rr = r & 15, cc = c & 31, ob = rr * 64 + cc * 2; return st * 1024 + (ob ^ (((ob >> 9) & 1) << 5)); }
__host__ __device__ __forceinline__ void stage_rc(int b, int& R, int& C) { const int st = b / 1024, sb = b % 1024, swz = sb ^ (((sb >> 9) & 1) << 5); R = (st >> 1) * 16 + swz / 64; C = (st & 1) * 32 + (swz % 64) / 2; }
__host__ __device__ __forceinline__ int perm32(int rho) { const int n = rho >> 4, i = rho & 15; return 8 * (i >> 2) + 4 * n + (i & 3); }

struct Unit { int pm, pn; };
struct Gemm { const bf16_t* A; const bf16_t* Bt; int M, N, K; };

struct StaticOrder {
    int nM, nN, nwg, G, c;
    __host__ __device__ void init(int M, int N, int G_, int c_) { nM = M / BM; nN = N / BM; nwg = nM * nN; G = G_; c = c_; }
    __host__ __device__ bool next(int i, Unit& u) const {
        const long L = (long)i * G + c; if (L >= nwg) return false;
        int wgid = (int)L; { const int q = nwg / NXCD, r = nwg % NXCD, xcd = wgid % NXCD, off = wgid / NXCD; wgid = (xcd < r ? xcd * (q + 1) : r * (q + 1) + (xcd - r) * q) + off; }
        const int nig = WGM * nN, gid = wgid / nig, fm = gid * WGM, gsz = (nM - fm) < WGM ? (nM - fm) : WGM;
        u.pm = fm + ((wgid % nig) % gsz); u.pn = (wgid % nig) / gsz; return true;
    }
    __device__ __forceinline__ void a_ready(const Unit&) const {}
    __device__ __forceinline__ void done(const Unit&) const {}
};

__device__ __forceinline__ unsigned cvt_pk_bf16(float lo, float hi) { unsigned r; asm volatile("v_cvt_pk_bf16_f32 %0, %1, %2" : "=v"(r) : "v"(lo), "v"(hi)); return r; }

struct HookOrder {
    StaticOrder so; unsigned* r1; unsigned* r2;
    __device__ __forceinline__ bool next(int i, Unit& u) const { return so.next(i, u); }
    __device__ __forceinline__ void a_ready(const Unit&) const {}
    __device__ __forceinline__ void done(const Unit&) const {}
    __device__ __forceinline__ void after(int ui, int lane) const {
        if (r1 != nullptr && ui >= 1) { asm volatile("s_waitcnt vmcnt(0)" ::: "memory"); if (lane == 0) (void)__hip_atomic_fetch_add(ui == 1 ? r1 : r2, 1u, __ATOMIC_RELAXED, __HIP_MEMORY_SCOPE_AGENT); }
    }
};
template <class T> struct has_hook { static constexpr bool v = false; };
template <> struct has_hook<HookOrder> { static constexpr bool v = true; };
__device__ __forceinline__ void war_wait(unsigned* p, unsigned target) {
    if (!p) return;
    unsigned sp = 0;
    while (__hip_atomic_load(p, __ATOMIC_RELAXED, __HIP_MEMORY_SCOPE_AGENT) < target) { __builtin_amdgcn_s_sleep(1); if (++sp > (1u << 20)) break; }
}
struct EpiProj {
    static constexpr bool PERM = true, AFTER_DRAIN = false;
    int odd; const float* ssq; const float* shw; unsigned char* ws; unsigned* wptr; unsigned wtarget;
    __device__ __forceinline__ void operator()(const f32x4 (&acc)[2][2][4][2], const Unit& u, int wr, int wc, int fr, int fq) const {
        using namespace nv;
        const int row0 = u.pm * BM + wr * 64 + fr, b = u.pm >> 3, pn = u.pn;
        war_wait(wptr, wtarget);
        size_t base; int cb, lg, nh, perm, kind;
        if (!odd) {
            if (pn < 6)       { base = lay::WS_QA + (size_t)(pn >> 1) * (16u << 20); cb = (pn & 1) * 256; lg = 6; nh = 8; perm = 0; kind = 0; }
            else if (pn < 10) { base = lay::WS_QB + (size_t)((pn - 6) >> 1) * (16u << 20); cb = ((pn - 6) & 1) * 256; lg = 6; nh = 8; perm = 0; kind = 0; }
            else if (pn < 12) { base = lay::WS_VB; cb = (pn - 10) * 256; lg = 7; nh = 4; perm = 0; kind = 0; }
            else              { base = lay::WS_SG; cb = (pn - 12) * 256; lg = 0; nh = 0; perm = 0; kind = 1; }
        } else {
            if (pn < 4)       { base = lay::WS_QC; cb = pn * 256; lg = 6; nh = 16; perm = 0; kind = 0; }
            else if (pn == 4) { base = lay::WS_KC; cb = 0; lg = 6; nh = 4; perm = 0; kind = 0; }
            else if (pn == 5) { base = lay::WS_VC; cb = 0; lg = 6; nh = 4; perm = 0; kind = 0; }
            else              { base = lay::WS_SG; cb = (pn - 6) * 256; lg = 0; nh = 0; perm = 0; kind = 1; }
        }
        const bool isq = (!odd && (pn < 2 || pn == 6 || pn == 7)) || (odd && pn < 4);
        const float qs = isq ? QSCALE : 1.f;
        bf16_t* dst = (bf16_t*)(ws + base);
        const int cl0 = wc * 32 + 8 * fq;
        f32x4 bv[2][2];
#pragma unroll
        for (int bj = 0; bj < 2; ++bj)
#pragma unroll
            for (int n = 0; n < 2; ++n) bv[bj][n] = *(const f32x4*)(shw + (size_t)b * 4096 + pn * BM + cl0 + bj * HALF + 4 * n);
        float rsv[2][4];
#pragma unroll
        for (int ai = 0; ai < 2; ++ai)
#pragma unroll
            for (int m = 0; m < 4; ++m) rsv[ai][m] = ssq[row0 + ai * HALF + m * 16];
#pragma unroll
        for (int ai = 0; ai < 2; ++ai)
#pragma unroll
            for (int m = 0; m < 4; ++m) rsv[ai][m] = rsqrtf(rsv[ai][m] * (1.f / 1024.f) + EPS);
#pragma unroll
        for (int ai = 0; ai < 2; ++ai)
#pragma unroll
            for (int m = 0; m < 4; ++m) {
                const int row = row0 + ai * HALF + m * 16, t = row & 2047;
                const float rs = rsv[ai][m];
                const int tt = perm ? pi16(t) : t;
#pragma unroll
                for (int bj = 0; bj < 2; ++bj) {
                    f32x4 v0 = acc[ai][bj][m][0] * rs + bv[bj][0], v1 = acc[ai][bj][m][1] * rs + bv[bj][1];
                    const int cc = cb + cl0 + bj * HALF;
                    size_t off;
                    if (kind == 1) { off = (size_t)row * 1024 + cc;
#pragma unroll
                        for (int q = 0; q < 4; ++q) { v0[q] = v0[q] * __builtin_amdgcn_rcpf(1.f + __builtin_amdgcn_exp2f(-v0[q] * LOG2E)); v1[q] = v1[q] * __builtin_amdgcn_rcpf(1.f + __builtin_amdgcn_exp2f(-v1[q] * LOG2E)); } }
                    else { off = ((((size_t)(b * nh + (cc >> lg)) << 11) + tt) << lg) + (cc & ((1 << lg) - 1)); v0 = v0 * qs; v1 = v1 * qs; }
                    u32x4 w; w.x = cvt_pk_bf16(v0[0], v0[1]); w.y = cvt_pk_bf16(v0[2], v0[3]); w.z = cvt_pk_bf16(v1[0], v1[1]); w.w = cvt_pk_bf16(v1[2], v1[3]);
                    *(u32x4*)(dst + off) = w;
                }
            }
    }
};
struct EpiOutR {
    static constexpr bool PERM = true, AFTER_DRAIN = false;
    const float* xin; float* xout; const float* gate; int has_next; const float* g_next; const float* scale_next; bf16_t* xs; float* ssq_next; unsigned* wptr; unsigned wtarget;
    __device__ __forceinline__ void operator()(const f32x4 (&acc)[2][2][4][2], const Unit& u, int wr, int wc, int fr, int fq) const {
        const int row0 = u.pm * BM + wr * 64 + fr, b = u.pm >> 3;
        war_wait(wptr, wtarget);
        const int c0 = u.pn * BM + wc * 32 + 8 * fq;
        f32x4 gt[2][2], gs[2][2];
#pragma unroll
        for (int bj = 0; bj < 2; ++bj)
#pragma unroll
            for (int n = 0; n < 2; ++n) { const int c = c0 + bj * HALF + 4 * n; gt[bj][n] = *(const f32x4*)(gate + (size_t)b * 3072 + c);
                if (has_next) { const f32x4 g = *(const f32x4*)(g_next + c), s = *(const f32x4*)(scale_next + (size_t)b * 3072 + c); gs[bj][n] = g * (1.f + s); } else gs[bj][n] = (f32x4){0.f, 0.f, 0.f, 0.f}; }
#pragma unroll
        for (int aq = 0; aq < 4; ++aq) { const int ai = aq >> 1, mb = (aq & 1) * 2;
            f32x4 xv[4][2][2];
#pragma unroll
            for (int m = mb; m < mb + 2; ++m)
#pragma unroll
                for (int bj = 0; bj < 2; ++bj) { const size_t off = (size_t)(row0 + ai * HALF + m * 16) * 1024 + c0 + bj * HALF; xv[m][bj][0] = *(const f32x4*)(xin + off); xv[m][bj][1] = *(const f32x4*)(xin + off + 4); }
#pragma unroll
            for (int m = mb; m < mb + 2; ++m) {
                const int row = row0 + ai * HALF + m * 16; float ss = 0.f;
#pragma unroll
                for (int bj = 0; bj < 2; ++bj) {
                    const size_t off = (size_t)row * 1024 + c0 + bj * HALF;
                    const f32x4 n0 = xv[m][bj][0] + gt[bj][0] * acc[ai][bj][m][0], n1 = xv[m][bj][1] + gt[bj][1] * acc[ai][bj][m][1];
                    *(f32x4*)(xout + off) = n0; *(f32x4*)(xout + off + 4) = n1;
                    if (has_next) {
                        ss += (n0[0] * n0[0] + n0[1] * n0[1]) + (n0[2] * n0[2] + n0[3] * n0[3]) + (n1[0] * n1[0] + n1[1] * n1[1]) + (n1[2] * n1[2] + n1[3] * n1[3]);
                        const f32x4 a = n0 * gs[bj][0], c = n1 * gs[bj][1];
                        u32x4 w; w.x = cvt_pk_bf16(a[0], a[1]); w.y = cvt_pk_bf16(a[2], a[3]); w.z = cvt_pk_bf16(c[0], c[1]); w.w = cvt_pk_bf16(c[2], c[3]);
                        *(u32x4*)(xs + off) = w; }
                }
                if (has_next) { ss += __shfl_xor(ss, 16); ss += __shfl_xor(ss, 32); if (fq == 0) atomicAdd(ssq_next + row, ss); }
            }
        }
    }
};

struct EpiOutFinal {
    static constexpr bool PERM = true, AFTER_DRAIN = true;
    const float* xin; float* out; const float* gate; const float* fg; float* xch; unsigned* cnt;
    __device__ __forceinline__ void fused(f32x4 (&acc)[2][2][4][2], const Unit& u, int wr, int wc, int fr, int fq, PG8_LAS unsigned char* lds, int wid, int lane) const {
        PG8_LAS float* P = (PG8_LAS float*)lds; PG8_LAS float* S = (PG8_LAS float*)(lds + 4096);
        const int row0 = u.pm * BM + wr * 64 + fr, b = u.pm >> 3, c0 = u.pn * BM + wc * 32 + 8 * fq;
        f32x4 gt[2][2];
#pragma unroll
        for (int bj = 0; bj < 2; ++bj)
#pragma unroll
            for (int n = 0; n < 2; ++n) gt[bj][n] = *(const f32x4*)(gate + (size_t)b * 3072 + c0 + bj * HALF + 4 * n);
#pragma unroll
        for (int aq = 0; aq < 4; ++aq) { const int ai = aq >> 1, mb = (aq & 1) * 2;
            f32x4 xv[4][2][2];
#pragma unroll
            for (int m = mb; m < mb + 2; ++m)
#pragma unroll
                for (int bj = 0; bj < 2; ++bj) { const size_t off = (size_t)(row0 + ai * HALF + m * 16) * 1024 + c0 + bj * HALF; xv[m][bj][0] = *(const f32x4*)(xin + off); xv[m][bj][1] = *(const f32x4*)(xin + off + 4); }
#pragma unroll
            for (int m = mb; m < mb + 2; ++m) { const int row = row0 + ai * HALF + m * 16; float ss = 0.f;
#pragma unroll
                for (int bj = 0; bj < 2; ++bj) {
                    const f32x4 n0 = xv[m][bj][0] + gt[bj][0] * acc[ai][bj][m][0], n1 = xv[m][bj][1] + gt[bj][1] * acc[ai][bj][m][1];
                    acc[ai][bj][m][0] = n0; acc[ai][bj][m][1] = n1;
                    ss += (n0[0] * n0[0] + n0[1] * n0[1]) + (n0[2] * n0[2] + n0[3] * n0[3]) + (n1[0] * n1[0] + n1[1] * n1[1]) + (n1[2] * n1[2] + n1[3] * n1[3]); }
                ss += __shfl_xor(ss, 16); ss += __shfl_xor(ss, 32);
                if (fq == 0) P[(ai * HALF + wr * 64 + m * 16 + fr) * 4 + wc] = ss; } }
        asm volatile("s_waitcnt lgkmcnt(0)" ::: "memory"); __builtin_amdgcn_s_barrier(); asm volatile("" ::: "memory");
        const int row = wid * 32 + (lane & 31);
        if (lane < 32) { const float t = (P[row * 4 + 0] + P[row * 4 + 1]) + (P[row * 4 + 2] + P[row * 4 + 3]);
            __hip_atomic_store(xch + (size_t)(u.pm * BM + row) * 4 + u.pn, t, __ATOMIC_RELAXED, __HIP_MEMORY_SCOPE_AGENT); }
        asm volatile("s_waitcnt vmcnt(0)" ::: "memory");
        if (lane == 0) __hip_atomic_fetch_add(cnt + 64 * u.pm, 1u, __ATOMIC_RELAXED, __HIP_MEMORY_SCOPE_AGENT);
        if (wid == 0) { unsigned spins = 0;
            while ((unsigned)__builtin_amdgcn_readfirstlane(__hip_atomic_load(cnt + 64 * u.pm, __ATOMIC_RELAXED, __HIP_MEMORY_SCOPE_AGENT)) < 32u) { __builtin_amdgcn_s_sleep(2); if (++spins > (1u << 22)) break; }
            __builtin_amdgcn_fence(__ATOMIC_ACQUIRE, "agent"); }
        asm volatile("s_waitcnt vmcnt(0) lgkmcnt(0)" ::: "memory"); __builtin_amdgcn_s_barrier(); asm volatile("" ::: "memory");
        if (lane < 32) { const float* slot = xch + (size_t)(u.pm * BM + row) * 4; float tot = 0.f;
#pragma unroll
            for (int t = 0; t < 4; ++t) tot += __hip_atomic_load(slot + t, __ATOMIC_RELAXED, __HIP_MEMORY_SCOPE_AGENT);
            S[row] = rsqrtf(tot * (1.f / 1024.f) + nv::EPS); }
        asm volatile("s_waitcnt vmcnt(0) lgkmcnt(0)" ::: "memory"); __builtin_amdgcn_s_barrier(); asm volatile("" ::: "memory");
        f32x4 gv[2][2];
#pragma unroll
        for (int bj = 0; bj < 2; ++bj)
#pragma unroll
            for (int n = 0; n < 2; ++n) gv[bj][n] = *(const f32x4*)(fg + c0 + bj * HALF + 4 * n);
#pragma unroll
        for (int ai = 0; ai < 2; ++ai)
#pragma unroll
            for (int m = 0; m < 4; ++m) { const int r = ai * HALF + wr * 64 + m * 16 + fr; const float rs = S[r]; const size_t off = (size_t)(u.pm * BM + r) * 1024 + c0;
#pragma unroll
                for (int bj = 0; bj < 2; ++bj) { *(f32x4*)(out + off + bj * HALF) = acc[ai][bj][m][0] * rs * gv[bj][0]; *(f32x4*)(out + off + bj * HALF + 4) = acc[ai][bj][m][1] * rs * gv[bj][1]; } }
    }
};

template <class Epi, class Sched, bool ALIGN_EPI = false, bool SP2 = false>
__device__ __forceinline__ void gemm_phase(PG8_LAS unsigned char* lds, const Gemm g, const Sched& S, const Epi& E, int wv) {
    int tid_ = wv * 64 + (int)__builtin_amdgcn_mbcnt_hi(~0u, __builtin_amdgcn_mbcnt_lo(~0u, 0u)); asm volatile("" : "+v"(tid_));
    const int tid = tid_, wid = __builtin_amdgcn_readfirstlane(tid >> 6), lane = tid & 63, wr = wid >> 2, wc = wid & 3, fr = lane & 15, fq = lane >> 4;
    const int K = g.K, nt = K / BK;
    unsigned voffA[2], voffB[2];
#pragma unroll
    for (int i = 0; i < 2; ++i) { int R, C; stage_rc(tid * 16 + i * 8192, R, C); const int Rb = Epi::PERM ? ((R & ~31) + perm32(R & 31)) : R;
        voffA[i] = (unsigned)(R * K + C) * 2u; voffB[i] = (unsigned)(Rb * K + C) * 2u; }
    const size_t kstep = (size_t)(BK * 2);
    const size_t hstep = (size_t)HALF * K * 2;
    const size_t tstep = 2 * hstep;
    const unsigned ldsw = (unsigned)wid * 1024u;
    const int aoff = lds_byte(wr * 64 + fr, fq * 8), boff = lds_byte(wc * 32 + fr, fq * 8);
#define PG8_SA(b, h) (((b) * 2 + (h)) * HTB)
#define PG8_SB(b, h) ((4 + (b) * 2 + (h)) * HTB)
#define PG8_STAGE(bufoff, gbase, voff) do { _Pragma("unroll") for (int _i = 0; _i < 2; ++_i) \
        __builtin_amdgcn_global_load_lds((const unsigned*)((const char*)(gbase) + (voff)[_i]), (PG8_LAS unsigned*)(lds + (bufoff) + ldsw + _i * 8192), 16, 0, 0); } while (0)
#define PG8_LDA(dst, b, h) do { _Pragma("unroll") for (int m = 0; m < 4; ++m) _Pragma("unroll") for (int k = 0; k < 2; ++k) dst[m][k] = *(const PG8_LAS bf16x8*)(lds + PG8_SA(b, h) + aoff + m * 2048 + k * 1024); } while (0)
#define PG8_LDB(dst, b, h) do { _Pragma("unroll") for (int n = 0; n < 2; ++n) _Pragma("unroll") for (int k = 0; k < 2; ++k) dst[n][k] = *(const PG8_LAS bf16x8*)(lds + PG8_SB(b, h) + boff + n * 2048 + k * 1024); } while (0)
#define PG8_MMA(ai, bj, At, Bt) do { __builtin_amdgcn_s_setprio(1); _Pragma("unroll") for (int m = 0; m < 4; ++m) _Pragma("unroll") for (int n = 0; n < 2; ++n) _Pragma("unroll") for (int k = 0; k < 2; ++k) \
        acc[ai][bj][m][n] = __builtin_amdgcn_mfma_f32_16x16x32_bf16(Bt[n][k], At[m][k], acc[ai][bj][m][n], 0, 0, 0); __builtin_amdgcn_s_setprio(0); } while (0)
#define PG8_WAIT_V(n) asm volatile("s_waitcnt vmcnt(" #n ")" ::: "memory")
#define PG8_WAIT_L(n) asm volatile("s_waitcnt lgkmcnt(" #n ")" ::: "memory")
#define PG8_BAR __builtin_amdgcn_s_barrier()
#define PG8_SCHED __builtin_amdgcn_sched_barrier(0)
    Unit cur, nxt; int ui = 0;
    if (!S.next(0, cur)) return;
    f32x4 acc[2][2][4][2];
#pragma unroll
    for (int a = 0; a < 2; ++a)
#pragma unroll
        for (int b = 0; b < 2; ++b)
#pragma unroll
            for (int m = 0; m < 4; ++m)
#pragma unroll
                for (int n = 0; n < 2; ++n) acc[a][b][m][n] = (f32x4){0.f, 0.f, 0.f, 0.f};
    bf16x8 At[4][2], B0[2][2], B1[2][2];
    const char* cA = (const char*)g.A + (size_t)cur.pm * tstep; const char* cB = (const char*)g.Bt + (size_t)cur.pn * tstep;
    S.a_ready(cur);
    if constexpr (SP2) {
        PG8_STAGE(PG8_SB(0, 0), cB, voffB); PG8_STAGE(PG8_SB(0, 1), cB + hstep, voffB); PG8_STAGE(PG8_SA(0, 0), cA, voffA); PG8_STAGE(PG8_SA(0, 1), cA + hstep, voffA);
        if (wr == 1) PG8_BAR;
        PG8_WAIT_V(2); PG8_BAR;
        PG8_STAGE(PG8_SB(1, 0), cB + kstep, voffB); PG8_STAGE(PG8_SA(1, 0), cA + kstep, voffA); PG8_STAGE(PG8_SB(1, 1), cB + hstep + kstep, voffB);
        PG8_WAIT_V(6); PG8_BAR;
    } else {
        PG8_STAGE(PG8_SB(0, 0), cB, voffB); PG8_STAGE(PG8_SA(0, 0), cA, voffA); PG8_STAGE(PG8_SB(0, 1), cB + hstep, voffB); PG8_STAGE(PG8_SA(0, 1), cA + hstep, voffA);
        if (wr == 1) PG8_BAR;
        PG8_WAIT_V(4); PG8_BAR;
        PG8_STAGE(PG8_SB(1, 0), cB + kstep, voffB); PG8_STAGE(PG8_SA(1, 0), cA + kstep, voffA); PG8_STAGE(PG8_SB(1, 1), cB + hstep + kstep, voffB);
        PG8_WAIT_V(6); PG8_BAR;
    }
    for (;;) {
        const bool has_next = S.next(ui + 1, nxt);
        const char* nA = has_next ? (const char*)g.A + (size_t)nxt.pm * tstep : cA; const char* nB = has_next ? (const char*)g.Bt + (size_t)nxt.pn * tstep : cB;
        for (int t = 0; t < nt; t += 2) {
            const bool last = (t == nt - 2);
            const char* a1 = cA + (size_t)(t + 1) * kstep;
            const char* a2 = last ? nA : cA + (size_t)(t + 2) * kstep; const char* b2 = last ? nB : cB + (size_t)(t + 2) * kstep;
            const char* a3 = a2 + kstep; const char* b3 = b2 + kstep;
            if (last && has_next) S.a_ready(nxt);
            if constexpr (SP2) {
            PG8_LDB(B0, 0, 0); PG8_LDB(B1, 0, 1); PG8_SCHED; PG8_LDA(At, 0, 0); PG8_STAGE(PG8_SA(1, 1), a1 + hstep, voffA);
            PG8_WAIT_V(8); PG8_WAIT_L(0); PG8_BAR; PG8_MMA(0, 0, At, B0); PG8_MMA(0, 1, At, B1); PG8_BAR; PG8_SCHED;
            PG8_LDA(At, 0, 1); PG8_STAGE(PG8_SB(0, 0), b2, voffB); PG8_STAGE(PG8_SB(0, 1), b2 + hstep, voffB); PG8_STAGE(PG8_SA(0, 0), a2, voffA);
            PG8_WAIT_V(8); PG8_WAIT_L(0); PG8_BAR; PG8_MMA(1, 0, At, B0); PG8_MMA(1, 1, At, B1); PG8_BAR; PG8_SCHED;
            PG8_LDB(B0, 1, 0); PG8_LDB(B1, 1, 1); PG8_SCHED; PG8_LDA(At, 1, 0); PG8_STAGE(PG8_SA(0, 1), a2 + hstep, voffA);
            PG8_WAIT_V(8); PG8_WAIT_L(0); PG8_BAR; PG8_MMA(0, 0, At, B0); PG8_MMA(0, 1, At, B1); PG8_BAR; PG8_SCHED;
            PG8_LDA(At, 1, 1); PG8_STAGE(PG8_SB(1, 0), b3, voffB); PG8_STAGE(PG8_SB(1, 1), b3 + hstep, voffB); PG8_STAGE(PG8_SA(1, 0), a3, voffA);
            PG8_WAIT_V(8); PG8_WAIT_L(0); PG8_BAR; PG8_MMA(1, 0, At, B0); PG8_MMA(1, 1, At, B1); PG8_BAR; PG8_SCHED;
            } else {
            PG8_LDB(B0, 0, 0); PG8_SCHED; PG8_LDA(At, 0, 0); PG8_STAGE(PG8_SA(1, 1), a1 + hstep, voffA);
            PG8_WAIT_L(8); PG8_BAR; PG8_WAIT_L(0); PG8_MMA(0, 0, At, B0); PG8_BAR; PG8_SCHED;
            PG8_LDB(B1, 0, 1); PG8_STAGE(PG8_SB(0, 0), b2, voffB);
            PG8_BAR; PG8_WAIT_L(0); PG8_MMA(0, 1, At, B1); PG8_BAR;
            PG8_LDA(At, 0, 1); PG8_STAGE(PG8_SA(0, 0), a2, voffA);
            PG8_BAR; PG8_WAIT_L(0); PG8_MMA(1, 0, At, B0); PG8_BAR; PG8_SCHED;
            PG8_STAGE(PG8_SB(0, 1), b2 + hstep, voffB);
            PG8_WAIT_V(6); PG8_BAR; PG8_MMA(1, 1, At, B1); PG8_BAR;
            PG8_LDB(B0, 1, 0); PG8_SCHED; PG8_LDA(At, 1, 0); PG8_STAGE(PG8_SA(0, 1), a2 + hstep, voffA);
            PG8_WAIT_L(8); PG8_BAR; PG8_WAIT_L(0); PG8_MMA(0, 0, At, B0); PG8_BAR; PG8_SCHED;
            PG8_LDB(B1, 1, 1); PG8_STAGE(PG8_SB(1, 0), b3, voffB);
            PG8_BAR; PG8_WAIT_L(0); PG8_MMA(0, 1, At, B1); PG8_BAR;
            PG8_LDA(At, 1, 1); PG8_STAGE(PG8_SA(1, 0), a3, voffA);
            PG8_BAR; PG8_WAIT_L(0); PG8_MMA(1, 0, At, B0); PG8_BAR; PG8_SCHED;
            PG8_STAGE(PG8_SB(1, 1), b3 + hstep, voffB);
            PG8_WAIT_V(6); PG8_BAR; PG8_MMA(1, 1, At, B1); PG8_BAR;
            }
        }
        if constexpr (ALIGN_EPI) { if (wr == 0) PG8_BAR; }
        if constexpr (!Epi::AFTER_DRAIN) { E(acc, cur, wr, wc, fr, fq); S.done(cur); if constexpr (has_hook<Sched>::v) S.after(ui, lane); }
        if (!has_next) break;
#pragma unroll
        for (int a = 0; a < 2; ++a)
#pragma unroll
            for (int b = 0; b < 2; ++b)
#pragma unroll
                for (int m = 0; m < 4; ++m)
#pragma unroll
                    for (int n = 0; n < 2; ++n) acc[a][b][m][n] = (f32x4){0.f, 0.f, 0.f, 0.f};
        cur = nxt; cA = nA; cB = nB; ++ui;
        if constexpr (ALIGN_EPI) { if (wr == 1) PG8_BAR; }
    }
    PG8_WAIT_V(0);
    if constexpr (!ALIGN_EPI) { if (wr == 0) PG8_BAR; }
    PG8_BAR;
    if constexpr (Epi::AFTER_DRAIN) { E.fused(acc, cur, wr, wc, fr, fq, lds, wid, lane); S.done(cur); }
#undef PG8_SA
#undef PG8_SB
#undef PG8_STAGE
#undef PG8_LDA
#undef PG8_LDB
#undef PG8_MMA
#undef PG8_WAIT_V
#undef PG8_WAIT_L
#undef PG8_BAR
#undef PG8_SCHED
}
}

namespace mk {
using nv::pi16; using nv::bf16; using nv::S_; using nv::D_; using nv::M_; using nv::LOG2E; using nv::QSCALE; using nv::EPS;
#define GAS __attribute__((address_space(1)))
#define LAS __attribute__((address_space(3)))
typedef unsigned v4u __attribute__((ext_vector_type(4)));
typedef unsigned v2u __attribute__((ext_vector_type(2)));
typedef float f32x4 __attribute__((ext_vector_type(4)));
constexpr int NWAVES = 8;
using namespace lay;
constexpr int RING_BYTES = 131072, LDSCTL_OFF = RING_BYTES, MISC_OFF = LDSCTL_OFF + 320, LDS_BYTES = 147456;

#define RLX_AGENT __ATOMIC_RELAXED, __HIP_MEMORY_SCOPE_AGENT
#define LDS_WAIT() asm volatile("s_waitcnt lgkmcnt(0)" ::: "memory")
#define VM_WAIT() asm volatile("s_waitcnt vmcnt(0)" ::: "memory")
__device__ __forceinline__ unsigned f2bfu(float f) { unsigned u = __builtin_bit_cast(unsigned, f); return (u + 0x7fffu + ((u >> 16) & 1u)) >> 16; }
__device__ __forceinline__ unsigned pk2(float lo, float hi) { return f2bfu(lo) | (f2bfu(hi) << 16); }
__device__ __forceinline__ float wsum(float v) {
#pragma unroll
    for (int o = 1; o < 64; o <<= 1) v += __shfl_xor(v, o);
    return v; }
__device__ __forceinline__ float silu_f(float x) { return x * __builtin_amdgcn_rcpf(1.f + __builtin_amdgcn_exp2f(-x * LOG2E)); }

#define XB_TMO      128
#define XB_XCNT(j)  (256  + 64 * (j))
#define XB_XSUB(j)  (1280 + 64 * (j))
#define XB_XGEN(j)  (2304 + 64 * (j))
#define XB_TOP      3328
#define XB_TOPGEN   3392
#define XCD_BAR_WORDS 3456
#define XB_SPIN_CAP (1u << 18)

__device__ __forceinline__ unsigned xb_ld(unsigned* p)              { return __hip_atomic_load(p, __ATOMIC_RELAXED, __HIP_MEMORY_SCOPE_AGENT); }
__device__ __forceinline__ unsigned xb_add(unsigned* p, unsigned v) { return __hip_atomic_fetch_add(p, v, __ATOMIC_RELAXED, __HIP_MEMORY_SCOPE_AGENT); }
__device__ __forceinline__ unsigned xb_xcc_id() { return (unsigned)__builtin_amdgcn_s_getreg((3 << 11) | 20) & 0xFu; }
#define XB_SPIN(cond, bar) do { unsigned _sp = 0; while (cond) { __builtin_amdgcn_s_sleep(1); \
    if ((++_sp & 255u) == 0u) { if (xb_ld(&(bar)[XB_TMO])) break; if (_sp > XB_SPIN_CAP) { atomicAdd(&(bar)[XB_TMO], 1u); break; } } } } while (0)

__device__ __forceinline__ bool wg_leader(int wave) { return wave == 0 && __builtin_amdgcn_mbcnt_hi(~0u, __builtin_amdgcn_mbcnt_lo(~0u, 0u)) == 0u; }
struct XcdBarrier {
    int wave;
    unsigned* bar; unsigned x;
    volatile LAS unsigned* st;
};

__device__ __forceinline__ XcdBarrier xcd_barrier_post(unsigned* bar, volatile LAS unsigned* st, int wave) {
    XcdBarrier b; b.wave = wave; b.bar = bar; b.x = xb_xcc_id(); b.st = st;
    if (wg_leader(wave)) (void)xb_add(&bar[XB_XCNT(b.x)], 1u);
    return b;
}
__device__ __forceinline__ void xcd_barrier_complete(unsigned* bar, unsigned x, unsigned& nloc, unsigned& nx) {
    const unsigned G = gridDim.x * gridDim.y * gridDim.z;
    unsigned sum, cnt, mine, sp = 0u;
    for (;;) {
        sum = 0u; cnt = 0u; mine = 0u;
#pragma unroll
        for (unsigned j = 0; j < 16; ++j) { const unsigned c = xb_ld(&bar[XB_XCNT(j)]); sum += c; cnt += (c > 0u) ? 1u : 0u; mine = (j == x) ? c : mine; }
        if (sum == G) break;
        __builtin_amdgcn_s_sleep(1);
        if ((++sp & 255u) == 0u) { if (xb_ld(&bar[XB_TMO])) break; if (sp > XB_SPIN_CAP) { atomicAdd(&bar[XB_TMO], 1u); break; } }
    }
    nloc = mine > 0u ? mine : 1u; nx = cnt > 0u ? cnt : 1u;
}

__device__ __forceinline__ void xcd_barrier(const XcdBarrier& b) {
    asm volatile("s_waitcnt vmcnt(0)" ::: "memory");
    __syncthreads();
    if (wg_leader(b.wave)) {
        unsigned* bar = b.bar;
        __builtin_amdgcn_s_waitcnt(0);
        unsigned nloc = b.st[0], nx = b.st[1];
        if (nloc == 0u) { xcd_barrier_complete(bar, b.x, nloc, nx); b.st[0] = nloc; b.st[1] = nx; }
        const unsigned old = xb_add(&bar[XB_XSUB(b.x)], 1u);
        const unsigned gen = old / nloc;
        if (old + 1u == (gen + 1u) * nloc) {
            __builtin_amdgcn_fence(__ATOMIC_RELEASE, "agent");
            asm volatile("s_waitcnt vmcnt(0)" ::: "memory");
            const unsigned og = xb_add(&bar[XB_TOP], 1u);
            const unsigned tg = og / nx;
            if (og + 1u == (tg + 1u) * nx) xb_add(&bar[XB_TOPGEN], 1u);
            else XB_SPIN(xb_ld(&bar[XB_TOPGEN]) == tg, bar);
            __builtin_amdgcn_fence(__ATOMIC_ACQUIRE, "agent");
            xb_add(&bar[XB_XGEN(b.x)], 1u);
            asm volatile("s_waitcnt vmcnt(0)" ::: "memory");
        } else {
            XB_SPIN(xb_ld(&bar[XB_XGEN(b.x)]) == gen, bar);
            __builtin_amdgcn_fence(__ATOMIC_ACQUIRE, "agent");
            asm volatile("s_waitcnt vmcnt(0)" ::: "memory");
        }
    }
    __syncthreads();
}


__device__ __forceinline__ void p0_transpose_item(const float* W, int K, int N, bf16* WT, LAS float* scr, int item, int lane) {
    const int nblk = N / 32, kb = item / nblk, nb = item % nblk, k0 = 64 * kb, n0 = 32 * nb;
#pragma unroll 8
    for (int i = 0; i < 32; ++i) { const int kk = 2 * i + (lane >> 5); scr[kk * 33 + (lane & 31)] = W[(size_t)(k0 + kk) * N + n0 + (lane & 31)]; }
    LDS_WAIT(); asm volatile("" ::: "memory");
    const int c = lane & 7;
#pragma unroll
    for (int j = 0; j < 4; ++j) { const int n = (lane >> 3) + 8 * j; const LAS float* s = scr + (8 * c) * 33 + n;
        v4u o; o.x = pk2(s[0 * 33], s[1 * 33]); o.y = pk2(s[2 * 33], s[3 * 33]); o.z = pk2(s[4 * 33], s[5 * 33]); o.w = pk2(s[6 * 33], s[7 * 33]);
        *(GAS v4u*)(WT + (size_t)(n0 + n) * K + k0 + 8 * c) = o; }
    LDS_WAIT(); asm volatile("" ::: "memory");
}
__device__ __forceinline__ void gemv8_item(const float* W, int ldw, int n0, const LAS float* vec, LAS float* red, const float* bias, float* out, int ldo, int wave, int lane) {
    float acc[8];
#pragma unroll
    for (int b = 0; b < 8; ++b) acc[b] = 0.f;
    const float* wp = W + (size_t)(wave * 128) * ldw + n0 + lane;
#pragma unroll 8
    for (int kk = 0; kk < 128; ++kk) { const float w = wp[(size_t)kk * ldw]; const int k = wave * 128 + kk;
#pragma unroll
        for (int b = 0; b < 8; ++b) acc[b] += vec[b * 1024 + k] * w; }
#pragma unroll
    for (int b = 0; b < 8; ++b) red[(wave * 8 + b) * 64 + lane] = acc[b];
    __syncthreads();
    { float s = 0.f;
#pragma unroll
      for (int w = 0; w < 8; ++w) s += red[(w * 8 + wave) * 64 + lane];
      out[(size_t)wave * ldo + n0 + lane] = s + (bias ? bias[n0 + lane] : 0.f); }
    __syncthreads();
}

typedef short bf16x8 __attribute__((ext_vector_type(8)));
typedef short s16x4 __attribute__((ext_vector_type(4)));
typedef short v4i16_t __attribute__((ext_vector_type(4)));
typedef float f32x16 __attribute__((ext_vector_type(16)));
constexpr float NEGBIG = -1e30f;
constexpr float THR = 8.f;
__device__ __forceinline__ int crow(int r, int hi) { return (r & 3) + 8 * (r >> 2) + 4 * hi; }
__device__ __forceinline__ unsigned cvtpk_c(float lo, float hi) { typedef float f2_t __attribute__((ext_vector_type(2))); typedef __bf16 b2_t __attribute__((ext_vector_type(2)));
    f2_t v = {lo, hi}; b2_t bb = __builtin_convertvector(v, b2_t); return __builtin_bit_cast(unsigned, bb); }
__device__ __forceinline__ float swapmax(float v) { auto rr = __builtin_amdgcn_permlane32_swap(__float_as_uint(v), __float_as_uint(v), false, false); return fmaxf(__uint_as_float(rr[0]), __uint_as_float(rr[1])); }
__device__ __forceinline__ float swapsum(float v) { auto rr = __builtin_amdgcn_permlane32_swap(__float_as_uint(v), __float_as_uint(v), false, false); return __uint_as_float(rr[0]) + __uint_as_float(rr[1]); }
__device__ __forceinline__ s16x4 vtr(const LAS char* p) { return __builtin_bit_cast(s16x4, __builtin_amdgcn_ds_read_tr16_b64_v4i16((LAS v4i16_t*)p)); }
__device__ __forceinline__ float max3(float a, float b, float c) { return fmaxf(fmaxf(a, b), c); }
__device__ __forceinline__ float rowmax16(const f32x16& p) {
    const float a = max3(p[0], p[1], p[2]), b = max3(p[3], p[4], p[5]), c = max3(p[6], p[7], p[8]), d = max3(p[9], p[10], p[11]), e = max3(p[12], p[13], p[14]);
    return max3(max3(a, b, c), max3(d, e, p[15]), a); }
__device__ __forceinline__ float rowsum16(const f32x16& p) {
    typedef float f2v __attribute__((ext_vector_type(2)));
    const f2v a = (f2v){p[0], p[1]} + (f2v){p[2], p[3]}, b = (f2v){p[4], p[5]} + (f2v){p[6], p[7]}, c = (f2v){p[8], p[9]} + (f2v){p[10], p[11]}, d = (f2v){p[12], p[13]} + (f2v){p[14], p[15]};
    const f2v e = (a + b) + (c + d); return e.x + e.y; }
__device__ __forceinline__ float rowsum32(const f32x16& p, const f32x16& q) {
    typedef float f2v __attribute__((ext_vector_type(2)));
    f2v a = (f2v){p[0], p[1]} + (f2v){q[0], q[1]};
#pragma unroll
    for (int i = 1; i < 8; ++i) a = a + ((f2v){p[2 * i], p[2 * i + 1]} + (f2v){q[2 * i], q[2 * i + 1]});
    return a.x + a.y; }
__device__ __forceinline__ void glds16(const void* gsrc, LAS unsigned char* dst_uniform) {
    __builtin_amdgcn_global_load_lds((const unsigned*)gsrc, (LAS unsigned*)dst_uniform, 16, 0, 0);
}
__device__ __forceinline__ void glds16_asm_s(unsigned voff, const void* sbase_uniform, unsigned lds_dst_uniform) { unsigned keep;
    asm volatile("s_mov_b32 %0, m0\n\ts_mov_b32 m0, %3\n\ts_nop 0\n\tglobal_load_lds_dwordx4 %1, %2\n\ts_mov_b32 m0, %0" : "=&s"(keep) : "v"(voff), "s"(sbase_uniform), "s"(lds_dst_uniform) : "memory"); }

template <int DV> struct WState { bf16x8 qr[4]; f32x16 o[DV / 32]; float m, l; };
__device__ __forceinline__ void q_fetch(bf16x8 (&q)[4], const bf16* qrow  ) {
#pragma unroll
    for (int d0 = 0; d0 < 4; ++d0) q[d0] = *(const bf16x8*)(qrow + d0 * 16);
}
template <int DV> __device__ __forceinline__ void w_begin(WState<DV>& w, const bf16x8 (&q)[4]) {
#pragma unroll
    for (int d0 = 0; d0 < 4; ++d0) { w.qr[d0] = q[d0]; asm volatile("" : "+v"(w.qr[d0])); }
#pragma unroll
    for (int d = 0; d < DV / 32; ++d)
#pragma unroll
        for (int r = 0; r < 16; ++r) w.o[d][r] = 0.f;
    w.m = 0.f; w.l = 0.f;
}
__device__ __forceinline__ int v_rd_base(int lane) { return ((lane >> 4) & 1) * 32 + (lane & 3) * 8 + (4 * (lane >> 5) + ((lane & 15) >> 2)) * 64; }
constexpr int VHI = 512;
#define PK4(P, BASE, OUT) do { v4u wv = {cvtpk_c(P[BASE + 0], P[BASE + 1]), cvtpk_c(P[BASE + 2], P[BASE + 3]), cvtpk_c(P[BASE + 4], P[BASE + 5]), cvtpk_c(P[BASE + 6], P[BASE + 7])}; \
    OUT = __builtin_bit_cast(bf16x8, wv); } while (0)
typedef float f2_t __attribute__((ext_vector_type(2)));
#define P2_(p, i) ((f2_t){p[2 * (i)], p[2 * (i) + 1]})

template <int DV, bool FIRST, class MaskF>
__device__ __forceinline__ void step32(WState<DV>& w, const LAS char* kb, const LAS char* vb, const f32x16& R, float doff, bool mixed, MaskF mf, int lane) {
    const int r32 = lane & 31, hi = lane >> 5;
    f32x16 p; const float mref = FIRST ? 0.f : w.m;
    if (!mixed) { const float sgn = doff > 0.f ? -1.f : 1.f, add = -fabsf(doff) - mref;
#pragma unroll
        for (int i = 0; i < 8; ++i) { const f2_t v = P2_(R, i) * sgn + add; p[2 * i] = v.x; p[2 * i + 1] = v.y; } }
    else {
#pragma unroll
        for (int r = 0; r < 16; ++r) p[r] = -fabsf(R[r] + doff) - mref; }
    { const LAS char* krow = kb + r32 * 128; const int ksw = (r32 >> 1) & 7;
      bf16x8 kf[4];
#pragma unroll
      for (int d0 = 0; d0 < 4; ++d0) kf[d0] = *(const LAS bf16x8*)(krow + (((2 * d0 + hi) ^ ksw) << 4));
#pragma unroll
      for (int d0 = 0; d0 < 4; ++d0) p = __builtin_amdgcn_mfma_f32_32x32x16_bf16(kf[d0], w.qr[d0], p, 0, 0, 0); }
    if (mf.on) mf(p);
    const float pmax = swapmax(rowmax16(p));
    if (FIRST) { w.m = pmax;
#pragma unroll
        for (int r = 0; r < 16; ++r) p[r] -= pmax; }
    else if (__any(pmax > THR)) { const float inc = pmax > THR ? pmax : 0.f, alpha = __builtin_amdgcn_exp2f(-inc); w.m += inc; w.l *= alpha;
#pragma unroll
        for (int r = 0; r < 16; ++r) p[r] -= inc;
#pragma unroll
        for (int d = 0; d < DV / 32; ++d)
#pragma unroll
            for (int r = 0; r < 16; ++r) w.o[d][r] *= alpha; }
#pragma unroll
    for (int r = 0; r < 16; ++r) p[r] = __builtin_amdgcn_exp2f(p[r]);
    w.l += swapsum(rowsum16(p));
    bf16x8 pa0, pa1; PK4(p, 0, pa0); PK4(p, 8, pa1);
    const LAS char* vbase = vb + v_rd_base(lane);
#pragma unroll
    for (int d = 0; d < DV / 32; ++d) {
        const s16x4 l0 = vtr(vbase + d * 2048), h0 = vtr(vbase + d * 2048 + VHI), l1 = vtr(vbase + d * 2048 + 1024), h1 = vtr(vbase + d * 2048 + 1024 + VHI);
        const bf16x8 v0 = (bf16x8){l0[0], l0[1], l0[2], l0[3], h0[0], h0[1], h0[2], h0[3]}, v1 = (bf16x8){l1[0], l1[1], l1[2], l1[3], h1[0], h1[1], h1[2], h1[3]};
        w.o[d] = __builtin_amdgcn_mfma_f32_32x32x16_bf16(v0, pa0, w.o[d], 0, 0, 0);
        w.o[d] = __builtin_amdgcn_mfma_f32_32x32x16_bf16(v1, pa1, w.o[d], 0, 0, 0);
    }
}
struct NoMask { static constexpr bool on = false; __device__ __forceinline__ void operator()(f32x16&) const {} };

#define ROLE_OF(wave) ((wave) >> 2)
#define ATT_WAIT_BAR(N) asm volatile("s_waitcnt vmcnt(" #N ") lgkmcnt(0)\n\ts_barrier" ::: "memory")
__device__ __forceinline__ void diff_unit(LAS unsigned char* lds, int b, int h, int qt, const bf16* QB, const bf16* KB, const bf16* VB, const bf16* SG,
                                          const float* subln_g, float lam, float lam_init, bf16* YM, int wv) {
    int tid = wv * 64 + (int)__builtin_amdgcn_mbcnt_hi(~0u, __builtin_amdgcn_mbcnt_lo(~0u, 0u)); asm volatile("" : "+v"(tid));
    const int lane = tid & 63, wave = __builtin_amdgcn_readfirstlane(tid >> 6), r32 = lane & 31, hi = lane >> 5;
    const int which = wave >> 2, sub = wave & 3, q0 = qt * 128 + sub * 32;
    const float slope = __builtin_amdgcn_exp2f(-2.f * (float)(h + 1)) * LOG2E;
    const bf16* K1 = KB + (size_t)(b * 8 + h * 2) * S_ * 64; const bf16* Vh = VB + (size_t)(b * 4 + h) * S_ * 128;
    unsigned offK, offV0, offV1, dstK, dstV0, dstV1;
    { const int kkb = 8 * (wave & 3) + (lane >> 3), c = (lane & 7) ^ ((kkb >> 1) & 7);
      offK = (unsigned)((8 * wave + (lane >> 3)) * 64 + c * 8) * 2u; dstK = wave * 1024;
      const int v0 = wave, v1 = wave + 8;
      offV0 = (unsigned)((32 * (v0 >> 3) + 16 * (v0 & 1) + (lane >> 2)) * 128 + ((v0 >> 1) & 3) * 32 + (lane & 3) * 8) * 2u; dstV0 = 16384 + (v0 >> 3) * 8192 + ((v0 >> 1) & 3) * 2048 + (v0 & 1) * 1024;
      offV1 = (unsigned)((32 * (v1 >> 3) + 16 * (v1 & 1) + (lane >> 2)) * 128 + ((v1 >> 1) & 3) * 32 + (lane & 3) * 8) * 2u; dstV1 = 16384 + (v1 >> 3) * 8192 + ((v1 >> 1) & 3) * 2048 + (v1 & 1) * 1024; }
    const unsigned lds0 = (unsigned)(uintptr_t)lds;
    constexpr int NT = S_ / 64;
    const int tdb = 2 * qt;
#define TILE_OF(i) ((i) < 2 ? tdb + (i) : ((i) - 2 < tdb ? (i) - 2 : (i)))
#define RFL(x) ((unsigned)__builtin_amdgcn_readfirstlane((int)(x)))
#define DDMA(i) do { const int ii_ = (i) < NT ? (i) : NT - 1; const int ts_ = TILE_OF(ii_); const unsigned bb_ = RFL(lds0 + (unsigned)(((i) & 3) * 32768)); \
        const char* kb_ = (const char*)K1 + (size_t)ts_ * 8192; const char* vb_ = (const char*)Vh + (size_t)ts_ * 16384; \
        glds16_asm_s(offK, kb_, RFL(bb_ + dstK)); glds16_asm_s(offK, kb_ + (size_t)S_ * 128, RFL(bb_ + 8192u + dstK)); \
        glds16_asm_s(offV0, vb_, RFL(bb_ + dstV0)); glds16_asm_s(offV1, vb_, RFL(bb_ + dstV1)); } while (0)
    DDMA(0); DDMA(1);
    WState<128> w;
    { bf16x8 q[4]; q_fetch(q, QB + ((size_t)(b * 8 + h * 2 + which) * S_ + q0 + r32) * 64 + hi * 8); w_begin<128>(w, q); }
    const float basef = (float)(4 * hi - r32);
    f32x16 Tr;
#pragma unroll
    for (int r = 0; r < 16; ++r) Tr[r] = slope * (basef + 64.f + (float)((r & 3) + 8 * (r >> 2)));
    f32x16 p0, p1, e0, e1; bf16x8 pa0, pa1, pa2, pa3;
#define KB_(i) ((const LAS char*)(lds + ((i) & 3) * 32768) + which * 8192)
#define VB_(i) ((const LAS char*)(lds + ((i) & 3) * 32768) + 16384)
    struct F4 { bf16x8 a, b, c, d; };
    const int ksw = (r32 >> 1) & 7;
#define SB_() __builtin_amdgcn_sched_barrier(0)
#define CR_(r) ((float)(((r) & 3) + 8 * ((r) >> 2)))
#define CTILE(E, dk, MREF) do { const int dki_ = (dk); const float dk_ = (float)dki_; \
        if (dki_ >= 64)       { const float ad_ = -slope * (dk_ - 64.f) - (MREF); _Pragma("unroll") for (int i = 0; i < 8; ++i) { const f2_t v = ad_ - P2_(Tr, i); E[2 * i] = v.x; E[2 * i + 1] = v.y; } } \
        else if (dki_ <= -64) { const float ad_ = slope * (dk_ - 64.f) - (MREF); _Pragma("unroll") for (int i = 0; i < 8; ++i) { const f2_t v = ad_ + P2_(Tr, i); E[2 * i] = v.x; E[2 * i + 1] = v.y; } } \
        else { const float sb_ = slope * (dk_ - 64.f), mr_ = (MREF); _Pragma("unroll") for (int r = 0; r < 16; ++r) E[r] = -fabsf(Tr[r] + sb_) - mr_; } } while (0)
#define VF_(P) (bf16x8){lo_[0], lo_[1], lo_[2], lo_[3], hi_[0], hi_[1], hi_[2], hi_[3]}
#define LDV1(DST, OFF) do { const s16x4 lo_ = vtr(vbp + (OFF)), hi_ = vtr(vbp + (OFF) + VHI); DST = VF_(0); } while (0)
#define LOADV(F, DI) do { LDV1(F.a, (DI) * 2048); LDV1(F.b, (DI) * 2048 + 1024); LDV1(F.c, 8192 + (DI) * 2048); LDV1(F.d, 8192 + (DI) * 2048 + 1024); } while (0)
#define KCO_(d0) (((2 * (d0) + hi) ^ ksw) << 4)
#define LOADK(F, dp) do { F.a = *(const LAS bf16x8*)(kbp + KCO_(2 * (dp))); F.b = *(const LAS bf16x8*)(kbp + 4096 + KCO_(2 * (dp))); \
        F.c = *(const LAS bf16x8*)(kbp + KCO_(2 * (dp) + 1)); F.d = *(const LAS bf16x8*)(kbp + 4096 + KCO_(2 * (dp) + 1)); } while (0)
#define PVM(F, DI) do { w.o[DI] = __builtin_amdgcn_mfma_f32_32x32x16_bf16(F.a, pa0, w.o[DI], 0, 0, 0); w.o[DI] = __builtin_amdgcn_mfma_f32_32x32x16_bf16(F.b, pa1, w.o[DI], 0, 0, 0); \
        w.o[DI] = __builtin_amdgcn_mfma_f32_32x32x16_bf16(F.c, pa2, w.o[DI], 0, 0, 0); w.o[DI] = __builtin_amdgcn_mfma_f32_32x32x16_bf16(F.d, pa3, w.o[DI], 0, 0, 0); } while (0)
#define QKM(F, dp, C0, C1) do { p0 = __builtin_amdgcn_mfma_f32_32x32x16_bf16(F.a, w.qr[2 * (dp)], C0, 0, 0, 0); p1 = __builtin_amdgcn_mfma_f32_32x32x16_bf16(F.b, w.qr[2 * (dp)], C1, 0, 0, 0); \
        p0 = __builtin_amdgcn_mfma_f32_32x32x16_bf16(F.c, w.qr[2 * (dp) + 1], p0, 0, 0, 0); p1 = __builtin_amdgcn_mfma_f32_32x32x16_bf16(F.d, w.qr[2 * (dp) + 1], p1, 0, 0, 0); } while (0)
#define SOFTMAX_SEG(FIRST_, inext, icur) do { const float pmax = swapmax(fmaxf(rowmax16(p0), rowmax16(p1))); skp = !(FIRST_) && __all(pmax < SKIP_BELOW); \
        if (!skp) { \
        if (FIRST_) { w.m = pmax; _Pragma("unroll") for (int r = 0; r < 16; ++r) { p0[r] -= pmax; p1[r] -= pmax; } } \
        else if (__any(pmax > THR)) { const float inc = pmax > THR ? pmax : 0.f, alpha = __builtin_amdgcn_exp2f(-inc); w.m += inc; w.l *= alpha; \
            _Pragma("unroll") for (int r = 0; r < 16; ++r) { p0[r] -= inc; p1[r] -= inc; } \
            _Pragma("unroll") for (int dd = 0; dd < 4; ++dd) _Pragma("unroll") for (int r = 0; r < 16; ++r) w.o[dd][r] *= alpha; } \
        _Pragma("unroll") for (int r = 0; r < 16; ++r) { p0[r] = __builtin_amdgcn_exp2f(p0[r]); p1[r] = __builtin_amdgcn_exp2f(p1[r]); } \
        w.l += swapsum(rowsum32(p0, p1)); \
        PK4(p0, 0, pa0); PK4(p0, 8, pa1); PK4(p1, 0, pa2); PK4(p1, 8, pa3); \
        { const LAS char* vbp = VB_(icur) + v_rd_base(lane); LOADV(X, 0); LOADV(Y, 1); } }     \
        { const int tn_ = TILE_OF((inext) < NT ? (inext) : NT - 1); CTILE(e0, tn_ * 64 - q0, w.m); CTILE(e1, tn_ * 64 + 32 - q0, w.m); } } while (0)
    constexpr float SKIP_BELOW = -28.f; bool skp = false;
    CTILE(e0, tdb * 64 - q0, 0.f); CTILE(e1, tdb * 64 + 32 - q0, 0.f);
#define MSEG(i) do { const LAS char* vbp = VB_((i) - 1) + v_rd_base(lane); const LAS char* kbp = KB_(i) + r32 * 128; \
        if ((i) > 0 && !skp) { LOADV(Z, 2); PVM(X, 0); LOADV(X, 3); PVM(Y, 1); PVM(Z, 2); PVM(X, 3); } \
        LOADK(Y, 0); LOADK(Z, 1); QKM(Y, 0, e0, e1); QKM(Z, 1, p0, p1); } while (0)
    const int role = ROLE_OF(wave);
    F4 X, Y, Z;
    ATT_WAIT_BAR(4);
    DDMA(2);
    if (role == 0) {
        MSEG(0); SOFTMAX_SEG(true, 1, 0);
        ATT_WAIT_BAR(4);
#pragma unroll 1
        for (int i = 1; i < NT; ++i) { DDMA(i + 2); MSEG(i); SOFTMAX_SEG(false, i + 1, i); ATT_WAIT_BAR(4); }
    } else {
        MSEG(0);
        ATT_WAIT_BAR(4);
        DDMA(3); SOFTMAX_SEG(true, 1, 0); MSEG(1);
        ATT_WAIT_BAR(4);
#pragma unroll 1
        for (int i = 2; i < NT; ++i) { DDMA(i + 2); SOFTMAX_SEG(false, i, i - 1); MSEG(i); ATT_WAIT_BAR(4); }
        SOFTMAX_SEG(false, NT, NT - 1);
    }
    { const LAS char* vbp = VB_(NT - 1) + v_rd_base(lane);
      if (!skp) { LOADV(Z, 2); PVM(X, 0); LOADV(X, 3); PVM(Y, 1); PVM(Z, 2); PVM(X, 3); } }
#undef MSEG
#undef SOFTMAX_SEG
#undef QKM
#undef PVM
#undef LOADK
#undef KCO_
#undef LOADV
#undef LDV1
#undef VF_
#undef CTILE
#undef CR_
#undef SB_
    ATT_WAIT_BAR(0);
#undef DDMA
#undef RFL
#undef TILE_OF
#undef KB_
#undef VB_
    LAS float* XCH = (LAS float*)lds + sub * 4096;
    const size_t rowoff = ((size_t)b * S_ + q0 + r32) * 1024 + 512 + h * 128;
    v2u sgv[16]; f32x4 gv[16];
    if (which == 0) {
#pragma unroll
        for (int i = 0; i < 16; ++i) { const int dv = 32 * (i >> 2) + 8 * (i & 3) + 4 * hi; sgv[i] = *(const v2u*)(SG + rowoff + dv); gv[i] = *(const f32x4*)(subln_g + dv); } }
    if (which == 1) { const float sc2 = lam / w.l;
#pragma unroll
        for (int d = 0; d < 4; ++d)
#pragma unroll
            for (int r = 0; r < 16; ++r) XCH[(d * 16 + r) * 64 + lane] = w.o[d][r] * sc2; }
    __syncthreads();
    if (which == 0) { const float il = 1.f / w.l; float ss = 0.f;
#pragma unroll
        for (int d = 0; d < 4; ++d)
#pragma unroll
            for (int r = 0; r < 16; ++r) { const float v = w.o[d][r] * il - XCH[(d * 16 + r) * 64 + lane]; w.o[d][r] = v; ss += v * v; }
        ss = swapsum(ss);
        const float rs = rsqrtf(ss * (1.f / 128.f) + EPS) * (1.f - lam_init);
#pragma unroll
        for (int i = 0; i < 16; ++i) { const int d = i >> 2, rr = i & 3, dv = 32 * d + 8 * rr + 4 * hi; const f32x4 g = gv[i];
            const float s0 = __uint_as_float(sgv[i].x << 16), s1 = __uint_as_float(sgv[i].x & 0xffff0000u), s2 = __uint_as_float(sgv[i].y << 16), s3 = __uint_as_float(sgv[i].y & 0xffff0000u);
            v2u o2; o2.x = pk2(w.o[d][4 * rr] * rs * g.x * s0, w.o[d][4 * rr + 1] * rs * g.y * s1); o2.y = pk2(w.o[d][4 * rr + 2] * rs * g.z * s2, w.o[d][4 * rr + 3] * rs * g.w * s3);
            *(v2u*)(YM + rowoff + dv) = o2; } }
    __syncthreads();
}

template <class RowFn>
__device__ __forceinline__ void stage_blocks(LAS unsigned char* lds, int nblk, const bf16* Kh, const bf16* Vh, RowFn rowfn, int wave, int lane) {
    for (int pc = wave; pc < nblk * 8; pc += NWAVES) {
        const int blk = pc >> 3, j = pc & 7;
        if (j < 4) { const int kk = 8 * j + (lane >> 3), c = (lane & 7) ^ ((kk >> 1) & 7); const long ro = rowfn(blk, kk);
            if (ro >= 0) glds16(Kh + ro + c * 8, lds + blk * 4096 + j * 1024); }
        else { const int vp = j - 4, kk = 16 * (vp & 1) + (lane >> 2); const long ro = rowfn(blk, kk);
            if (ro >= 0) glds16(Vh + ro + (vp >> 1) * 32 + (lane & 3) * 8, lds + 65536 + blk * 4096 + (vp >> 1) * 2048 + (vp & 1) * 1024); }
    }
}
struct BandMask { bool on; int dk, W, r32, hi; __device__ __forceinline__ void operator()(f32x16& p) const {
#pragma unroll
    for (int r = 0; r < 16; ++r) { const int dist = crow(r, hi) - r32 + dk; if (dist > W || dist < -W) p[r] = NEGBIG; } } };
#define STORE_Y64(w, sc, sgv, YM, rowoff) do { _Pragma("unroll") for (int i_ = 0; i_ < 8; ++i_) { const int d_ = i_ >> 2, rr_ = i_ & 3, dv_ = 32 * d_ + 8 * rr_ + 4 * hi; \
        const float s0 = __uint_as_float(sgv[i_].x << 16), s1 = __uint_as_float(sgv[i_].x & 0xffff0000u), s2 = __uint_as_float(sgv[i_].y << 16), s3 = __uint_as_float(sgv[i_].y & 0xffff0000u); \
        v2u o2; o2.x = pk2(w.o[d_][4 * rr_] * sc * s0, w.o[d_][4 * rr_ + 1] * sc * s1); o2.y = pk2(w.o[d_][4 * rr_ + 2] * sc * s2, w.o[d_][4 * rr_ + 3] * sc * s3); \
        *(v2u*)(YM + rowoff + dv_) = o2; } } while (0)

__device__ __forceinline__ void band_unit(LAS unsigned char* lds, int b, int g, int s4, const bf16* QC, const bf16* KC, const bf16* VC, const bf16* SG, const float* sink, bf16* YM, int it_lo, int it_hi, int wv) {
    int tid = wv * 64 + (int)__builtin_amdgcn_mbcnt_hi(~0u, __builtin_amdgcn_mbcnt_lo(~0u, 0u)); asm volatile("" : "+v"(tid));
    const int lane = tid & 63, wave = __builtin_amdgcn_readfirstlane(tid >> 6), r32 = lane & 31, hi = lane >> 5;
    const int head = g * 4 + (wave >> 1), sub = wave & 1, ks = s4 * 256 - 128;
    const bf16* Kh = KC + (size_t)(b * 4 + g) * S_ * 64; const bf16* Vh = VC + (size_t)(b * 4 + g) * S_ * 64;
    stage_blocks(lds, 16, Kh, Vh, [&](int blk, int kk) -> long { const int t = ks + blk * 32 + kk; return (t >= 0 && t < S_) ? (long)t * 64 : -1L; }, wave, lane);
    const float slope = __builtin_amdgcn_exp2f(-0.5f * (float)(head + 1)) * LOG2E;
    const bf16* Qh = QC + ((size_t)(b * 16 + head) * S_ + r32) * 64 + hi * 8;
    bf16x8 qn[4]; q_fetch(qn, Qh + (size_t)(s4 * 256 + it_lo * 64 + sub * 32) * 64);
    f32x16 R;
#pragma unroll
    for (int r = 0; r < 16; ++r) R[r] = slope * (float)(crow(r, hi) - r32);
    const float sk = sink[head] * LOG2E;
    __syncthreads();
#pragma unroll 1
    for (int it = it_lo; it < it_hi; ++it) {
        const int q0 = s4 * 256 + it * 64 + sub * 32;
        WState<64> w; w_begin<64>(w, qn);
        if (it + 1 < it_hi) q_fetch(qn, Qh + (size_t)(q0 + 64) * 64);
        const size_t rowoff = ((size_t)b * S_ + q0 + r32) * 1024 + head * 64;
        v2u sgv[8];
#pragma unroll
        for (int i = 0; i < 8; ++i) sgv[i] = *(const v2u*)(SG + rowoff + 32 * (i >> 2) + 8 * (i & 3) + 4 * hi);
        { const int j = (q0 - ks) >> 5; step32<64, true>(w, (const LAS char*)(lds + j * 4096), (const LAS char*)(lds + 65536 + j * 4096), R, 0.f, true, NoMask(), lane); }
#pragma unroll 1
        for (int i = 1; i < 9; ++i) {
            const int dk = (i & 1) ? -32 * ((i + 1) >> 1) : 32 * (i >> 1);
            const int kb0 = q0 + dk; if (kb0 < 0 || kb0 >= S_) continue;
            const int j = (kb0 - ks) >> 5;
            step32<64, false>(w, (const LAS char*)(lds + j * 4096), (const LAS char*)(lds + 65536 + j * 4096), R, slope * (float)dk, false, BandMask{dk == 128 || dk == -128, dk, 128, r32, hi}, lane);
        }
        const float Mx = fmaxf(w.m, sk), e = __builtin_amdgcn_exp2f(w.m - Mx);
        const float sc = e / (w.l * e + __builtin_amdgcn_exp2f(sk - Mx));
        STORE_Y64(w, sc, sgv, YM, rowoff);
    }
    __syncthreads();
}

struct DilMask { bool on; int dm0, dr, own, r32, hi; __device__ __forceinline__ void operator()(f32x16& p) const {
    const float base = (float)(16 * (dm0 + 4 * hi - r32) + dr);
    if (own) {
#pragma unroll
        for (int r = 0; r < 16; ++r) { const float ad = fabsf(base + (float)(16 * ((r & 3) + 8 * (r >> 2))));
            const float bonus = __builtin_amdgcn_fmed3f(fmaf(256.f - ad, 0.0625f, 1.f), 0.f, 1.f);
            p[r] = fmaf(fminf(1024.f - ad, 0.f), 1e30f, p[r] + bonus); } }
    else {
#pragma unroll
        for (int r = 0; r < 16; ++r) { const float ad = fabsf(base + (float)(16 * ((r & 3) + 8 * (r >> 2)))); p[r] = fmaf(fminf(256.f - ad, 0.f), 1e30f, p[r]); } } } };
__device__ __forceinline__ void dilB_unit(LAS unsigned char* lds, int b, int h, int r4, const bf16* QA, const bf16* KA, const bf16* VA, float* STO, float* STML, int wv) {
    int tid = wv * 64 + (int)__builtin_amdgcn_mbcnt_hi(~0u, __builtin_amdgcn_mbcnt_lo(~0u, 0u)); asm volatile("" : "+v"(tid));
    const int lane = tid & 63, wave = __builtin_amdgcn_readfirstlane(tid >> 6), r32 = lane & 31, hi = lane >> 5;
    const size_t hb = (size_t)(b * 8 + h) * S_;
    const bf16* Kh = KA + hb * 64; const bf16* Vh = VA + hb * 64;
    stage_blocks(lds, 16, Kh, Vh, [&](int blk, int kk) -> long { return (long)(16 * ((blk & 3) * 32 + kk) + r4 + 4 * (blk >> 2)) * 64; }, wave, lane);
    const float slope = __builtin_amdgcn_exp2f(-(float)(h + 1)) * LOG2E;
    f32x16 R;
#pragma unroll
    for (int r = 0; r < 16; ++r) R[r] = 16.f * slope * (float)(crow(r, hi) - r32);
    const bf16* Qh = QA + (hb + 16 * r32) * 64 + hi * 8;
    bf16x8 qn[4]; q_fetch(qn, Qh + (size_t)(16 * 32 * (wave & 3) + r4 + 4 * (wave >> 2)) * 64);
    __syncthreads();
#pragma unroll 1
    for (int tk = 0; tk < 2; ++tk) {
        const int qi = tk * 2 + (wave >> 2), qmb = tk ? ((wave & 3) ^ 2) : (wave & 3), cq = r4 + 4 * qi, m0 = 32 * qmb;
        WState<64> w; w_begin<64>(w, qn);
        if (tk == 0) q_fetch(qn, Qh + (size_t)(16 * 32 * ((wave & 3) ^ 2) + r4 + 4 * (2 + (wave >> 2))) * 64);
        { const int blk = qi * 4 + qmb;
          step32<64, true>(w, (const LAS char*)(lds + blk * 4096), (const LAS char*)(lds + 65536 + blk * 4096), R, 0.f, true, DilMask{true, 0, 0, 1, r32, hi}, lane); }
#pragma unroll 1
        for (int s = 1; s < 16; ++s) {
            const int ki = (qi + (s >> 2)) & 3, kmb = (qmb + (s & 3)) & 3;
            const int dm0 = 32 * (kmb - qmb), dr = 4 * (ki - qi), own = (ki == qi);
            if (own ? (dm0 >= 96 || dm0 <= -96) : (dm0 >= 64 || dm0 <= -64)) continue;
            const int blk = ki * 4 + kmb;
            step32<64, false>(w, (const LAS char*)(lds + blk * 4096), (const LAS char*)(lds + 65536 + blk * 4096), R, slope * (float)(16 * dm0 + dr), dm0 == 0, DilMask{true, dm0, dr, own, r32, hi}, lane);
        }
        const int t = 16 * (m0 + r32) + cq;
        float* so = STO + (hb + t) * 64;
#pragma unroll
        for (int d = 0; d < 2; ++d)
#pragma unroll
            for (int rr = 0; rr < 4; ++rr) *(f32x4*)(so + 32 * d + 8 * rr + 4 * hi) = (f32x4){w.o[d][4 * rr], w.o[d][4 * rr + 1], w.o[d][4 * rr + 2], w.o[d][4 * rr + 3]};
        if (hi == 0) { float2 ml; ml.x = w.m; ml.y = w.l; *(float2*)(STML + (hb + t) * 2) = ml; }
    }
    __syncthreads();
}
__device__ __forceinline__ void dilA_unit(LAS unsigned char* lds, int b, int h, int qt, const bf16* QA, const bf16* KA, const bf16* VA, const float* STO, const float* STML, const bf16* SG, bf16* YM, int wv) {
    int tid = wv * 64 + (int)__builtin_amdgcn_mbcnt_hi(~0u, __builtin_amdgcn_mbcnt_lo(~0u, 0u)); asm volatile("" : "+v"(tid));
    const int lane = tid & 63, wave = __builtin_amdgcn_readfirstlane(tid >> 6), r32 = lane & 31, hi = lane >> 5;
    const size_t hb = (size_t)(b * 8 + h) * S_;
    const bf16* Kh = KA + hb * 64; const bf16* Vh = VA + hb * 64;
    const int q0 = qt * 256 + wave * 32, ks = qt * 256 - 64, tq = q0 + r32;
    stage_blocks(lds, 12, Kh, Vh, [&](int blk, int kk) -> long { const int t = ks + blk * 32 + kk; return (t >= 0 && t < S_) ? (long)t * 64 : -1L; }, wave, lane);
    const float slope = __builtin_amdgcn_exp2f(-(float)(h + 1)) * LOG2E;
    WState<64> w;
    { bf16x8 q[4]; q_fetch(q, QA + (hb + tq) * 64 + hi * 8);
      const size_t rowoff = ((size_t)b * S_ + tq) * 1024 + h * 64; v2u sgv[8];
#pragma unroll
      for (int i = 0; i < 8; ++i) sgv[i] = *(const v2u*)(SG + rowoff + 32 * (i >> 2) + 8 * (i & 3) + 4 * hi);
      const float* so = STO + (hb + tq) * 64; f32x4 sv[8];
#pragma unroll
      for (int i = 0; i < 8; ++i) sv[i] = *(const f32x4*)(so + 32 * (i >> 2) + 8 * (i & 3) + 4 * hi);
      const float2 ml = *(const float2*)(STML + (hb + tq) * 2);
      w_begin<64>(w, q);
#pragma unroll
      for (int i = 0; i < 8; ++i) { w.o[i >> 2][4 * (i & 3)] = sv[i].x; w.o[i >> 2][4 * (i & 3) + 1] = sv[i].y; w.o[i >> 2][4 * (i & 3) + 2] = sv[i].z; w.o[i >> 2][4 * (i & 3) + 3] = sv[i].w; }
      w.m = ml.x; w.l = ml.y;
      f32x16 R;
#pragma unroll
      for (int r = 0; r < 16; ++r) R[r] = slope * (float)(crow(r, hi) - r32);
      __syncthreads();
#pragma unroll 1
      for (int i = 0; i < 5; ++i) {
          const int dk = 32 * (i - 2), kb0 = q0 + dk; if (kb0 < 0 || kb0 >= S_) continue;
          const int j = (kb0 - ks) >> 5;
          step32<64, false>(w, (const LAS char*)(lds + j * 4096), (const LAS char*)(lds + 65536 + j * 4096), R, slope * (float)dk, dk == 0, BandMask{dk == 64 || dk == -64, dk, 64, r32, hi}, lane);
      }
      const float sc = 1.f / w.l;
      STORE_Y64(w, sc, sgv, YM, rowoff); }
    __syncthreads();
}

__device__ __forceinline__ void xcc_local_barrier(unsigned* lb, unsigned x, unsigned* tmo, int wave) {
    asm volatile("s_waitcnt vmcnt(0)" ::: "memory");
    __syncthreads();
    if (wg_leader(wave)) {
        const unsigned old = xb_add(&lb[64 * x], 1u), gen = old / 32u;
        if (old + 1u == (gen + 1u) * 32u) xb_add(&lb[512 + 64 * x], 1u);
        else { unsigned sp = 0; while (xb_ld(&lb[512 + 64 * x]) == gen) { __builtin_amdgcn_s_sleep(1); if ((++sp & 255u) == 0u) { if (xb_ld(tmo)) break; if (sp > XB_SPIN_CAP) { atomicAdd(tmo, 1u); break; } } } }
        __builtin_amdgcn_fence(__ATOMIC_ACQUIRE, "agent");
        asm volatile("s_waitcnt vmcnt(0)" ::: "memory");
    }
    __syncthreads();
}
__device__ __forceinline__ void cu_wait_ge(unsigned* p, unsigned target, unsigned* tmo, int wave) {
    if (wg_leader(wave)) { unsigned sp = 0;
        while (xb_ld(p) < target) { __builtin_amdgcn_s_sleep(1); if ((++sp & 255u) == 0u) { if (xb_ld(tmo)) break; if (sp > XB_SPIN_CAP) { atomicAdd(tmo, 1u); break; } } }
        __builtin_amdgcn_fence(__ATOMIC_ACQUIRE, "agent"); asm volatile("s_waitcnt vmcnt(0)" ::: "memory"); }
    __syncthreads();
}
struct Args { const float* in[16]; float* out; unsigned char* ws; int ph_lo, ph_hi; };
constexpr int PROBE_BLK = 0, PROBE_UNIT = 2;
constexpr int PROBE_CAT = -1, PROBE_AMP = 4;
constexpr int PROBE_PH = -1, PROBE_REPS = 1;
constexpr int PH_P0A = 0, PH_P0B = 1, PH_L0 = 2, PH_FINAL = 18, PH_END = 18;

__global__ void __launch_bounds__(NWAVES * 64, 2) mega(Args args) {
    extern __shared__ __attribute__((aligned(16))) unsigned char lds_raw[];
    LAS unsigned char* lds = (LAS unsigned char*)lds_raw;
    volatile LAS unsigned* MISC = (volatile LAS unsigned*)(lds + MISC_OFF);
    const int tid = threadIdx.x, lane = tid & 63, wave = __builtin_amdgcn_readfirstlane(tid >> 6);
    const int G = gridDim.x; const int bx = blockIdx.x; const int vcu = (G % 8 == 0) ? (bx % 8) * (G / 8) + bx / 8 : bx;
    unsigned char* ws = args.ws;
    unsigned* ctl = (unsigned*)(ws + WS_CTL);
    for (int u = tid; u < (LDS_BYTES - LDSCTL_OFF) / 4; u += NWAVES * 64) ((LAS unsigned*)(lds + LDSCTL_OFF))[u] = 0u;
    __syncthreads();
    const unsigned myx = xb_xcc_id() & 7u;
    if (tid == 0) MISC[17] = xb_add(ctl + CW_RANK + 64 * myx, 1u);
    __syncthreads();
    const unsigned myrank = MISC[17];
    constexpr int lo = PH_P0A, hi = PH_END;
    const bool use_bar = (hi - lo) > 1;
    XcdBarrier bar; bar.bar = ctl + CW_BAR; bar.x = 0; bar.st = nullptr;
    if (use_bar) bar = xcd_barrier_post(ctl + CW_BAR, MISC + 8, wave);
    unsigned long long pacc[8] = {0, 0, 0, 0, 0, 0, 0, 0}; unsigned long long plast = 0, pbar = 0; const bool pon = (PROBE_CAT >= 0) && (PROBE_CAT < 8) && bx == 0 && wave == 0;
#define IN(k) (lo <= (k) && (k) < hi)
#define REPS(k) for (int rep_ = 0; rep_ < ((k) == PROBE_PH ? PROBE_REPS : 1); ++rep_)
#define SEAM(k) do { if (IN(k) && IN((k) + 1)) { if (PROBE_CAT == 8) { const unsigned long long tb_ = __builtin_readcyclecounter(); xcd_barrier(bar); pbar += __builtin_readcyclecounter() - tb_; } else xcd_barrier(bar); } } while (0)
    const float* x_in = args.in[0]; const float* c_in = args.in[1]; const float* ada_w = args.in[2]; const float* ada_b = args.in[3]; const float* norm_g = args.in[4];
    const float* ab_w_in = args.in[5]; const float* ab_w_out = args.in[6]; const float* c_w_in = args.in[12]; const float* c_w_out = args.in[13]; const float* final_g = args.in[15];
    float* mod = (float*)(ws + WS_MOD); float* shw = (float*)(ws + WS_SHW); float* ssq = (float*)(ws + WS_SSQ); float* lam = (float*)(ws + WS_LAM);
    bf16* XS = (bf16*)(ws + WS_XS);
    const int gw = vcu * NWAVES + wave, NGW = G * NWAVES;

    if (IN(PH_P0A)) REPS(PH_P0A) {
        LAS float* vec = (LAS float*)lds; LAS float* red = (LAS float*)(lds + 32768);
        for (int i = tid; i < 8 * 1024; i += NWAVES * 64) vec[i] = nv::silu(c_in[i]);
        __syncthreads();
        for (int it = bx; it < 4 * 48; it += G) { const int l = it / 48, jc = it % 48;
            gemv8_item(ada_w + (size_t)l * 1024 * 3072, 3072, jc * 64, vec, red, ada_b + l * 3072, mod + (size_t)l * 8 * 3072, 3072, wave, lane); }
        __syncthreads();
        LAS float* scr = (LAS float*)(lds + wave * 16384);
        constexpr int I_WE = 16 * 128, I_WO = 16 * 32, I_CE = 16 * 80;
        constexpr int NITEMS = 2 * I_WE + 2 * I_WO + 2 * I_CE + 2 * I_WO;
        for (int it = gw; it < NITEMS; it += NGW) { int r = it;
            if (r < 2 * I_WE) { const int j = r / I_WE; p0_transpose_item(ab_w_in + (size_t)j * 1024 * 4096, 1024, 4096, (bf16*)(ws + WS_WIN_E) + (size_t)j * 4096 * 1024, scr, r % I_WE, lane); continue; } r -= 2 * I_WE;
            if (r < 2 * I_WO) { const int j = r / I_WO; p0_transpose_item(ab_w_out + (size_t)j * 1024 * 1024, 1024, 1024, (bf16*)(ws + WS_WOUT_E) + (size_t)j * 1024 * 1024, scr, r % I_WO, lane); continue; } r -= 2 * I_WO;
            if (r < 2 * I_CE) { const int j = r / I_CE; p0_transpose_item(c_w_in + (size_t)j * 1024 * 2560, 1024, 2560, (bf16*)(ws + WS_WIN_O) + (size_t)j * 2560 * 1024, scr, r % I_CE, lane); continue; } r -= 2 * I_CE;
            { const int j = r / I_WO; p0_transpose_item(c_w_out + (size_t)j * 1024 * 1024, 1024, 1024, (bf16*)(ws + WS_WOUT_O) + (size_t)j * 1024 * 1024, scr, r % I_WO, lane); } }
        for (int i = bx * 512 + tid; i < 3 * M_; i += G * 512) ssq[M_ + i] = 0.f;
        if (bx == 0 && tid < 2) { const float* lq1 = args.in[7]; const float* lk1 = args.in[8]; const float* lq2 = args.in[9]; const float* lk2 = args.in[10];
            float s1 = 0.f, s2 = 0.f;
            for (int d = 0; d < 64; ++d) { s1 += lq1[tid * 64 + d] * lk1[tid * 64 + d]; s2 += lq2[tid * 64 + d] * lk2[tid * 64 + d]; }
            lam[tid] = expf(s1) - expf(s2) + (0.8f - 0.6f * expf(-0.3f * (float)(2 * tid))); }
        __syncthreads();
    }
    SEAM(PH_P0A);
    if (IN(PH_P0B)) REPS(PH_P0B) {
        LAS float* vec = (LAS float*)lds; LAS float* red = (LAS float*)(lds + 32768);
        int cur_l = -1;
        for (int it = bx; it < 2 * 64 + 2 * 40; it += G) {
            int l, nc; if (it < 128) { l = (it / 64) * 2; nc = it % 64; } else { l = ((it - 128) / 40) * 2 + 1; nc = (it - 128) % 40; }
            if (l != cur_l) { __syncthreads(); for (int i = tid; i < 8 * 1024; i += NWAVES * 64) vec[i] = mod[(size_t)l * 8 * 3072 + (i >> 10) * 3072 + (i & 1023)]; cur_l = l; __syncthreads(); }
            const int j = l >> 1; const float* W = (l & 1) ? c_w_in + (size_t)j * 1024 * 2560 : ab_w_in + (size_t)j * 1024 * 4096; const int ldw = (l & 1) ? 2560 : 4096;
            gemv8_item(W, ldw, nc * 64, vec, red, nullptr, shw + (size_t)l * 8 * 4096, 4096, wave, lane); }
        {
            const f32x4* gr = (const f32x4*)norm_g + lane; f32x4 gv[4];
#pragma unroll
            for (int j = 0; j < 4; ++j) gv[j] = gr[64 * j];
#pragma unroll 1
            for (int row0 = gw; row0 < M_; row0 += 4 * NGW) {
                f32x4 xv[4][4], sv[4][4];
#pragma unroll
                for (int q = 0; q < 4; ++q) { const int row = row0 + q * NGW; const int rr = row < M_ ? row : row0; const int b = rr >> 11;
                    const GAS f32x4* xr = (const GAS f32x4*)(x_in + (size_t)rr * D_) + lane; const f32x4* sr = (const f32x4*)(mod + (size_t)b * 3072 + 1024) + lane;
#pragma unroll
                    for (int j = 0; j < 4; ++j) { xv[q][j] = xr[64 * j]; sv[q][j] = sr[64 * j]; } }
#pragma unroll
                for (int q = 0; q < 4; ++q) { const int row = row0 + q * NGW; if (row >= M_) break;
                    GAS v2u* o8 = (GAS v2u*)(XS + (size_t)row * D_) + lane; float ss = 0.f;
#pragma unroll
                    for (int j = 0; j < 4; ++j) { const f32x4 v = xv[q][j], g = gv[j], s = sv[q][j]; ss += (v.x * v.x + v.y * v.y) + (v.z * v.z + v.w * v.w);
                        v2u o; o.x = pk2(v.x * g.x * (1.f + s.x), v.y * g.y * (1.f + s.y)); o.y = pk2(v.z * g.z * (1.f + s.z), v.w * g.w * (1.f + s.w)); o8[64 * j] = o; }
                    ss = wsum(ss); if (lane == 0) ssq[row] = ss; }
            }
        }
    }
    SEAM(PH_P0B);
    bool local_ok = use_bar && lo == 0 && G == 256 && myrank < 32u;
    if (local_ok) {
#pragma unroll
        for (int jx = 0; jx < 8; ++jx) local_ok = local_ok && (xb_ld(ctl + CW_RANK + 64 * jx) == 32u); }
    local_ok = __builtin_amdgcn_readfirstlane((int)local_ok) != 0;
    const int bbx = local_ok ? (int)myx : (vcu >> 5) & 7, rkx = local_ok ? (int)myrank : (vcu & 31);
    const int vcl = (vcu & ~255) + bbx * 32 + rkx;
    const int cgm = local_ok ? rkx * 8 + bbx : bx;
#define LSEAM(k) do { if (IN(k) && IN((k) + 1)) { if (local_ok) xcc_local_barrier(ctl + CW_LB, myx, ctl + CW_BAR + XB_TMO, wave); else xcd_barrier(bar); } } while (0)
#pragma unroll 1
    for (int l = 0; l < 4; ++l) {
        const int j = l >> 1, odd = l & 1; const int ph = PH_L0 + 4 * l;
        const float* mod_l = mod + (size_t)l * 8 * 3072;
        unsigned* syn = ctl + CW_SYN + (l * 8 + bbx) * 32;
        if (IN(ph)) REPS(ph) {
            const int N = odd ? 2560 : 4096;
            const bf16* Wt = odd ? (const bf16*)(ws + WS_WIN_O) + (size_t)j * 2560 * 1024 : (const bf16*)(ws + WS_WIN_E) + (size_t)j * 4096 * 1024;
            if (local_ok && l > 0 && IN(ph - 1)) cu_wait_ge(syn - 32 * 8 + 8 + (rkx & 7), 4u, ctl + CW_BAR + XB_TMO, wave);
            pg8::Gemm g{XS, Wt, M_, N, 1024}; pg8::HookOrder S; S.so.init(M_, N, G, cgm); S.r1 = (odd && local_ok && IN(ph + 1)) ? syn + 17 : nullptr; S.r2 = syn + 18;
            pg8::EpiProj E{odd, ssq + (size_t)l * M_, shw + (size_t)l * 8 * 4096, ws, (local_ok && l > 0 && IN(ph - 1)) ? syn - 32 * 8 + 16 : nullptr, 32u};
            pg8::gemm_phase<pg8::EpiProj, pg8::HookOrder, true, true>(lds, g, S, E, wave);
        }
        if (odd && local_ok) { if (IN(ph) && IN(ph + 1)) cu_wait_ge(syn + 17, 256u, ctl + CW_BAR + XB_TMO, wave); }
        else LSEAM(ph);
        if (IN(ph + 1)) REPS(ph + 1) {
            const bf16* SGp = (const bf16*)(ws + WS_SG); bf16* YMp = (bf16*)(ws + WS_YMIX);
            if (!odd) {
                REPS(100 + ph + 1) for (int u = vcl; u < 256; u += G) dilB_unit(lds, u >> 5, (u >> 2) & 7, u & 3, (const bf16*)(ws + WS_QA), (const bf16*)(ws + WS_KA), (const bf16*)(ws + WS_VA), (float*)(ws + WS_STO), (float*)(ws + WS_STML), wave);
                if (local_ok) { asm volatile("s_waitcnt vmcnt(0)" ::: "memory"); __syncthreads(); if (wg_leader(wave)) (void)xb_add(ctl + CW_GRP + (j * 64 + ((vcl >> 2) & 63)) * 4, 1u); }
                const float lam_init = __uint_as_float(__builtin_amdgcn_readfirstlane(__float_as_uint(0.8f - 0.6f * __expf(-0.3f * (float)l)))); const float lam_v = __uint_as_float(__builtin_amdgcn_readfirstlane(__float_as_uint(lam[j])));
                const bool swapA = local_ok && (rkx & 1);
#pragma unroll 1
                for (int st = 0; st < 2; ++st) {
                    if ((st == 0) == swapA) {
                        if (local_ok) cu_wait_ge(ctl + CW_GRP + (j * 64 + ((vcl >> 2) & 63)) * 4, 4u, ctl + CW_BAR + XB_TMO, wave); else xcd_barrier(bar);
                        for (int u = vcl; u < 512; u += G) dilA_unit(lds, (u >> 5) & 7, (u & 31) >> 2, 2 * (u & 3) + (u >> 8), (const bf16*)(ws + WS_QA), (const bf16*)(ws + WS_KA), (const bf16*)(ws + WS_VA), (const float*)(ws + WS_STO), (const float*)(ws + WS_STML), (const bf16*)(ws + WS_SG), (bf16*)(ws + WS_YMIX), wave);
                    } else {
                    REPS(200 + ph + 1) for (int u = vcl; u < 512; u += G) { const int iu = u >> 8, ru = u & 31, bh = ((u >> 5) & 7) * 4, qt = 2 * (ru & 7) + iu; const int hh = iu ? 3 - (ru >> 3) : (ru >> 3);
                    diff_unit(lds, bh >> 2, hh, qt, (const bf16*)(ws + WS_QB), (const bf16*)(ws + WS_KB), (const bf16*)(ws + WS_VB), SGp, args.in[11] + j * 128, lam_v, lam_init, YMp, wave); }
                    }
                }
            } else {
                const int late = rkx < 16 ? 1 : 0;
#pragma unroll 1
                for (int k = 0; k < 4; ++k) {
                    int gb, gg, gs, lo = 0, hi = 4;
                    if (local_ok) { if (k >= 2 - late) break; gb = bbx; gg = k ? (rkx >> 3) : (((rkx >> 3) + 2) & 3); gs = rkx & 7; lo = k ? 3 : 0; hi = (k || !late) ? 4 : 3;
                        if (k) cu_wait_ge(syn + 18, 128u, ctl + CW_BAR + XB_TMO, wave); }
                    else { const int u = vcl + k * G; if (u >= 256) break; gb = u >> 5; gg = (u >> 3) & 3; gs = u & 7; }
                    band_unit(lds, gb, gg, gs, (const bf16*)(ws + WS_QC), (const bf16*)(ws + WS_KC), (const bf16*)(ws + WS_VC), SGp, args.in[14] + j * 16, YMp, lo, hi, wave);
                }
            }
        }
        if (IN(ph + 2) && IN(ph + 3)) {
            if (local_ok) {
                asm volatile("s_waitcnt vmcnt(0)" ::: "memory"); __syncthreads();
                if (wg_leader(wave)) { (void)xb_add(syn + (rkx & 7), 1u); if (!odd) { (void)xb_add(syn + 2 * (rkx & 3), 1u); (void)xb_add(syn + 2 * (rkx & 3) + 1, 1u); } (void)xb_add(syn + 16, 1u); }
                cu_wait_ge(syn + (rkx & 7), odd ? 4u : 12u, ctl + CW_BAR + XB_TMO, wave);
            } else xcd_barrier(bar);
        }
        if (IN(ph + 3)) {
            const bf16* Wt = odd ? (const bf16*)(ws + WS_WOUT_O) + (size_t)j * 1024 * 1024 : (const bf16*)(ws + WS_WOUT_E) + (size_t)j * 1024 * 1024;
            pg8::Gemm g{(const bf16*)(ws + WS_YMIX), Wt, M_, 1024, 1024}; pg8::StaticOrder S; S.init(M_, 1024, G, cgm);
            if (l < 3) {
                pg8::EpiOutR E{l == 0 ? x_in : args.out, args.out, mod_l + 2048, 1, norm_g + (l + 1) * 1024, mod_l + 8 * 3072 + 1024, XS, ssq + (size_t)(l + 1) * M_, (local_ok && !odd && IN(ph + 2)) ? syn + 16 : nullptr, 32u};
                pg8::gemm_phase<pg8::EpiOutR, pg8::StaticOrder, true, true>(lds, g, S, E, wave);
                if (local_ok && IN(ph + 4) && wg_leader(wave)) (void)xb_add(syn + 8 + (rkx & 7), 1u);
            } else {
                pg8::EpiOutFinal E{args.out, args.out, mod_l + 2048, final_g, (float*)(ws + WS_XCH), ctl + CW_PANEL};
                pg8::gemm_phase<pg8::EpiOutFinal, pg8::StaticOrder, false, true>(lds, g, S, E, wave);
            }
        }
        if (l < 3 && !local_ok && IN(ph + 3) && IN(ph + 4)) xcd_barrier(bar);
    }
    if (PROBE_CAT >= 0 && bx == PROBE_BLK && wave == 0) { const unsigned long long t0 = __builtin_readcyclecounter(), dur = (unsigned long long)PROBE_AMP * (PROBE_CAT == 8 ? pbar : pacc[(PROBE_CAT >= 0 && PROBE_CAT < 8) ? PROBE_CAT : 0]);
        while (__builtin_readcyclecounter() - t0 < dur) __builtin_amdgcn_s_sleep(8); }
#undef IN
#undef REPS
#undef SEAM
#undef LSEAM
}
}

static void launch_mega(const mk::Args& base, int lo, int hi, int grid, hipStream_t stream) {
    mk::Args a = base; a.ph_lo = lo; a.ph_hi = hi;
    hipLaunchKernelGGL(mk::mega, dim3(grid), dim3(mk::NWAVES * 64), mk::LDS_BYTES, stream, a);
}
extern "C" void kernel_launch(void* const* d_in, const int* in_sizes, int n_in, void* d_out, int out_size, void* d_ws, size_t ws_size, hipStream_t stream) {
    using namespace nv;
    static int grid = 0;
    if (grid == 0) {
        if (n_in != 16 || in_sizes[0] != M_ * D_ || out_size != M_ * D_ || ws_size < lay::WS_END) { fprintf(stderr, "kernel_launch: unexpected shapes / workspace (%d inputs, ws %zu)\n", n_in, ws_size); grid = -1; return; }
        int dev = 0, cus = 0, per_cu = 0;
        if (hipGetDevice(&dev) != hipSuccess || hipDeviceGetAttribute(&cus, hipDeviceAttributeMultiprocessorCount, dev) != hipSuccess) { grid = -1; return; }
        if (hipFuncSetAttribute((const void*)mk::mega, hipFuncAttributeMaxDynamicSharedMemorySize, mk::LDS_BYTES) != hipSuccess) { fprintf(stderr, "kernel_launch: hipFuncSetAttribute failed\n"); grid = -1; return; }
        if (hipOccupancyMaxActiveBlocksPerMultiprocessor(&per_cu, (const void*)mk::mega, mk::NWAVES * 64, mk::LDS_BYTES) != hipSuccess || per_cu < 1) { fprintf(stderr, "kernel_launch: occupancy query says %d blocks/CU\n", per_cu); per_cu = 1; }
        (void)hipGetLastError();
        grid = cus;
        if (grid != 256) fprintf(stderr, "kernel_launch: note: %d CUs\n", grid);
    }
    if (grid < 0) return;
    (void)hipMemsetAsync((char*)d_ws + lay::WS_CTL, 0, lay::CTL_ZERO_BYTES, stream);
    mk::Args a{};
    for (int i = 0; i < 16; ++i) a.in[i] = (const float*)d_in[i];
    a.out = (float*)d_out; a.ws = (unsigned char*)d_ws;
    launch_mega(a, mk::PH_P0A, mk::PH_END, grid, stream);
    const hipError_t le = hipPeekAtLastError();
    if (le != hipSuccess) fprintf(stderr, "kernel_launch: launch failed: %s\n", hipGetErrorName(le));
}
```

```cpp
#include <hip/hip_runtime.h>
#include <cstdio>
#include <cstdint>

namespace lay {
constexpr size_t MiB = 1u << 20;
constexpr size_t WS_CTL = 0, CTL_ZERO_BYTES = 64 * 1024;
constexpr size_t WS_MOD = 1 * MiB;
constexpr size_t WS_SHW = WS_MOD + 512 * 1024;
constexpr size_t WS_SSQ = 2 * MiB;
constexpr size_t WS_LAM = WS_SSQ + 512 * 1024;
constexpr size_t WS_WIN_E = 3 * MiB;
constexpr size_t WS_WOUT_E = 19 * MiB;
constexpr size_t WS_WIN_O = 23 * MiB;
constexpr size_t WS_WOUT_O = 33 * MiB;
constexpr size_t WS_X16 = 37 * MiB;
constexpr size_t WS_YMIX = 69 * MiB;
constexpr size_t WS_SG = 101 * MiB;
constexpr size_t WS_P = 133 * MiB;
constexpr size_t WS_QA = WS_P, WS_KA = WS_P + 16 * MiB, WS_VA = WS_P + 32 * MiB, WS_QB = WS_P + 48 * MiB, WS_KB = WS_P + 64 * MiB, WS_VB = WS_P + 80 * MiB;
constexpr size_t WS_QC = WS_P, WS_KC = WS_P + 32 * MiB, WS_VC = WS_P + 40 * MiB;
constexpr size_t WS_STML = WS_P + 96 * MiB;
constexpr size_t WS_END = WS_STML + 1 * MiB;
static_assert(WS_END <= 256 * MiB, "ws map");
constexpr size_t WS_XCH = WS_LAM + 64 * 1024;
constexpr int CW_RANK = 13312, CW_LB = 14336;
constexpr int CW_SYN = 12288;
constexpr int CW_GRP = 15360;
constexpr int CW_BAR = 1024, CW_PANEL = 8192;
static_assert(CW_PANEL + 64 * 64 <= CW_SYN && CW_SYN + 4 * 8 * 32 <= CW_RANK && CW_RANK + 8 * 64 <= CW_LB && CW_LB + 1024 <= CW_GRP && (CW_GRP + 512) * 4 <= (int)CTL_ZERO_BYTES, "control words inside the memset region");
}

namespace nv {
typedef unsigned short bf16;
constexpr int B_ = 8, S_ = 2048, D_ = 1024, M_ = B_ * S_;
constexpr float LOG2E = 1.4426950408889634f;
constexpr float QSCALE = 0.125f * LOG2E;
constexpr float EPS = 1e-6f;
__device__ __forceinline__ float silu(float x) { return x / (1.f + __expf(-x)); }
__device__ __forceinline__ int pi16(int t) { return (t & 15) * 128 + (t >> 4); }
using namespace lay;
}

namespace pg8 {
#define PG8_LAS __attribute__((address_space(3)))
typedef unsigned short bf16_t;
typedef short bf16x8 __attribute__((ext_vector_type(8)));
typedef float f32x4 __attribute__((ext_vector_type(4)));
typedef unsigned u32x4 __attribute__((ext_vector_type(4)));
constexpr int BM = 256, BK = 64, HALF = 128, HTB = HALF * BK * 2  , STAGE_BYTES = 8 * HTB, NXCD = 8, WGM = 8;

__host__ __device__ __forceinline__ int lds_byte(int r, int c) { const int st = (r >> 4) * 2 + (c >> 5), rr = r & 15, cc = c & 31, ob = rr * 64 + cc * 2; return st * 1024 + (ob ^ (((ob >> 9) & 1) << 5)); }
__host__ __device__ __forceinline__ void stage_rc(int b, int& R, int& C) { const int st = b / 1024, sb = b % 1024, swz = sb ^ (((sb >> 9) & 1) << 5); R = (st >> 1) * 16 + swz / 64; C = (st & 1) * 32 + (swz % 64) / 2; }
__host__ __device__ __forceinline__ int perm32(int rho) { const int n = rho >> 4, i = rho & 15; return 8 * (i >> 2) + 4 * n + (i & 3); }

struct Unit { int pm, pn; };
struct Gemm { const bf16_t* A; const bf16_t* Bt; int M, N, K; };

struct StaticOrder {
    int nM, nN, nwg, G, c;
    __host__ __device__ void init(int M, int N, int G_, int c_) { nM = M / BM; nN = N / BM; nwg = nM * nN; G = G_; c = c_; }
    __host__ __device__ bool next(int i, Unit& u) const {
        const long L = (long)i * G + c; if (L >= nwg) return false;
        int wgid = (int)L; { const int q = nwg / NXCD, r = nwg % NXCD, xcd = wgid % NXCD, off = wgid / NXCD; wgid = (xcd < r ? xcd * (q + 1) : r * (q + 1) + (xcd - r) * q) + off; }
        const int nig = WGM * nN, gid = wgid / nig, fm = gid * WGM, gsz = (nM - fm) < WGM ? (nM - fm) : WGM;
        u.pm = fm + ((wgid % nig) % gsz); u.pn = (wgid % nig) / gsz; return true;
    }
    __device__ __forceinline__ void a_ready(const Unit&) const {}
    __device__ __forceinline__ void done(const Unit&) const {}
};

__device__ __forceinline__ unsigned cvt_pk_bf16(float lo, float hi) { unsigned r; asm volatile("v_cvt_pk_bf16_f32 %0, %1, %2" : "=v"(r) : "v"(lo), "v"(hi)); return r; }

struct HookOrder {
    StaticOrder so; unsigned* r1; unsigned* r2;
    __device__ __forceinline__ bool next(int i, Unit& u) const { return so.next(i, u); }
    __device__ __forceinline__ void a_ready(const Unit&) const {}
    __device__ __forceinline__ void done(const Unit&) const {}
    __device__ __forceinline__ void after(int ui, int lane) const {
        if (r1 != nullptr && ui >= 1) { asm volatile("s_waitcnt vmcnt(0)" ::: "memory"); if (lane == 0) (void)__hip_atomic_fetch_add(ui == 1 ? r1 : r2, 1u, __ATOMIC_RELAXED, __HIP_MEMORY_SCOPE_AGENT); }
    }
};
template <class T> struct has_hook { static constexpr bool v = false; };
template <> struct has_hook<HookOrder> { static constexpr bool v = true; };
__device__ __forceinline__ void war_wait(unsigned* p, unsigned target) {
    if (!p) return;
    unsigned sp = 0;
    while (__hip_atomic_load(p, __ATOMIC_RELAXED, __HIP_MEMORY_SCOPE_AGENT) < target) { __builtin_amdgcn_s_sleep(1); if (++sp > (1u << 20)) break; }
}
struct EpiProj {
    static constexpr bool PERM = true, AFTER_DRAIN = false;
    int odd; const float* ssq; const float* shw; unsigned char* ws; unsigned* wptr; unsigned wtarget;
    __device__ __forceinline__ void operator()(const f32x4 (&acc)[2][2][4][2], const Unit& u, int wr, int wc, int fr, int fq) const {
        using namespace nv;
        const int row0 = u.pm * BM + wr * 64 + fr, b = u.pm >> 3, pn = u.pn;
        war_wait(wptr, wtarget);
        size_t base; int cb, lg, nh, perm, kind;
        if (!odd) {
            if (pn < 6)       { base = lay::WS_QA + (size_t)(pn >> 1) * (16u << 20); cb = (pn & 1) * 256; lg = 6; nh = 8; perm = 0; kind = 0; }
            else if (pn < 10) { base = lay::WS_QB + (size_t)((pn - 6) >> 1) * (16u << 20); cb = ((pn - 6) & 1) * 256; lg = 6; nh = 8; perm = 0; kind = 0; }
            else if (pn < 12) { base = lay::WS_VB; cb = (pn - 10) * 256; lg = 7; nh = 4; perm = 0; kind = 0; }
            else              { base = lay::WS_SG; cb = (pn - 12) * 256; lg = 0; nh = 0; perm = 0; kind = 1; }
        } else {
            if (pn < 4)       { base = lay::WS_QC; cb = pn * 256; lg = 6; nh = 16; perm = 0; kind = 0; }
            else if (pn == 4) { base = lay::WS_KC; cb = 0; lg = 6; nh = 4; perm = 0; kind = 0; }
            else if (pn == 5) { base = lay::WS_VC; cb = 0; lg = 6; nh = 4; perm = 0; kind = 0; }
            else              { base = lay::WS_SG; cb = (pn - 6) * 256; lg = 0; nh = 0; perm = 0; kind = 1; }
        }
        const bool isq = (!odd && (pn < 2 || pn == 6 || pn == 7)) || (odd && pn < 4);
        const float qs = isq ? QSCALE : 1.f;
        bf16_t* dst = (bf16_t*)(ws + base);
        const int cl0 = wc * 32 + 8 * fq;
        f32x4 bv[2][2];
#pragma unroll
        for (int bj = 0; bj < 2; ++bj)
#pragma unroll
            for (int n = 0; n < 2; ++n) bv[bj][n] = *(const f32x4*)(shw + (size_t)b * 4096 + pn * BM + cl0 + bj * HALF + 4 * n);
        float rsv[2][4];
#pragma unroll
        for (int ai = 0; ai < 2; ++ai)
#pragma unroll
            for (int m = 0; m < 4; ++m) rsv[ai][m] = ssq[row0 + ai * HALF + m * 16];
#pragma unroll
        for (int ai = 0; ai < 2; ++ai)
#pragma unroll
            for (int m = 0; m < 4; ++m) rsv[ai][m] = rsqrtf(rsv[ai][m] * (1.f / 1024.f) + EPS);
#pragma unroll
        for (int ai = 0; ai < 2; ++ai)
#pragma unroll
            for (int m = 0; m < 4; ++m) {
                const int row = row0 + ai * HALF + m * 16, t = row & 2047;
                const float rs = rsv[ai][m];
                const int tt = perm ? pi16(t) : t;
#pragma unroll
                for (int bj = 0; bj < 2; ++bj) {
                    f32x4 v0 = acc[ai][bj][m][0] * rs + bv[bj][0], v1 = acc[ai][bj][m][1] * rs + bv[bj][1];
                    const int cc = cb + cl0 + bj * HALF;
                    size_t off;
                    if (kind == 1) { off = (size_t)row * 1024 + cc;
#pragma unroll
                        for (int q = 0; q < 4; ++q) { v0[q] = v0[q] * __builtin_amdgcn_rcpf(1.f + __builtin_amdgcn_exp2f(-v0[q] * LOG2E)); v1[q] = v1[q] * __builtin_amdgcn_rcpf(1.f + __builtin_amdgcn_exp2f(-v1[q] * LOG2E)); } }
                    else { off = ((((size_t)(b * nh + (cc >> lg)) << 11) + tt) << lg) + (cc & ((1 << lg) - 1)); v0 = v0 * qs; v1 = v1 * qs; }
                    u32x4 w; w.x = cvt_pk_bf16(v0[0], v0[1]); w.y = cvt_pk_bf16(v0[2], v0[3]); w.z = cvt_pk_bf16(v1[0], v1[1]); w.w = cvt_pk_bf16(v1[2], v1[3]);
                    *(u32x4*)(dst + off) = w;
                }
            }
    }
};
typedef _Float16 h16x8 __attribute__((ext_vector_type(8)));
typedef float f32x8 __attribute__((ext_vector_type(8)));
__device__ __forceinline__ void ld_res16(const _Float16* p, f32x4& a, f32x4& b) { const f32x8 v = __builtin_convertvector(*(const h16x8*)p, f32x8); a = (f32x4){v[0], v[1], v[2], v[3]}; b = (f32x4){v[4], v[5], v[6], v[7]}; }
__device__ __forceinline__ void st_res16(_Float16* p, const f32x4& a, const f32x4& b) { const f32x8 v = {a[0], a[1], a[2], a[3], b[0], b[1], b[2], b[3]}; *(h16x8*)p = __builtin_convertvector(v, h16x8); }
struct EpiOutR {
    static constexpr bool PERM = true, AFTER_DRAIN = false;
    const float* xin; const _Float16* xin16; _Float16* xout; const float* gate; int has_next; const float* g_next; const float* scale_next; bf16_t* xs; float* ssq_next; unsigned* wptr; unsigned wtarget;
    __device__ __forceinline__ void operator()(const f32x4 (&acc)[2][2][4][2], const Unit& u, int wr, int wc, int fr, int fq) const {
        const int row0 = u.pm * BM + wr * 64 + fr, b = u.pm >> 3;
        war_wait(wptr, wtarget);
        const int c0 = u.pn * BM + wc * 32 + 8 * fq;
        f32x4 gt[2][2], gs[2][2];
#pragma unroll
        for (int bj = 0; bj < 2; ++bj)
#pragma unroll
            for (int n = 0; n < 2; ++n) { const int c = c0 + bj * HALF + 4 * n; gt[bj][n] = *(const f32x4*)(gate + (size_t)b * 3072 + c);
                if (has_next) { const f32x4 g = *(const f32x4*)(g_next + c), s = *(const f32x4*)(scale_next + (size_t)b * 3072 + c); gs[bj][n] = g * (1.f + s); } else gs[bj][n] = (f32x4){0.f, 0.f, 0.f, 0.f}; }
#pragma unroll
        for (int aq = 0; aq < 4; ++aq) { const int ai = aq >> 1, mb = (aq & 1) * 2;
            f32x4 xv[4][2][2];
#pragma unroll
            for (int m = mb; m < mb + 2; ++m)
#pragma unroll
                for (int bj = 0; bj < 2; ++bj) { const size_t off = (size_t)(row0 + ai * HALF + m * 16) * 1024 + c0 + bj * HALF;
                    if (xin) { xv[m][bj][0] = *(const f32x4*)(xin + off); xv[m][bj][1] = *(const f32x4*)(xin + off + 4); } else ld_res16(xin16 + off, xv[m][bj][0], xv[m][bj][1]); }
#pragma unroll
            for (int m = mb; m < mb + 2; ++m) {
                const int row = row0 + ai * HALF + m * 16; float ss = 0.f;
#pragma unroll
                for (int bj = 0; bj < 2; ++bj) {
                    const size_t off = (size_t)row * 1024 + c0 + bj * HALF;
                    const f32x4 n0 = xv[m][bj][0] + gt[bj][0] * acc[ai][bj][m][0], n1 = xv[m][bj][1] + gt[bj][1] * acc[ai][bj][m][1];
                    st_res16(xout + off, n0, n1);
                    if (has_next) {
                        ss += (n0[0] * n0[0] + n0[1] * n0[1]) + (n0[2] * n0[2] + n0[3] * n0[3]) + (n1[0] * n1[0] + n1[1] * n1[1]) + (n1[2] * n1[2] + n1[3] * n1[3]);
                        const f32x4 a = n0 * gs[bj][0], c = n1 * gs[bj][1];
                        u32x4 w; w.x = cvt_pk_bf16(a[0], a[1]); w.y = cvt_pk_bf16(a[2], a[3]); w.z = cvt_pk_bf16(c[0], c[1]); w.w = cvt_pk_bf16(c[2], c[3]);
                        *(u32x4*)(xs + off) = w; }
                }
                if (has_next) { ss += __shfl_xor(ss, 16); ss += __shfl_xor(ss, 32); if (fq == 0) atomicAdd(ssq_next + row, ss); }
            }
        }
    }
};

struct EpiOutFinal {
    static constexpr bool PERM = true, AFTER_DRAIN = true;
    const _Float16* xin; float* out; const float* gate; const float* fg; float* xch; unsigned* cnt; unsigned* wptr; unsigned wtarget;
    __device__ __forceinline__ void fused(f32x4 (&acc)[2][2][4][2], const Unit& u, int wr, int wc, int fr, int fq, PG8_LAS unsigned char* lds, int wid, int lane) const {
        PG8_LAS float* P = (PG8_LAS float*)lds; PG8_LAS float* S = (PG8_LAS float*)(lds + 4096);
        const int row0 = u.pm * BM + wr * 64 + fr, b = u.pm >> 3, c0 = u.pn * BM + wc * 32 + 8 * fq;
        f32x4 gt[2][2];
#pragma unroll
        for (int bj = 0; bj < 2; ++bj)
#pragma unroll
            for (int n = 0; n < 2; ++n) gt[bj][n] = *(const f32x4*)(gate + (size_t)b * 3072 + c0 + bj * HALF + 4 * n);
#pragma unroll
        for (int aq = 0; aq < 4; ++aq) { const int ai = aq >> 1, mb = (aq & 1) * 2;
            f32x4 xv[4][2][2];
#pragma unroll
            for (int m = mb; m < mb + 2; ++m)
#pragma unroll
                for (int bj = 0; bj < 2; ++bj) { const size_t off = (size_t)(row0 + ai * HALF + m * 16) * 1024 + c0 + bj * HALF; ld_res16(xin + off, xv[m][bj][0], xv[m][bj][1]); }
#pragma unroll
            for (int m = mb; m < mb + 2; ++m) { const int row = row0 + ai * HALF + m * 16; float ss = 0.f;
#pragma unroll
                for (int bj = 0; bj < 2; ++bj) {
                    const f32x4 n0 = xv[m][bj][0] + gt[bj][0] * acc[ai][bj][m][0], n1 = xv[m][bj][1] + gt[bj][1] * acc[ai][bj][m][1];
                    acc[ai][bj][m][0] = n0; acc[ai][bj][m][1] = n1;
                    ss += (n0[0] * n0[0] + n0[1] * n0[1]) + (n0[2] * n0[2] + n0[3] * n0[3]) + (n1[0] * n1[0] + n1[1] * n1[1]) + (n1[2] * n1[2] + n1[3] * n1[3]); }
                ss += __shfl_xor(ss, 16); ss += __shfl_xor(ss, 32);
                if (fq == 0) P[(ai * HALF + wr * 64 + m * 16 + fr) * 4 + wc] = ss; } }
        asm volatile("s_waitcnt lgkmcnt(0)" ::: "memory"); __builtin_amdgcn_s_barrier(); asm volatile("" ::: "memory");
        const int row = wid * 32 + (lane & 31);
        if (lane < 32) { const float t = (P[row * 4 + 0] + P[row * 4 + 1]) + (P[row * 4 + 2] + P[row * 4 + 3]);
            __hip_atomic_store(xch + (size_t)(u.pm * BM + row) * 4 + u.pn, t, __ATOMIC_RELAXED, __HIP_MEMORY_SCOPE_AGENT); }
        asm volatile("s_waitcnt vmcnt(0)" ::: "memory");
        if (lane == 0) __hip_atomic_fetch_add(cnt + 64 * u.pm, 1u, __ATOMIC_RELAXED, __HIP_MEMORY_SCOPE_AGENT);
        if (wid == 0) { unsigned spins = 0;
            while ((unsigned)__builtin_amdgcn_readfirstlane(__hip_atomic_load(cnt + 64 * u.pm, __ATOMIC_RELAXED, __HIP_MEMORY_SCOPE_AGENT)) < 32u) { __builtin_amdgcn_s_sleep(2); if (++spins > (1u << 22)) break; }
            __builtin_amdgcn_fence(__ATOMIC_ACQUIRE, "agent"); }
        asm volatile("s_waitcnt vmcnt(0) lgkmcnt(0)" ::: "memory"); __builtin_amdgcn_s_barrier(); asm volatile("" ::: "memory");
        if (lane < 32) { const float* slot = xch + (size_t)(u.pm * BM + row) * 4; float tot = 0.f;
#pragma unroll
            for (int t = 0; t < 4; ++t) tot += __hip_atomic_load(slot + t, __ATOMIC_RELAXED, __HIP_MEMORY_SCOPE_AGENT);
            S[row] = rsqrtf(tot * (1.f / 1024.f) + nv::EPS); }
        asm volatile("s_waitcnt vmcnt(0) lgkmcnt(0)" ::: "memory"); __builtin_amdgcn_s_barrier(); asm volatile("" ::: "memory");
        war_wait(wptr, wtarget);
        f32x4 gv[2][2];
#pragma unroll
        for (int bj = 0; bj < 2; ++bj)
#pragma unroll
            for (int n = 0; n < 2; ++n) gv[bj][n] = *(const f32x4*)(fg + c0 + bj * HALF + 4 * n);
#pragma unroll
        for (int ai = 0; ai < 2; ++ai)
#pragma unroll
            for (int m = 0; m < 4; ++m) { const int r = ai * HALF + wr * 64 + m * 16 + fr; const float rs = S[r]; const size_t off = (size_t)(u.pm * BM + r) * 1024 + c0;
#pragma unroll
                for (int bj = 0; bj < 2; ++bj) { *(f32x4*)(out + off + bj * HALF) = acc[ai][bj][m][0] * rs * gv[bj][0]; *(f32x4*)(out + off + bj * HALF + 4) = acc[ai][bj][m][1] * rs * gv[bj][1]; } }
    }
};

template <class Epi, class Sched, bool ALIGN_EPI = false, bool SP2 = false>
__device__ __forceinline__ void gemm_phase(PG8_LAS unsigned char* lds, const Gemm g, const Sched& S, const Epi& E, int wv) {
    int tid_ = wv * 64 + (int)__builtin_amdgcn_mbcnt_hi(~0u, __builtin_amdgcn_mbcnt_lo(~0u, 0u)); asm volatile("" : "+v"(tid_));
    const int tid = tid_, wid = __builtin_amdgcn_readfirstlane(tid >> 6), lane = tid & 63, wr = wid >> 2, wc = wid & 3, fr = lane & 15, fq = lane >> 4;
    const int K = g.K, nt = K / BK;
    unsigned voffA[2], voffB[2];
#pragma unroll
    for (int i = 0; i < 2; ++i) { int R, C; stage_rc(tid * 16 + i * 8192, R, C); const int Rb = Epi::PERM ? ((R & ~31) + perm32(R & 31)) : R;
        voffA[i] = (unsigned)(R * K + C) * 2u; voffB[i] = (unsigned)(Rb * K + C) * 2u; }
    const size_t kstep = (size_t)(BK * 2);
    const size_t hstep = (size_t)HALF * K * 2;
    const size_t tstep = 2 * hstep;
    const unsigned ldsw = (unsigned)wid * 1024u;
    const int aoff = lds_byte(wr * 64 + fr, fq * 8), boff = lds_byte(wc * 32 + fr, fq * 8);
#define PG8_SA(b, h) (((b) * 2 + (h)) * HTB)
#define PG8_SB(b, h) ((4 + (b) * 2 + (h)) * HTB)
#define PG8_STAGE(bufoff, gbase, voff) do { _Pragma("unroll") for (int _i = 0; _i < 2; ++_i) \
        __builtin_amdgcn_global_load_lds((const unsigned*)((const char*)(gbase) + (voff)[_i]), (PG8_LAS unsigned*)(lds + (bufoff) + ldsw + _i * 8192), 16, 0, 0); } while (0)
#define PG8_LDA(dst, b, h) do { _Pragma("unroll") for (int m = 0; m < 4; ++m) _Pragma("unroll") for (int k = 0; k < 2; ++k) dst[m][k] = *(const PG8_LAS bf16x8*)(lds + PG8_SA(b, h) + aoff + m * 2048 + k * 1024); } while (0)
#define PG8_LDB(dst, b, h) do { _Pragma("unroll") for (int n = 0; n < 2; ++n) _Pragma("unroll") for (int k = 0; k < 2; ++k) dst[n][k] = *(const PG8_LAS bf16x8*)(lds + PG8_SB(b, h) + boff + n * 2048 + k * 1024); } while (0)
#define PG8_MMA(ai, bj, At, Bt) do { __builtin_amdgcn_s_setprio(1); _Pragma("unroll") for (int m = 0; m < 4; ++m) _Pragma("unroll") for (int n = 0; n < 2; ++n) _Pragma("unroll") for (int k = 0; k < 2; ++k) \
        acc[ai][bj][m][n] = __builtin_amdgcn_mfma_f32_16x16x32_bf16(Bt[n][k], At[m][k], acc[ai][bj][m][n], 0, 0, 0); __builtin_amdgcn_s_setprio(0); } while (0)
#define PG8_WAIT_V(n) asm volatile("s_waitcnt vmcnt(" #n ")" ::: "memory")
#define PG8_WAIT_L(n) asm volatile("s_waitcnt lgkmcnt(" #n ")" ::: "memory")
#define PG8_BAR __builtin_amdgcn_s_barrier()
#define PG8_SCHED __builtin_amdgcn_sched_barrier(0)
    Unit cur, nxt; int ui = 0;
    if (!S.next(0, cur)) return;
    f32x4 acc[2][2][4][2];
#pragma unroll
    for (int a = 0; a < 2; ++a)
#pragma unroll
        for (int b = 0; b < 2; ++b)
#pragma unroll
            for (int m = 0; m < 4; ++m)
#pragma unroll
                for (int n = 0; n < 2; ++n) acc[a][b][m][n] = (f32x4){0.f, 0.f, 0.f, 0.f};
    bf16x8 At[4][2], B0[2][2], B1[2][2];
    const char* cA = (const char*)g.A + (size_t)cur.pm * tstep; const char* cB = (const char*)g.Bt + (size_t)cur.pn * tstep;
    S.a_ready(cur);
    if constexpr (SP2) {
        PG8_STAGE(PG8_SB(0, 0), cB, voffB); PG8_STAGE(PG8_SB(0, 1), cB + hstep, voffB); PG8_STAGE(PG8_SA(0, 0), cA, voffA); PG8_STAGE(PG8_SA(0, 1), cA + hstep, voffA);
        if (wr == 1) PG8_BAR;
        PG8_WAIT_V(2); PG8_BAR;
        PG8_STAGE(PG8_SB(1, 0), cB + kstep, voffB); PG8_STAGE(PG8_SA(1, 0), cA + kstep, voffA); PG8_STAGE(PG8_SB(1, 1), cB + hstep + kstep, voffB);
        PG8_WAIT_V(6); PG8_BAR;
    } else {
        PG8_STAGE(PG8_SB(0, 0), cB, voffB); PG8_STAGE(PG8_SA(0, 0), cA, voffA); PG8_STAGE(PG8_SB(0, 1), cB + hstep, voffB); PG8_STAGE(PG8_SA(0, 1), cA + hstep, voffA);
        if (wr == 1) PG8_BAR;
        PG8_WAIT_V(4); PG8_BAR;
        PG8_STAGE(PG8_SB(1, 0), cB + kstep, voffB); PG8_STAGE(PG8_SA(1, 0), cA + kstep, voffA); PG8_STAGE(PG8_SB(1, 1), cB + hstep + kstep, voffB);
        PG8_WAIT_V(6); PG8_BAR;
    }
    for (;;) {
        const bool has_next = S.next(ui + 1, nxt);
        const char* nA = has_next ? (const char*)g.A + (size_t)nxt.pm * tstep : cA; const char* nB = has_next ? (const char*)g.Bt + (size_t)nxt.pn * tstep : cB;
        for (int t = 0; t < nt; t += 2) {
            const bool last = (t == nt - 2);
            const char* a1 = cA + (size_t)(t + 1) * kstep;
            const char* a2 = last ? nA : cA + (size_t)(t + 2) * kstep; const char* b2 = last ? nB : cB + (size_t)(t + 2) * kstep;
            const char* a3 = a2 + kstep; const char* b3 = b2 + kstep;
            if (last && has_next) S.a_ready(nxt);
            if constexpr (SP2) {
            PG8_LDB(B0, 0, 0); PG8_LDB(B1, 0, 1); PG8_SCHED; PG8_LDA(At, 0, 0); PG8_STAGE(PG8_SA(1, 1), a1 + hstep, voffA);
            PG8_WAIT_V(8); PG8_WAIT_L(0); PG8_BAR; PG8_MMA(0, 0, At, B0); PG8_MMA(0, 1, At, B1); PG8_BAR; PG8_SCHED;
            PG8_LDA(At, 0, 1); PG8_STAGE(PG8_SB(0, 0), b2, voffB); PG8_STAGE(PG8_SB(0, 1), b2 + hstep, voffB); PG8_STAGE(PG8_SA(0, 0), a2, voffA);
            PG8_WAIT_V(8); PG8_WAIT_L(0); PG8_BAR; PG8_MMA(1, 0, At, B0); PG8_MMA(1, 1, At, B1); PG8_BAR; PG8_SCHED;
            PG8_LDB(B0, 1, 0); PG8_LDB(B1, 1, 1); PG8_SCHED; PG8_LDA(At, 1, 0); PG8_STAGE(PG8_SA(0, 1), a2 + hstep, voffA);
            PG8_WAIT_V(8); PG8_WAIT_L(0); PG8_BAR; PG8_MMA(0, 0, At, B0); PG8_MMA(0, 1, At, B1); PG8_BAR; PG8_SCHED;
            PG8_LDA(At, 1, 1); PG8_STAGE(PG8_SB(1, 0), b3, voffB); PG8_STAGE(PG8_SB(1, 1), b3 + hstep, voffB); PG8_STAGE(PG8_SA(1, 0), a3, voffA);
            PG8_WAIT_V(8); PG8_WAIT_L(0); PG8_BAR; PG8_MMA(1, 0, At, B0); PG8_MMA(1, 1, At, B1); PG8_BAR; PG8_SCHED;
            } else {
            PG8_LDB(B0, 0, 0); PG8_SCHED; PG8_LDA(At, 0, 0); PG8_STAGE(PG8_SA(1, 1), a1 + hstep, voffA);
            PG8_WAIT_L(8); PG8_BAR; PG8_WAIT_L(0); PG8_MMA(0, 0, At, B0); PG8_BAR; PG8_SCHED;
            PG8_LDB(B1, 0, 1); PG8_STAGE(PG8_SB(0, 0), b2, voffB);
            PG8_BAR; PG8_WAIT_L(0); PG8_MMA(0, 1, At, B1); PG8_BAR;
            PG8_LDA(At, 0, 1); PG8_STAGE(PG8_SA(0, 0), a2, voffA);
            PG8_BAR; PG8_WAIT_L(0); PG8_MMA(1, 0, At, B0); PG8_BAR; PG8_SCHED;
            PG8_STAGE(PG8_SB(0, 1), b2 + hstep, voffB);
            PG8_WAIT_V(6); PG8_BAR; PG8_MMA(1, 1, At, B1); PG8_BAR;
            PG8_LDB(B0, 1, 0); PG8_SCHED; PG8_LDA(At, 1, 0); PG8_STAGE(PG8_SA(0, 1), a2 + hstep, voffA);
            PG8_WAIT_L(8); PG8_BAR; PG8_WAIT_L(0); PG8_MMA(0, 0, At, B0); PG8_BAR; PG8_SCHED;
            PG8_LDB(B1, 1, 1); PG8_STAGE(PG8_SB(1, 0), b3, voffB);
            PG8_BAR; PG8_WAIT_L(0); PG8_MMA(0, 1, At, B1); PG8_BAR;
            PG8_LDA(At, 1, 1); PG8_STAGE(PG8_SA(1, 0), a3, voffA);
            PG8_BAR; PG8_WAIT_L(0); PG8_MMA(1, 0, At, B0); PG8_BAR; PG8_SCHED;
            PG8_STAGE(PG8_SB(1, 1), b3 + hstep, voffB);
            PG8_WAIT_V(6); PG8_BAR; PG8_MMA(1, 1, At, B1); PG8_BAR;
            }
        }
        if constexpr (ALIGN_EPI) { if (wr == 0) PG8_BAR; }
        if constexpr (!Epi::AFTER_DRAIN) { E(acc, cur, wr, wc, fr, fq); S.done(cur); if constexpr (has_hook<Sched>::v) S.after(ui, lane); }
        if (!has_next) break;
#pragma unroll
        for (int a = 0; a < 2; ++a)
#pragma unroll
            for (int b = 0; b < 2; ++b)
#pragma unroll
                for (int m = 0; m < 4; ++m)
#pragma unroll
                    for (int n = 0; n < 2; ++n) acc[a][b][m][n] = (f32x4){0.f, 0.f, 0.f, 0.f};
        cur = nxt; cA = nA; cB = nB; ++ui;
        if constexpr (ALIGN_EPI) { if (wr == 1) PG8_BAR; }
    }
    PG8_WAIT_V(0);
    if constexpr (!ALIGN_EPI) { if (wr == 0) PG8_BAR; }
    PG8_BAR;
    if constexpr (Epi::AFTER_DRAIN) { E.fused(acc, cur, wr, wc, fr, fq, lds, wid, lane); S.done(cur); }
#undef PG8_SA
#undef PG8_SB
#undef PG8_STAGE
#undef PG8_LDA
#undef PG8_LDB
#undef PG8_MMA
#undef PG8_WAIT_V
#undef PG8_WAIT_L
#undef PG8_BAR
#undef PG8_SCHED
}
}

namespace mk {
using nv::pi16; using nv::bf16; using nv::S_; using nv::D_; using nv::M_; using nv::LOG2E; using nv::QSCALE; using nv::EPS;
#define GAS __attribute__((address_space(1)))
#define LAS __attribute__((address_space(3)))
typedef unsigned v4u __attribute__((ext_vector_type(4)));
typedef unsigned v2u __attribute__((ext_vector_type(2)));
typedef float f32x4 __attribute__((ext_vector_type(4)));
constexpr int NWAVES = 8;
using namespace lay;
constexpr int RING_BYTES = 131072, LDSCTL_OFF = RING_BYTES, MISC_OFF = LDSCTL_OFF + 320, LDS_BYTES = 147456;

#define RLX_AGENT __ATOMIC_RELAXED, __HIP_MEMORY_SCOPE_AGENT
#define LDS_WAIT() asm volatile("s_waitcnt lgkmcnt(0)" ::: "memory")
#define VM_WAIT() asm volatile("s_waitcnt vmcnt(0)" ::: "memory")
__device__ __forceinline__ unsigned f2bfu(float f) { unsigned u = __builtin_bit_cast(unsigned, f); return (u + 0x7fffu + ((u >> 16) & 1u)) >> 16; }
__device__ __forceinline__ unsigned pk2(float lo, float hi) { return f2bfu(lo) | (f2bfu(hi) << 16); }
__device__ __forceinline__ float wsum(float v) {
#pragma unroll
    for (int o = 1; o < 64; o <<= 1) v += __shfl_xor(v, o);
    return v; }
__device__ __forceinline__ float silu_f(float x) { return x * __builtin_amdgcn_rcpf(1.f + __builtin_amdgcn_exp2f(-x * LOG2E)); }

#define XB_TMO      128
#define XB_XCNT(j)  (256  + 64 * (j))
#define XB_XSUB(j)  (1280 + 64 * (j))
#define XB_XGEN(j)  (2304 + 64 * (j))
#define XB_TOP      3328
#define XB_TOPGEN   3392
#define XCD_BAR_WORDS 3456
#define XB_SPIN_CAP (1u << 18)

__device__ __forceinline__ unsigned xb_ld(unsigned* p)              { return __hip_atomic_load(p, __ATOMIC_RELAXED, __HIP_MEMORY_SCOPE_AGENT); }
__device__ __forceinline__ unsigned xb_add(unsigned* p, unsigned v) { return __hip_atomic_fetch_add(p, v, __ATOMIC_RELAXED, __HIP_MEMORY_SCOPE_AGENT); }
__device__ __forceinline__ unsigned xb_xcc_id() { return (unsigned)__builtin_amdgcn_s_getreg((3 << 11) | 20) & 0xFu; }
#define XB_SPIN(cond, bar) do { unsigned _sp = 0; while (cond) { __builtin_amdgcn_s_sleep(1); \
    if ((++_sp & 255u) == 0u) { if (xb_ld(&(bar)[XB_TMO])) break; if (_sp > XB_SPIN_CAP) { atomicAdd(&(bar)[XB_TMO], 1u); break; } } } } while (0)

__device__ __forceinline__ bool wg_leader(int wave) { return wave == 0 && __builtin_amdgcn_mbcnt_hi(~0u, __builtin_amdgcn_mbcnt_lo(~0u, 0u)) == 0u; }
struct XcdBarrier {
    int wave;
    unsigned* bar; unsigned x;
    volatile LAS unsigned* st;
};

__device__ __forceinline__ XcdBarrier xcd_barrier_post(unsigned* bar, volatile LAS unsigned* st, int wave) {
    XcdBarrier b; b.wave = wave; b.bar = bar; b.x = xb_xcc_id(); b.st = st;
    if (wg_leader(wave)) (void)xb_add(&bar[XB_XCNT(b.x)], 1u);
    return b;
}
__device__ __forceinline__ void xcd_barrier_complete(unsigned* bar, unsigned x, unsigned& nloc, unsigned& nx) {
    const unsigned G = gridDim.x * gridDim.y * gridDim.z;
    unsigned sum, cnt, mine, sp = 0u;
    for (;;) {
        sum = 0u; cnt = 0u; mine = 0u;
#pragma unroll
        for (unsigned j = 0; j < 16; ++j) { const unsigned c = xb_ld(&bar[XB_XCNT(j)]); sum += c; cnt += (c > 0u) ? 1u : 0u; mine = (j == x) ? c : mine; }
        if (sum == G) break;
        __builtin_amdgcn_s_sleep(1);
        if ((++sp & 255u) == 0u) { if (xb_ld(&bar[XB_TMO])) break; if (sp > XB_SPIN_CAP) { atomicAdd(&bar[XB_TMO], 1u); break; } }
    }
    nloc = mine > 0u ? mine : 1u; nx = cnt > 0u ? cnt : 1u;
}

__device__ __forceinline__ void xcd_barrier(const XcdBarrier& b) {
    asm volatile("s_waitcnt vmcnt(0)" ::: "memory");
    __syncthreads();
    if (wg_leader(b.wave)) {
        unsigned* bar = b.bar;
        __builtin_amdgcn_s_waitcnt(0);
        unsigned nloc = b.st[0], nx = b.st[1];
        if (nloc == 0u) { xcd_barrier_complete(bar, b.x, nloc, nx); b.st[0] = nloc; b.st[1] = nx; }
        const unsigned old = xb_add(&bar[XB_XSUB(b.x)], 1u);
        const unsigned gen = old / nloc;
        if (old + 1u == (gen + 1u) * nloc) {
            __builtin_amdgcn_fence(__ATOMIC_RELEASE, "agent");
            asm volatile("s_waitcnt vmcnt(0)" ::: "memory");
            const unsigned og = xb_add(&bar[XB_TOP], 1u);
            const unsigned tg = og / nx;
            if (og + 1u == (tg + 1u) * nx) xb_add(&bar[XB_TOPGEN], 1u);
            else XB_SPIN(xb_ld(&bar[XB_TOPGEN]) == tg, bar);
            __builtin_amdgcn_fence(__ATOMIC_ACQUIRE, "agent");
            xb_add(&bar[XB_XGEN(b.x)], 1u);
            asm volatile("s_waitcnt vmcnt(0)" ::: "memory");
        } else {
            XB_SPIN(xb_ld(&bar[XB_XGEN(b.x)]) == gen, bar);
            __builtin_amdgcn_fence(__ATOMIC_ACQUIRE, "agent");
            asm volatile("s_waitcnt vmcnt(0)" ::: "memory");
        }
    }
    __syncthreads();
}


__device__ __forceinline__ void p0_transpose_item(const float* W, int K, int N, bf16* WT, LAS float* scr, int item, int lane) {
    const int nblk = N / 32, kb = item / nblk, nb = item % nblk, k0 = 64 * kb, n0 = 32 * nb;
#pragma unroll 8
    for (int i = 0; i < 32; ++i) { const int kk = 2 * i + (lane >> 5); scr[kk * 33 + (lane & 31)] = W[(size_t)(k0 + kk) * N + n0 + (lane & 31)]; }
    LDS_WAIT(); asm volatile("" ::: "memory");
    const int c = lane & 7;
#pragma unroll
    for (int j = 0; j < 4; ++j) { const int n = (lane >> 3) + 8 * j; const LAS float* s = scr + (8 * c) * 33 + n;
        v4u o; o.x = pk2(s[0 * 33], s[1 * 33]); o.y = pk2(s[2 * 33], s[3 * 33]); o.z = pk2(s[4 * 33], s[5 * 33]); o.w = pk2(s[6 * 33], s[7 * 33]);
        *(GAS v4u*)(WT + (size_t)(n0 + n) * K + k0 + 8 * c) = o; }
    LDS_WAIT(); asm volatile("" ::: "memory");
}
__device__ __forceinline__ void gemv8_item(const float* W, int ldw, int n0, const LAS float* vec, LAS float* red, const float* bias, float* out, int ldo, int wave, int lane) {
    float acc[8];
#pragma unroll
    for (int b = 0; b < 8; ++b) acc[b] = 0.f;
    const float* wp = W + (size_t)(wave * 128) * ldw + n0 + lane;
#pragma unroll 8
    for (int kk = 0; kk < 128; ++kk) { const float w = wp[(size_t)kk * ldw]; const int k = wave * 128 + kk;
#pragma unroll
        for (int b = 0; b < 8; ++b) acc[b] += vec[b * 1024 + k] * w; }
#pragma unroll
    for (int b = 0; b < 8; ++b) red[(wave * 8 + b) * 64 + lane] = acc[b];
    __syncthreads();
    { float s = 0.f;
#pragma unroll
      for (int w = 0; w < 8; ++w) s += red[(w * 8 + wave) * 64 + lane];
      out[(size_t)wave * ldo + n0 + lane] = s + (bias ? bias[n0 + lane] : 0.f); }
    __syncthreads();
}

typedef short bf16x8 __attribute__((ext_vector_type(8)));
typedef short s16x4 __attribute__((ext_vector_type(4)));
typedef short v4i16_t __attribute__((ext_vector_type(4)));
typedef float f32x16 __attribute__((ext_vector_type(16)));
constexpr float NEGBIG = -1e30f;
constexpr float THR = 8.f;
__device__ __forceinline__ int crow(int r, int hi) { return (r & 3) + 8 * (r >> 2) + 4 * hi; }
__device__ __forceinline__ unsigned cvtpk_c(float lo, float hi) { typedef float f2_t __attribute__((ext_vector_type(2))); typedef __bf16 b2_t __attribute__((ext_vector_type(2)));
    f2_t v = {lo, hi}; b2_t bb = __builtin_convertvector(v, b2_t); return __builtin_bit_cast(unsigned, bb); }
__device__ __forceinline__ float swapmax(float v) { auto rr = __builtin_amdgcn_permlane32_swap(__float_as_uint(v), __float_as_uint(v), false, false); return fmaxf(__uint_as_float(rr[0]), __uint_as_float(rr[1])); }
__device__ __forceinline__ float swapsum(float v) { auto rr = __builtin_amdgcn_permlane32_swap(__float_as_uint(v), __float_as_uint(v), false, false); return __uint_as_float(rr[0]) + __uint_as_float(rr[1]); }
__device__ __forceinline__ s16x4 vtr(const LAS char* p) { return __builtin_bit_cast(s16x4, __builtin_amdgcn_ds_read_tr16_b64_v4i16((LAS v4i16_t*)p)); }
__device__ __forceinline__ float max3(float a, float b, float c) { return fmaxf(fmaxf(a, b), c); }
__device__ __forceinline__ float rowmax16(const f32x16& p) {
    const float a = max3(p[0], p[1], p[2]), b = max3(p[3], p[4], p[5]), c = max3(p[6], p[7], p[8]), d = max3(p[9], p[10], p[11]), e = max3(p[12], p[13], p[14]);
    return max3(max3(a, b, c), max3(d, e, p[15]), a); }
__device__ __forceinline__ float rowsum16(const f32x16& p) {
    typedef float f2v __attribute__((ext_vector_type(2)));
    const f2v a = (f2v){p[0], p[1]} + (f2v){p[2], p[3]}, b = (f2v){p[4], p[5]} + (f2v){p[6], p[7]}, c = (f2v){p[8], p[9]} + (f2v){p[10], p[11]}, d = (f2v){p[12], p[13]} + (f2v){p[14], p[15]};
    const f2v e = (a + b) + (c + d); return e.x + e.y; }
__device__ __forceinline__ float rowsum32(const f32x16& p, const f32x16& q) {
    typedef float f2v __attribute__((ext_vector_type(2)));
    f2v a = (f2v){p[0], p[1]} + (f2v){q[0], q[1]};
#pragma unroll
    for (int i = 1; i < 8; ++i) a = a + ((f2v){p[2 * i], p[2 * i + 1]} + (f2v){q[2 * i], q[2 * i + 1]});
    return a.x + a.y; }
__device__ __forceinline__ void glds16(const void* gsrc, LAS unsigned char* dst_uniform) {
    __builtin_amdgcn_global_load_lds((const unsigned*)gsrc, (LAS unsigned*)dst_uniform, 16, 0, 0);
}
__device__ __forceinline__ void glds16_asm_s(unsigned voff, const void* sbase_uniform, unsigned lds_dst_uniform) { unsigned keep;
    asm volatile("s_mov_b32 %0, m0\n\ts_mov_b32 m0, %3\n\ts_nop 0\n\tglobal_load_lds_dwordx4 %1, %2\n\ts_mov_b32 m0, %0" : "=&s"(keep) : "v"(voff), "s"(sbase_uniform), "s"(lds_dst_uniform) : "memory"); }

template <int DV> struct WState { bf16x8 qr[4]; f32x16 o[DV / 32]; float m, l; };
__device__ __forceinline__ void q_fetch(bf16x8 (&q)[4], const bf16* qrow  ) {
#pragma unroll
    for (int d0 = 0; d0 < 4; ++d0) q[d0] = *(const bf16x8*)(qrow + d0 * 16);
}
template <int DV> __device__ __forceinline__ void w_begin(WState<DV>& w, const bf16x8 (&q)[4]) {
#pragma unroll
    for (int d0 = 0; d0 < 4; ++d0) { w.qr[d0] = q[d0]; asm volatile("" : "+v"(w.qr[d0])); }
#pragma unroll
    for (int d = 0; d < DV / 32; ++d)
#pragma unroll
        for (int r = 0; r < 16; ++r) w.o[d][r] = 0.f;
    w.m = 0.f; w.l = 0.f;
}
__device__ __forceinline__ int v_rd_base(int lane) { return ((lane >> 4) & 1) * 32 + (lane & 3) * 8 + (4 * (lane >> 5) + ((lane & 15) >> 2)) * 64; }
constexpr int VHI = 512;
#define PK4(P, BASE, OUT) do { v4u wv = {cvtpk_c(P[BASE + 0], P[BASE + 1]), cvtpk_c(P[BASE + 2], P[BASE + 3]), cvtpk_c(P[BASE + 4], P[BASE + 5]), cvtpk_c(P[BASE + 6], P[BASE + 7])}; \
    OUT = __builtin_bit_cast(bf16x8, wv); } while (0)
typedef float f2_t __attribute__((ext_vector_type(2)));
#define P2_(p, i) ((f2_t){p[2 * (i)], p[2 * (i) + 1]})

template <int DV, bool FIRST, class MaskF>
__device__ __forceinline__ void step32(WState<DV>& w, const LAS char* kb, const LAS char* vb, const f32x16& R, float doff, bool mixed, MaskF mf, int lane) {
    const int r32 = lane & 31, hi = lane >> 5;
    f32x16 p; const float mref = FIRST ? 0.f : w.m;
    if (!mixed) { const float sgn = doff > 0.f ? -1.f : 1.f, add = -fabsf(doff) - mref;
#pragma unroll
        for (int i = 0; i < 8; ++i) { const f2_t v = P2_(R, i) * sgn + add; p[2 * i] = v.x; p[2 * i + 1] = v.y; } }
    else {
#pragma unroll
        for (int r = 0; r < 16; ++r) p[r] = -fabsf(R[r] + doff) - mref; }
    { const LAS char* krow = kb + r32 * 128; const int ksw = (r32 >> 1) & 7;
      bf16x8 kf[4];
#pragma unroll
      for (int d0 = 0; d0 < 4; ++d0) kf[d0] = *(const LAS bf16x8*)(krow + (((2 * d0 + hi) ^ ksw) << 4));
#pragma unroll
      for (int d0 = 0; d0 < 4; ++d0) p = __builtin_amdgcn_mfma_f32_32x32x16_bf16(kf[d0], w.qr[d0], p, 0, 0, 0); }
    if (mf.on) mf(p);
    const float pmax = swapmax(rowmax16(p));
    if (FIRST) { w.m = pmax;
#pragma unroll
        for (int r = 0; r < 16; ++r) p[r] -= pmax; }
    else if (__any(pmax > THR)) { const float inc = pmax > THR ? pmax : 0.f, alpha = __builtin_amdgcn_exp2f(-inc); w.m += inc; w.l *= alpha;
#pragma unroll
        for (int r = 0; r < 16; ++r) p[r] -= inc;
#pragma unroll
        for (int d = 0; d < DV / 32; ++d)
#pragma unroll
            for (int r = 0; r < 16; ++r) w.o[d][r] *= alpha; }
#pragma unroll
    for (int r = 0; r < 16; ++r) p[r] = __builtin_amdgcn_exp2f(p[r]);
    w.l += swapsum(rowsum16(p));
    bf16x8 pa0, pa1; PK4(p, 0, pa0); PK4(p, 8, pa1);
    const LAS char* vbase = vb + v_rd_base(lane);
#pragma unroll
    for (int d = 0; d < DV / 32; ++d) {
        const s16x4 l0 = vtr(vbase + d * 2048), h0 = vtr(vbase + d * 2048 + VHI), l1 = vtr(vbase + d * 2048 + 1024), h1 = vtr(vbase + d * 2048 + 1024 + VHI);
        const bf16x8 v0 = (bf16x8){l0[0], l0[1], l0[2], l0[3], h0[0], h0[1], h0[2], h0[3]}, v1 = (bf16x8){l1[0], l1[1], l1[2], l1[3], h1[0], h1[1], h1[2], h1[3]};
        w.o[d] = __builtin_amdgcn_mfma_f32_32x32x16_bf16(v0, pa0, w.o[d], 0, 0, 0);
        w.o[d] = __builtin_amdgcn_mfma_f32_32x32x16_bf16(v1, pa1, w.o[d], 0, 0, 0);
    }
}
struct NoMask { static constexpr bool on = false; __device__ __forceinline__ void operator()(f32x16&) const {} };

#define ROLE_OF(wave) ((wave) >> 2)
#define ATT_WAIT_BAR(N) asm volatile("s_waitcnt vmcnt(" #N ") lgkmcnt(0)\n\ts_barrier" ::: "memory")
__device__ __forceinline__ void diff_unit(LAS unsigned char* lds, int b, int h, int qt, const bf16* QB, const bf16* KB, const bf16* VB, const bf16* SG,
                                          const float* subln_g, float lam, float lam_init, bf16* YM, int wv) {
    int tid = wv * 64 + (int)__builtin_amdgcn_mbcnt_hi(~0u, __builtin_amdgcn_mbcnt_lo(~0u, 0u)); asm volatile("" : "+v"(tid));
    const int lane = tid & 63, wave = __builtin_amdgcn_readfirstlane(tid >> 6), r32 = lane & 31, hi = lane >> 5;
    const int which = wave >> 2, sub = wave & 3, q0 = qt * 128 + sub * 32;
    const float slope = __builtin_amdgcn_exp2f(-2.f * (float)(h + 1)) * LOG2E;
    const bf16* K1 = KB + (size_t)(b * 8 + h * 2) * S_ * 64; const bf16* Vh = VB + (size_t)(b * 4 + h) * S_ * 128;
    unsigned offK, offV0, offV1, dstK, dstV0, dstV1;
    { const int kkb = 8 * (wave & 3) + (lane >> 3), c = (lane & 7) ^ ((kkb >> 1) & 7);
      offK = (unsigned)((8 * wave + (lane >> 3)) * 64 + c * 8) * 2u; dstK = wave * 1024;
      const int v0 = wave, v1 = wave + 8;
      offV0 = (unsigned)((32 * (v0 >> 3) + 16 * (v0 & 1) + (lane >> 2)) * 128 + ((v0 >> 1) & 3) * 32 + (lane & 3) * 8) * 2u; dstV0 = 16384 + (v0 >> 3) * 8192 + ((v0 >> 1) & 3) * 2048 + (v0 & 1) * 1024;
      offV1 = (unsigned)((32 * (v1 >> 3) + 16 * (v1 & 1) + (lane >> 2)) * 128 + ((v1 >> 1) & 3) * 32 + (lane & 3) * 8) * 2u; dstV1 = 16384 + (v1 >> 3) * 8192 + ((v1 >> 1) & 3) * 2048 + (v1 & 1) * 1024; }
    const unsigned lds0 = (unsigned)(uintptr_t)lds;
    constexpr int NT = S_ / 64;
    const int tdb = 2 * qt;
#define TILE_OF(i) ((i) < 2 ? tdb + (i) : ((i) - 2 < tdb ? (i) - 2 : (i)))
#define RFL(x) ((unsigned)__builtin_amdgcn_readfirstlane((int)(x)))
#define DDMA(i) do { const int ii_ = (i) < NT ? (i) : NT - 1; const int ts_ = TILE_OF(ii_); const unsigned bb_ = RFL(lds0 + (unsigned)(((i) & 3) * 32768)); \
        const char* kb_ = (const char*)K1 + (size_t)ts_ * 8192; const char* vb_ = (const char*)Vh + (size_t)ts_ * 16384; \
        glds16_asm_s(offK, kb_, RFL(bb_ + dstK)); glds16_asm_s(offK, kb_ + (size_t)S_ * 128, RFL(bb_ + 8192u + dstK)); \
        glds16_asm_s(offV0, vb_, RFL(bb_ + dstV0)); glds16_asm_s(offV1, vb_, RFL(bb_ + dstV1)); } while (0)
    DDMA(0); DDMA(1);
    WState<128> w;
    { bf16x8 q[4]; q_fetch(q, QB + ((size_t)(b * 8 + h * 2 + which) * S_ + q0 + r32) * 64 + hi * 8); w_begin<128>(w, q); }
    const float basef = (float)(4 * hi - r32);
    f32x16 Tr;
#pragma unroll
    for (int r = 0; r < 16; ++r) Tr[r] = slope * (basef + 64.f + (float)((r & 3) + 8 * (r >> 2)));
    f32x16 p0, p1, e0, e1; bf16x8 pa0, pa1, pa2, pa3;
#define KB_(i) ((const LAS char*)(lds + ((i) & 3) * 32768) + which * 8192)
#define VB_(i) ((const LAS char*)(lds + ((i) & 3) * 32768) + 16384)
    struct F4 { bf16x8 a, b, c, d; };
    const int ksw = (r32 >> 1) & 7;
#define SB_() __builtin_amdgcn_sched_barrier(0)
#define CR_(r) ((float)(((r) & 3) + 8 * ((r) >> 2)))
#define CTILE(E, dk, MREF) do { const int dki_ = (dk); const float dk_ = (float)dki_; \
        if (dki_ >= 64)       { const float ad_ = -slope * (dk_ - 64.f) - (MREF); _Pragma("unroll") for (int i = 0; i < 8; ++i) { const f2_t v = ad_ - P2_(Tr, i); E[2 * i] = v.x; E[2 * i + 1] = v.y; } } \
        else if (dki_ <= -64) { const float ad_ = slope * (dk_ - 64.f) - (MREF); _Pragma("unroll") for (int i = 0; i < 8; ++i) { const f2_t v = ad_ + P2_(Tr, i); E[2 * i] = v.x; E[2 * i + 1] = v.y; } } \
        else { const float sb_ = slope * (dk_ - 64.f), mr_ = (MREF); _Pragma("unroll") for (int r = 0; r < 16; ++r) E[r] = -fabsf(Tr[r] + sb_) - mr_; } } while (0)
#define VF_(P) (bf16x8){lo_[0], lo_[1], lo_[2], lo_[3], hi_[0], hi_[1], hi_[2], hi_[3]}
#define LDV1(DST, OFF) do { const s16x4 lo_ = vtr(vbp + (OFF)), hi_ = vtr(vbp + (OFF) + VHI); DST = VF_(0); } while (0)
#define LOADV(F, DI) do { LDV1(F.a, (DI) * 2048); LDV1(F.b, (DI) * 2048 + 1024); LDV1(F.c, 8192 + (DI) * 2048); LDV1(F.d, 8192 + (DI) * 2048 + 1024); } while (0)
#define KCO_(d0) (((2 * (d0) + hi) ^ ksw) << 4)
#define LOADK(F, dp) do { F.a = *(const LAS bf16x8*)(kbp + KCO_(2 * (dp))); F.b = *(const LAS bf16x8*)(kbp + 4096 + KCO_(2 * (dp))); \
        F.c = *(const LAS bf16x8*)(kbp + KCO_(2 * (dp) + 1)); F.d = *(const LAS bf16x8*)(kbp + 4096 + KCO_(2 * (dp) + 1)); } while (0)
#define PVM(F, DI) do { w.o[DI] = __builtin_amdgcn_mfma_f32_32x32x16_bf16(F.a, pa0, w.o[DI], 0, 0, 0); w.o[DI] = __builtin_amdgcn_mfma_f32_32x32x16_bf16(F.b, pa1, w.o[DI], 0, 0, 0); \
        w.o[DI] = __builtin_amdgcn_mfma_f32_32x32x16_bf16(F.c, pa2, w.o[DI], 0, 0, 0); w.o[DI] = __builtin_amdgcn_mfma_f32_32x32x16_bf16(F.d, pa3, w.o[DI], 0, 0, 0); } while (0)
#define QKM(F, dp, C0, C1) do { p0 = __builtin_amdgcn_mfma_f32_32x32x16_bf16(F.a, w.qr[2 * (dp)], C0, 0, 0, 0); p1 = __builtin_amdgcn_mfma_f32_32x32x16_bf16(F.b, w.qr[2 * (dp)], C1, 0, 0, 0); \
        p0 = __builtin_amdgcn_mfma_f32_32x32x16_bf16(F.c, w.qr[2 * (dp) + 1], p0, 0, 0, 0); p1 = __builtin_amdgcn_mfma_f32_32x32x16_bf16(F.d, w.qr[2 * (dp) + 1], p1, 0, 0, 0); } while (0)
#define SOFTMAX_SEG(FIRST_, inext, icur) do { const float pmax = swapmax(fmaxf(rowmax16(p0), rowmax16(p1))); skp = !(FIRST_) && __all(pmax < SKIP_BELOW); \
        if (!skp) { \
        if (FIRST_) { w.m = pmax; _Pragma("unroll") for (int r = 0; r < 16; ++r) { p0[r] -= pmax; p1[r] -= pmax; } } \
        else if (__any(pmax > THR)) { const float inc = pmax > THR ? pmax : 0.f, alpha = __builtin_amdgcn_exp2f(-inc); w.m += inc; w.l *= alpha; \
            _Pragma("unroll") for (int r = 0; r < 16; ++r) { p0[r] -= inc; p1[r] -= inc; } \
            _Pragma("unroll") for (int dd = 0; dd < 4; ++dd) _Pragma("unroll") for (int r = 0; r < 16; ++r) w.o[dd][r] *= alpha; } \
        _Pragma("unroll") for (int r = 0; r < 16; ++r) { p0[r] = __builtin_amdgcn_exp2f(p0[r]); p1[r] = __builtin_amdgcn_exp2f(p1[r]); } \
        w.l += swapsum(rowsum32(p0, p1)); \
        PK4(p0, 0, pa0); PK4(p0, 8, pa1); PK4(p1, 0, pa2); PK4(p1, 8, pa3); \
        { const LAS char* vbp = VB_(icur) + v_rd_base(lane); LOADV(X, 0); LOADV(Y, 1); } }     \
        { const int tn_ = TILE_OF((inext) < NT ? (inext) : NT - 1); CTILE(e0, tn_ * 64 - q0, w.m); CTILE(e1, tn_ * 64 + 32 - q0, w.m); } } while (0)
    constexpr float SKIP_BELOW = -28.f; bool skp = false;
    CTILE(e0, tdb * 64 - q0, 0.f); CTILE(e1, tdb * 64 + 32 - q0, 0.f);
#define MSEG(i) do { const LAS char* vbp = VB_((i) - 1) + v_rd_base(lane); const LAS char* kbp = KB_(i) + r32 * 128; \
        if ((i) > 0 && !skp) { LOADV(Z, 2); PVM(X, 0); LOADV(X, 3); PVM(Y, 1); PVM(Z, 2); PVM(X, 3); } \
        LOADK(Y, 0); LOADK(Z, 1); QKM(Y, 0, e0, e1); QKM(Z, 1, p0, p1); } while (0)
    const int role = ROLE_OF(wave);
    F4 X, Y, Z;
    ATT_WAIT_BAR(4);
    DDMA(2);
    if (role == 0) {
        MSEG(0); SOFTMAX_SEG(true, 1, 0);
        ATT_WAIT_BAR(4);
#pragma unroll 1
        for (int i = 1; i < NT; ++i) { DDMA(i + 2); MSEG(i); SOFTMAX_SEG(false, i + 1, i); ATT_WAIT_BAR(4); }
    } else {
        MSEG(0);
        ATT_WAIT_BAR(4);
        DDMA(3); SOFTMAX_SEG(true, 1, 0); MSEG(1);
        ATT_WAIT_BAR(4);
#pragma unroll 1
        for (int i = 2; i < NT; ++i) { DDMA(i + 2); SOFTMAX_SEG(false, i, i - 1); MSEG(i); ATT_WAIT_BAR(4); }
        SOFTMAX_SEG(false, NT, NT - 1);
    }
    { const LAS char* vbp = VB_(NT - 1) + v_rd_base(lane);
      if (!skp) { LOADV(Z, 2); PVM(X, 0); LOADV(X, 3); PVM(Y, 1); PVM(Z, 2); PVM(X, 3); } }
#undef MSEG
#undef SOFTMAX_SEG
#undef QKM
#undef PVM
#undef LOADK
#undef KCO_
#undef LOADV
#undef LDV1
#undef VF_
#undef CTILE
#undef CR_
#undef SB_
    ATT_WAIT_BAR(0);
#undef DDMA
#undef RFL
#undef TILE_OF
#undef KB_
#undef VB_
    LAS float* XCH = (LAS float*)lds + sub * 4096;
    const size_t rowoff = ((size_t)b * S_ + q0 + r32) * 1024 + 512 + h * 128;
    v2u sgv[16]; f32x4 gv[16];
    if (which == 0) {
#pragma unroll
        for (int i = 0; i < 16; ++i) { const int dv = 32 * (i >> 2) + 8 * (i & 3) + 4 * hi; sgv[i] = *(const v2u*)(SG + rowoff + dv); gv[i] = *(const f32x4*)(subln_g + dv); } }
    if (which == 1) { const float sc2 = lam / w.l;
#pragma unroll
        for (int d = 0; d < 4; ++d)
#pragma unroll
            for (int r = 0; r < 16; ++r) XCH[(d * 16 + r) * 64 + lane] = w.o[d][r] * sc2; }
    __syncthreads();
    if (which == 0) { const float il = 1.f / w.l; float ss = 0.f;
#pragma unroll
        for (int d = 0; d < 4; ++d)
#pragma unroll
            for (int r = 0; r < 16; ++r) { const float v = w.o[d][r] * il - XCH[(d * 16 + r) * 64 + lane]; w.o[d][r] = v; ss += v * v; }
        ss = swapsum(ss);
        const float rs = rsqrtf(ss * (1.f / 128.f) + EPS) * (1.f - lam_init);
#pragma unroll
        for (int i = 0; i < 16; ++i) { const int d = i >> 2, rr = i & 3, dv = 32 * d + 8 * rr + 4 * hi; const f32x4 g = gv[i];
            const float s0 = __uint_as_float(sgv[i].x << 16), s1 = __uint_as_float(sgv[i].x & 0xffff0000u), s2 = __uint_as_float(sgv[i].y << 16), s3 = __uint_as_float(sgv[i].y & 0xffff0000u);
            v2u o2; o2.x = pk2(w.o[d][4 * rr] * rs * g.x * s0, w.o[d][4 * rr + 1] * rs * g.y * s1); o2.y = pk2(w.o[d][4 * rr + 2] * rs * g.z * s2, w.o[d][4 * rr + 3] * rs * g.w * s3);
            *(v2u*)(YM + rowoff + dv) = o2; } }
    __syncthreads();
}

template <class RowFn>
__device__ __forceinline__ void stage_blocks(LAS unsigned char* lds, int nblk, const bf16* Kh, const bf16* Vh, RowFn rowfn, int wave, int lane) {
    for (int pc = wave; pc < nblk * 8; pc += NWAVES) {
        const int blk = pc >> 3, j = pc & 7;
        if (j < 4) { const int kk = 8 * j + (lane >> 3), c = (lane & 7) ^ ((kk >> 1) & 7); const long ro = rowfn(blk, kk);
            if (ro >= 0) glds16(Kh + ro + c * 8, lds + blk * 4096 + j * 1024); }
        else { const int vp = j - 4, kk = 16 * (vp & 1) + (lane >> 2); const long ro = rowfn(blk, kk);
            if (ro >= 0) glds16(Vh + ro + (vp >> 1) * 32 + (lane & 3) * 8, lds + 65536 + blk * 4096 + (vp >> 1) * 2048 + (vp & 1) * 1024); }
    }
}
struct BandMask { bool on; int dk, W, r32, hi; __device__ __forceinline__ void operator()(f32x16& p) const {
#pragma unroll
    for (int r = 0; r < 16; ++r) { const int dist = crow(r, hi) - r32 + dk; if (dist > W || dist < -W) p[r] = NEGBIG; } } };
#define STORE_Y64(w, sc, sgv, YM, rowoff) do { _Pragma("unroll") for (int i_ = 0; i_ < 8; ++i_) { const int d_ = i_ >> 2, rr_ = i_ & 3, dv_ = 32 * d_ + 8 * rr_ + 4 * hi; \
        const float s0 = __uint_as_float(sgv[i_].x << 16), s1 = __uint_as_float(sgv[i_].x & 0xffff0000u), s2 = __uint_as_float(sgv[i_].y << 16), s3 = __uint_as_float(sgv[i_].y & 0xffff0000u); \
        v2u o2; o2.x = pk2(w.o[d_][4 * rr_] * sc * s0, w.o[d_][4 * rr_ + 1] * sc * s1); o2.y = pk2(w.o[d_][4 * rr_ + 2] * sc * s2, w.o[d_][4 * rr_ + 3] * sc * s3); \
        *(v2u*)(YM + rowoff + dv_) = o2; } } while (0)

__device__ __forceinline__ void band_unit(LAS unsigned char* lds, int b, int g, int s4, const bf16* QC, const bf16* KC, const bf16* VC, const bf16* SG, const float* sink, bf16* YM, int it_lo, int it_hi, int wv) {
    int tid = wv * 64 + (int)__builtin_amdgcn_mbcnt_hi(~0u, __builtin_amdgcn_mbcnt_lo(~0u, 0u)); asm volatile("" : "+v"(tid));
    const int lane = tid & 63, wave = __builtin_amdgcn_readfirstlane(tid >> 6), r32 = lane & 31, hi = lane >> 5;
    const int head = g * 4 + (wave >> 1), sub = wave & 1, ks = s4 * 256 - 128;
    const bf16* Kh = KC + (size_t)(b * 4 + g) * S_ * 64; const bf16* Vh = VC + (size_t)(b * 4 + g) * S_ * 64;
    stage_blocks(lds, 16, Kh, Vh, [&](int blk, int kk) -> long { const int t = ks + blk * 32 + kk; return (t >= 0 && t < S_) ? (long)t * 64 : -1L; }, wave, lane);
    const float slope = __builtin_amdgcn_exp2f(-0.5f * (float)(head + 1)) * LOG2E;
    const bf16* Qh = QC + ((size_t)(b * 16 + head) * S_ + r32) * 64 + hi * 8;
    bf16x8 qn[4]; q_fetch(qn, Qh + (size_t)(s4 * 256 + it_lo * 64 + sub * 32) * 64);
    f32x16 R;
#pragma unroll
    for (int r = 0; r < 16; ++r) R[r] = slope * (float)(crow(r, hi) - r32);
    const float sk = sink[head] * LOG2E;
    __syncthreads();
#pragma unroll 1
    for (int it = it_lo; it < it_hi; ++it) {
        const int q0 = s4 * 256 + it * 64 + sub * 32;
        WState<64> w; w_begin<64>(w, qn);
        if (it + 1 < it_hi) q_fetch(qn, Qh + (size_t)(q0 + 64) * 64);
        const size_t rowoff = ((size_t)b * S_ + q0 + r32) * 1024 + head * 64;
        v2u sgv[8];
#pragma unroll
        for (int i = 0; i < 8; ++i) sgv[i] = *(const v2u*)(SG + rowoff + 32 * (i >> 2) + 8 * (i & 3) + 4 * hi);
        { const int j = (q0 - ks) >> 5; step32<64, true>(w, (const LAS char*)(lds + j * 4096), (const LAS char*)(lds + 65536 + j * 4096), R, 0.f, true, NoMask(), lane); }
#pragma unroll 1
        for (int i = 1; i < 9; ++i) {
            const int dk = (i & 1) ? -32 * ((i + 1) >> 1) : 32 * (i >> 1);
            const int kb0 = q0 + dk; if (kb0 < 0 || kb0 >= S_) continue;
            const int j = (kb0 - ks) >> 5;
            step32<64, false>(w, (const LAS char*)(lds + j * 4096), (const LAS char*)(lds + 65536 + j * 4096), R, slope * (float)dk, false, BandMask{dk == 128 || dk == -128, dk, 128, r32, hi}, lane);
        }
        const float Mx = fmaxf(w.m, sk), e = __builtin_amdgcn_exp2f(w.m - Mx);
        const float sc = e / (w.l * e + __builtin_amdgcn_exp2f(sk - Mx));
        STORE_Y64(w, sc, sgv, YM, rowoff);
    }
    __syncthreads();
}

struct DilMask { bool on; int dm0, dr, own, r32, hi; __device__ __forceinline__ void operator()(f32x16& p) const {
    const float base = (float)(16 * (dm0 + 4 * hi - r32) + dr);
    if (own) {
#pragma unroll
        for (int r = 0; r < 16; ++r) { const float ad = fabsf(base + (float)(16 * ((r & 3) + 8 * (r >> 2))));
            const float bonus = __builtin_amdgcn_fmed3f(fmaf(256.f - ad, 0.0625f, 1.f), 0.f, 1.f);
            p[r] = fmaf(fminf(1024.f - ad, 0.f), 1e30f, p[r] + bonus); } }
    else {
#pragma unroll
        for (int r = 0; r < 16; ++r) { const float ad = fabsf(base + (float)(16 * ((r & 3) + 8 * (r >> 2)))); p[r] = fmaf(fminf(256.f - ad, 0.f), 1e30f, p[r]); } } } };
__device__ __forceinline__ void dilB_unit(LAS unsigned char* lds, int b, int h, int r4, const bf16* QA, const bf16* KA, const bf16* VA, float* STO, float* STML, int wv) {
    int tid = wv * 64 + (int)__builtin_amdgcn_mbcnt_hi(~0u, __builtin_amdgcn_mbcnt_lo(~0u, 0u)); asm volatile("" : "+v"(tid));
    const int lane = tid & 63, wave = __builtin_amdgcn_readfirstlane(tid >> 6), r32 = lane & 31, hi = lane >> 5;
    const size_t hb = (size_t)(b * 8 + h) * S_;
    const bf16* Kh = KA + hb * 64; const bf16* Vh = VA + hb * 64;
    stage_blocks(lds, 16, Kh, Vh, [&](int blk, int kk) -> long { return (long)(16 * ((blk & 3) * 32 + kk) + r4 + 4 * (blk >> 2)) * 64; }, wave, lane);
    const float slope = __builtin_amdgcn_exp2f(-(float)(h + 1)) * LOG2E;
    f32x16 R;
#pragma unroll
    for (int r = 0; r < 16; ++r) R[r] = 16.f * slope * (float)(crow(r, hi) - r32);
    const bf16* Qh = QA + (hb + 16 * r32) * 64 + hi * 8;
    bf16x8 qn[4]; q_fetch(qn, Qh + (size_t)(16 * 32 * (wave & 3) + r4 + 4 * (wave >> 2)) * 64);
    __syncthreads();
#pragma unroll 1
    for (int tk = 0; tk < 2; ++tk) {
        const int qi = tk * 2 + (wave >> 2), qmb = tk ? ((wave & 3) ^ 2) : (wave & 3), cq = r4 + 4 * qi, m0 = 32 * qmb;
        WState<64> w; w_begin<64>(w, qn);
        if (tk == 0) q_fetch(qn, Qh + (size_t)(16 * 32 * ((wave & 3) ^ 2) + r4 + 4 * (2 + (wave >> 2))) * 64);
        { const int blk = qi * 4 + qmb;
          step32<64, true>(w, (const LAS char*)(lds + blk * 4096), (const LAS char*)(lds + 65536 + blk * 4096), R, 0.f, true, DilMask{true, 0, 0, 1, r32, hi}, lane); }
#pragma unroll 1
        for (int s = 1; s < 16; ++s) {
            const int ki = (qi + (s >> 2)) & 3, kmb = (qmb + (s & 3)) & 3;
            const int dm0 = 32 * (kmb - qmb), dr = 4 * (ki - qi), own = (ki == qi);
            if (own ? (dm0 >= 96 || dm0 <= -96) : (dm0 >= 64 || dm0 <= -64)) continue;
            const int blk = ki * 4 + kmb;
            step32<64, false>(w, (const LAS char*)(lds + blk * 4096), (const LAS char*)(lds + 65536 + blk * 4096), R, slope * (float)(16 * dm0 + dr), dm0 == 0, DilMask{true, dm0, dr, own, r32, hi}, lane);
        }
        const int t = 16 * (m0 + r32) + cq;
        float* so = STO + (hb + t) * 64;
#pragma unroll
        for (int d = 0; d < 2; ++d)
#pragma unroll
            for (int rr = 0; rr < 4; ++rr) *(f32x4*)(so + 32 * d + 8 * rr + 4 * hi) = (f32x4){w.o[d][4 * rr], w.o[d][4 * rr + 1], w.o[d][4 * rr + 2], w.o[d][4 * rr + 3]};
        if (hi == 0) { float2 ml; ml.x = w.m; ml.y = w.l; *(float2*)(STML + (hb + t) * 2) = ml; }
    }
    __syncthreads();
}
__device__ __forceinline__ void dilA_unit(LAS unsigned char* lds, int b, int h, int qt, const bf16* QA, const bf16* KA, const bf16* VA, const float* STO, const float* STML, const bf16* SG, bf16* YM, int wv) {
    int tid = wv * 64 + (int)__builtin_amdgcn_mbcnt_hi(~0u, __builtin_amdgcn_mbcnt_lo(~0u, 0u)); asm volatile("" : "+v"(tid));
    const int lane = tid & 63, wave = __builtin_amdgcn_readfirstlane(tid >> 6), r32 = lane & 31, hi = lane >> 5;
    const size_t hb = (size_t)(b * 8 + h) * S_;
    const bf16* Kh = KA + hb * 64; const bf16* Vh = VA + hb * 64;
    const int q0 = qt * 256 + wave * 32, ks = qt * 256 - 64, tq = q0 + r32;
    stage_blocks(lds, 12, Kh, Vh, [&](int blk, int kk) -> long { const int t = ks + blk * 32 + kk; return (t >= 0 && t < S_) ? (long)t * 64 : -1L; }, wave, lane);
    const float slope = __builtin_amdgcn_exp2f(-(float)(h + 1)) * LOG2E;
    WState<64> w;
    { bf16x8 q[4]; q_fetch(q, QA + (hb + tq) * 64 + hi * 8);
      const size_t rowoff = ((size_t)b * S_ + tq) * 1024 + h * 64; v2u sgv[8];
#pragma unroll
      for (int i = 0; i < 8; ++i) sgv[i] = *(const v2u*)(SG + rowoff + 32 * (i >> 2) + 8 * (i & 3) + 4 * hi);
      const float* so = STO + (hb + tq) * 64; f32x4 sv[8];
#pragma unroll
      for (int i = 0; i < 8; ++i) sv[i] = *(const f32x4*)(so + 32 * (i >> 2) + 8 * (i & 3) + 4 * hi);
      const float2 ml = *(const float2*)(STML + (hb + tq) * 2);
      w_begin<64>(w, q);
#pragma unroll
      for (int i = 0; i < 8; ++i) { w.o[i >> 2][4 * (i & 3)] = sv[i].x; w.o[i >> 2][4 * (i & 3) + 1] = sv[i].y; w.o[i >> 2][4 * (i & 3) + 2] = sv[i].z; w.o[i >> 2][4 * (i & 3) + 3] = sv[i].w; }
      w.m = ml.x; w.l = ml.y;
      f32x16 R;
#pragma unroll
      for (int r = 0; r < 16; ++r) R[r] = slope * (float)(crow(r, hi) - r32);
      __syncthreads();
#pragma unroll 1
      for (int i = 0; i < 5; ++i) {
          const int dk = 32 * (i - 2), kb0 = q0 + dk; if (kb0 < 0 || kb0 >= S_) continue;
          const int j = (kb0 - ks) >> 5;
          step32<64, false>(w, (const LAS char*)(lds + j * 4096), (const LAS char*)(lds + 65536 + j * 4096), R, slope * (float)dk, dk == 0, BandMask{dk == 64 || dk == -64, dk, 64, r32, hi}, lane);
      }
      const float sc = 1.f / w.l;
      STORE_Y64(w, sc, sgv, YM, rowoff); }
    __syncthreads();
}

__device__ __forceinline__ void xcc_local_barrier(unsigned* lb, unsigned x, unsigned* tmo, int wave) {
    asm volatile("s_waitcnt vmcnt(0)" ::: "memory");
    __syncthreads();
    if (wg_leader(wave)) {
        const unsigned old = xb_add(&lb[64 * x], 1u), gen = old / 32u;
        if (old + 1u == (gen + 1u) * 32u) xb_add(&lb[512 + 64 * x], 1u);
        else { unsigned sp = 0; while (xb_ld(&lb[512 + 64 * x]) == gen) { __builtin_amdgcn_s_sleep(1); if ((++sp & 255u) == 0u) { if (xb_ld(tmo)) break; if (sp > XB_SPIN_CAP) { atomicAdd(tmo, 1u); break; } } } }
        __builtin_amdgcn_fence(__ATOMIC_ACQUIRE, "agent");
        asm volatile("s_waitcnt vmcnt(0)" ::: "memory");
    }
    __syncthreads();
}
__device__ __forceinline__ void cu_wait_ge(unsigned* p, unsigned target, unsigned* tmo, int wave) {
    if (wg_leader(wave)) { unsigned sp = 0;
        while (xb_ld(p) < target) { __builtin_amdgcn_s_sleep(1); if ((++sp & 255u) == 0u) { if (xb_ld(tmo)) break; if (sp > XB_SPIN_CAP) { atomicAdd(tmo, 1u); break; } } }
        __builtin_amdgcn_fence(__ATOMIC_ACQUIRE, "agent"); asm volatile("s_waitcnt vmcnt(0)" ::: "memory"); }
    __syncthreads();
}
struct Args { const float* in[16]; float* out; unsigned char* ws; int ph_lo, ph_hi; };
constexpr int PROBE_BLK = 0, PROBE_UNIT = 2;
constexpr int PROBE_CAT = -1, PROBE_AMP = 4;
constexpr int PROBE_PH = -1, PROBE_REPS = 1;
constexpr int PH_P0A = 0, PH_P0B = 1, PH_L0 = 2, PH_FINAL = 18, PH_END = 18;

__global__ void __launch_bounds__(NWAVES * 64, 2) mega(Args args) {
    extern __shared__ __attribute__((aligned(16))) unsigned char lds_raw[];
    LAS unsigned char* lds = (LAS unsigned char*)lds_raw;
    volatile LAS unsigned* MISC = (volatile LAS unsigned*)(lds + MISC_OFF);
    const int tid = threadIdx.x, lane = tid & 63, wave = __builtin_amdgcn_readfirstlane(tid >> 6);
    const int G = gridDim.x; const int bx = blockIdx.x; const int vcu = (G % 8 == 0) ? (bx % 8) * (G / 8) + bx / 8 : bx;
    unsigned char* ws = args.ws;
    unsigned* ctl = (unsigned*)(ws + WS_CTL);
    for (int u = tid; u < (LDS_BYTES - LDSCTL_OFF) / 4; u += NWAVES * 64) ((LAS unsigned*)(lds + LDSCTL_OFF))[u] = 0u;
    __syncthreads();
    const unsigned myx = xb_xcc_id() & 7u;
    if (tid == 0) MISC[17] = xb_add(ctl + CW_RANK + 64 * myx, 1u);
    __syncthreads();
    const unsigned myrank = MISC[17];
    constexpr int lo = PH_P0A, hi = PH_END;
    const bool use_bar = (hi - lo) > 1;
    XcdBarrier bar; bar.bar = ctl + CW_BAR; bar.x = 0; bar.st = nullptr;
    if (use_bar) bar = xcd_barrier_post(ctl + CW_BAR, MISC + 8, wave);
    unsigned long long pacc[8] = {0, 0, 0, 0, 0, 0, 0, 0}; unsigned long long plast = 0, pbar = 0; const bool pon = (PROBE_CAT >= 0) && (PROBE_CAT < 8) && bx == 0 && wave == 0;
#define IN(k) (lo <= (k) && (k) < hi)
#define REPS(k) for (int rep_ = 0; rep_ < ((k) == PROBE_PH ? PROBE_REPS : 1); ++rep_)
#define SEAM(k) do { if (IN(k) && IN((k) + 1)) { if (PROBE_CAT == 8) { const unsigned long long tb_ = __builtin_readcyclecounter(); xcd_barrier(bar); pbar += __builtin_readcyclecounter() - tb_; } else xcd_barrier(bar); } } while (0)
    const float* x_in = args.in[0]; const float* c_in = args.in[1]; const float* ada_w = args.in[2]; const float* ada_b = args.in[3]; const float* norm_g = args.in[4];
    const float* ab_w_in = args.in[5]; const float* ab_w_out = args.in[6]; const float* c_w_in = args.in[12]; const float* c_w_out = args.in[13]; const float* final_g = args.in[15];
    float* mod = (float*)(ws + WS_MOD); float* shw = (float*)(ws + WS_SHW); float* ssq = (float*)(ws + WS_SSQ); float* lam = (float*)(ws + WS_LAM);
    bf16* XS = (bf16*)args.out;
    float* STOp = args.out + (size_t)8 * 1024 * 1024; _Float16* X16 = (_Float16*)(ws + WS_X16);
    const int gw = vcu * NWAVES + wave, NGW = G * NWAVES;

    if (IN(PH_P0A)) REPS(PH_P0A) {
        LAS float* vec = (LAS float*)lds; LAS float* red = (LAS float*)(lds + 32768);
        for (int i = tid; i < 8 * 1024; i += NWAVES * 64) vec[i] = nv::silu(c_in[i]);
        __syncthreads();
        for (int it = bx; it < 4 * 48; it += G) { const int l = it / 48, jc = it % 48;
            gemv8_item(ada_w + (size_t)l * 1024 * 3072, 3072, jc * 64, vec, red, ada_b + l * 3072, mod + (size_t)l * 8 * 3072, 3072, wave, lane); }
        __syncthreads();
        LAS float* scr = (LAS float*)(lds + wave * 16384);
        constexpr int I_WE = 16 * 128, I_WO = 16 * 32, I_CE = 16 * 80;
        constexpr int NITEMS = 2 * I_WE + 2 * I_WO + 2 * I_CE + 2 * I_WO;
        for (int it = gw; it < NITEMS; it += NGW) { int r = it;
            if (r < 2 * I_WE) { const int j = r / I_WE; p0_transpose_item(ab_w_in + (size_t)j * 1024 * 4096, 1024, 4096, (bf16*)(ws + WS_WIN_E) + (size_t)j * 4096 * 1024, scr, r % I_WE, lane); continue; } r -= 2 * I_WE;
            if (r < 2 * I_WO) { const int j = r / I_WO; p0_transpose_item(ab_w_out + (size_t)j * 1024 * 1024, 1024, 1024, (bf16*)(ws + WS_WOUT_E) + (size_t)j * 1024 * 1024, scr, r % I_WO, lane); continue; } r -= 2 * I_WO;
            if (r < 2 * I_CE) { const int j = r / I_CE; p0_transpose_item(c_w_in + (size_t)j * 1024 * 2560, 1024, 2560, (bf16*)(ws + WS_WIN_O) + (size_t)j * 2560 * 1024, scr, r % I_CE, lane); continue; } r -= 2 * I_CE;
            { const int j = r / I_WO; p0_transpose_item(c_w_out + (size_t)j * 1024 * 1024, 1024, 1024, (bf16*)(ws + WS_WOUT_O) + (size_t)j * 1024 * 1024, scr, r % I_WO, lane); } }
        for (int i = bx * 512 + tid; i < 3 * M_; i += G * 512) ssq[M_ + i] = 0.f;
        if (bx == 0 && tid < 2) { const float* lq1 = args.in[7]; const float* lk1 = args.in[8]; const float* lq2 = args.in[9]; const float* lk2 = args.in[10];
            float s1 = 0.f, s2 = 0.f;
            for (int d = 0; d < 64; ++d) { s1 += lq1[tid * 64 + d] * lk1[tid * 64 + d]; s2 += lq2[tid * 64 + d] * lk2[tid * 64 + d]; }
            lam[tid] = expf(s1) - expf(s2) + (0.8f - 0.6f * expf(-0.3f * (float)(2 * tid))); }
        __syncthreads();
    }
    SEAM(PH_P0A);
    if (IN(PH_P0B)) REPS(PH_P0B) {
        LAS float* vec = (LAS float*)lds; LAS float* red = (LAS float*)(lds + 32768);
        int cur_l = -1;
        for (int it = bx; it < 2 * 64 + 2 * 40; it += G) {
            int l, nc; if (it < 128) { l = (it / 64) * 2; nc = it % 64; } else { l = ((it - 128) / 40) * 2 + 1; nc = (it - 128) % 40; }
            if (l != cur_l) { __syncthreads(); for (int i = tid; i < 8 * 1024; i += NWAVES * 64) vec[i] = mod[(size_t)l * 8 * 3072 + (i >> 10) * 3072 + (i & 1023)]; cur_l = l; __syncthreads(); }
            const int j = l >> 1; const float* W = (l & 1) ? c_w_in + (size_t)j * 1024 * 2560 : ab_w_in + (size_t)j * 1024 * 4096; const int ldw = (l & 1) ? 2560 : 4096;
            gemv8_item(W, ldw, nc * 64, vec, red, nullptr, shw + (size_t)l * 8 * 4096, 4096, wave, lane); }
        {
            const f32x4* gr = (const f32x4*)norm_g + lane; f32x4 gv[4];
#pragma unroll
            for (int j = 0; j < 4; ++j) gv[j] = gr[64 * j];
#pragma unroll 1
            for (int row0 = gw; row0 < M_; row0 += 4 * NGW) {
                f32x4 xv[4][4], sv[4][4];
#pragma unroll
                for (int q = 0; q < 4; ++q) { const int row = row0 + q * NGW; const int rr = row < M_ ? row : row0; const int b = rr >> 11;
                    const GAS f32x4* xr = (const GAS f32x4*)(x_in + (size_t)rr * D_) + lane; const f32x4* sr = (const f32x4*)(mod + (size_t)b * 3072 + 1024) + lane;
#pragma unroll
                    for (int j = 0; j < 4; ++j) { xv[q][j] = xr[64 * j]; sv[q][j] = sr[64 * j]; } }
#pragma unroll
                for (int q = 0; q < 4; ++q) { const int row = row0 + q * NGW; if (row >= M_) break;
                    GAS v2u* o8 = (GAS v2u*)(XS + (size_t)row * D_) + lane; float ss = 0.f;
#pragma unroll
                    for (int j = 0; j < 4; ++j) { const f32x4 v = xv[q][j], g = gv[j], s = sv[q][j]; ss += (v.x * v.x + v.y * v.y) + (v.z * v.z + v.w * v.w);
                        v2u o; o.x = pk2(v.x * g.x * (1.f + s.x), v.y * g.y * (1.f + s.y)); o.y = pk2(v.z * g.z * (1.f + s.z), v.w * g.w * (1.f + s.w)); o8[64 * j] = o; }
                    ss = wsum(ss); if (lane == 0) ssq[row] = ss; }
            }
        }
    }
    SEAM(PH_P0B);
    bool local_ok = use_bar && lo == 0 && G == 256 && myrank < 32u;
    if (local_ok) {
#pragma unroll
        for (int jx = 0; jx < 8; ++jx) local_ok = local_ok && (xb_ld(ctl + CW_RANK + 64 * jx) == 32u); }
    local_ok = __builtin_amdgcn_readfirstlane((int)local_ok) != 0;
    const int bbx = local_ok ? (int)myx : (vcu >> 5) & 7, rkx = local_ok ? (int)myrank : (vcu & 31);
    const int vcl = (vcu & ~255) + bbx * 32 + rkx;
    const int cgm = local_ok ? rkx * 8 + bbx : bx;
#define LSEAM(k) do { if (IN(k) && IN((k) + 1)) { if (local_ok) xcc_local_barrier(ctl + CW_LB, myx, ctl + CW_BAR + XB_TMO, wave); else xcd_barrier(bar); } } while (0)
#pragma unroll 1
    for (int l = 0; l < 4; ++l) {
        const int j = l >> 1, odd = l & 1; const int ph = PH_L0 + 4 * l;
        const float* mod_l = mod + (size_t)l * 8 * 3072;
        unsigned* syn = ctl + CW_SYN + (l * 8 + bbx) * 32;
        if (IN(ph)) REPS(ph) {
            const int N = odd ? 2560 : 4096;
            const bf16* Wt = odd ? (const bf16*)(ws + WS_WIN_O) + (size_t)j * 2560 * 1024 : (const bf16*)(ws + WS_WIN_E) + (size_t)j * 4096 * 1024;
            if (local_ok && l > 0 && IN(ph - 1)) cu_wait_ge(syn - 32 * 8 + 8 + (rkx & 7), 4u, ctl + CW_BAR + XB_TMO, wave);
            pg8::Gemm g{XS, Wt, M_, N, 1024}; pg8::HookOrder S; S.so.init(M_, N, G, cgm); S.r1 = (odd && local_ok && IN(ph + 1)) ? syn + 17 : nullptr; S.r2 = syn + 18;
            pg8::EpiProj E{odd, ssq + (size_t)l * M_, shw + (size_t)l * 8 * 4096, ws, (local_ok && l > 0 && IN(ph - 1)) ? syn - 32 * 8 + 16 : nullptr, 32u};
            pg8::gemm_phase<pg8::EpiProj, pg8::HookOrder, true, true>(lds, g, S, E, wave);
        }
        if (odd && local_ok) { if (IN(ph) && IN(ph + 1)) cu_wait_ge(syn + 17, 256u, ctl + CW_BAR + XB_TMO, wave); }
        else LSEAM(ph);
        if (IN(ph + 1)) REPS(ph + 1) {
            const bf16* SGp = (const bf16*)(ws + WS_SG); bf16* YMp = (bf16*)(ws + WS_YMIX);
            if (!odd) {
                REPS(100 + ph + 1) for (int u = vcl; u < 256; u += G) dilB_unit(lds, u >> 5, (u >> 2) & 7, u & 3, (const bf16*)(ws + WS_QA), (const bf16*)(ws + WS_KA), (const bf16*)(ws + WS_VA), STOp, (float*)(ws + WS_STML), wave);
                if (local_ok) { asm volatile("s_waitcnt vmcnt(0)" ::: "memory"); __syncthreads(); if (wg_leader(wave)) (void)xb_add(ctl + CW_GRP + (j * 64 + ((vcl >> 2) & 63)) * 4, 1u); }
                const float lam_init = __uint_as_float(__builtin_amdgcn_readfirstlane(__float_as_uint(0.8f - 0.6f * __expf(-0.3f * (float)l)))); const float lam_v = __uint_as_float(__builtin_amdgcn_readfirstlane(__float_as_uint(lam[j])));
                REPS(200 + ph + 1) for (int u = vcl; u < 512; u += G) { const int iu = u >> 8, ru = u & 31, bh = ((u >> 5) & 7) * 4, qt = 2 * (ru & 7) + iu; const int hh = iu ? 3 - (ru >> 3) : (ru >> 3);
                    diff_unit(lds, bh >> 2, hh, qt, (const bf16*)(ws + WS_QB), (const bf16*)(ws + WS_KB), (const bf16*)(ws + WS_VB), SGp, args.in[11] + j * 128, lam_v, lam_init, YMp, wave); }
            } else {
                const int late = rkx < 16 ? 1 : 0;
#pragma unroll 1
                for (int k = 0; k < 4; ++k) {
                    int gb, gg, gs, lo = 0, hi = 4;
                    if (local_ok) { if (k >= 2 - late) break; gb = bbx; gg = k ? (rkx >> 3) : (((rkx >> 3) + 2) & 3); gs = rkx & 7; lo = k ? 3 : 0; hi = (k || !late) ? 4 : 3;
                        if (k) cu_wait_ge(syn + 18, 128u, ctl + CW_BAR + XB_TMO, wave); }
                    else { const int u = vcl + k * G; if (u >= 256) break; gb = u >> 5; gg = (u >> 3) & 3; gs = u & 7; }
                    band_unit(lds, gb, gg, gs, (const bf16*)(ws + WS_QC), (const bf16*)(ws + WS_KC), (const bf16*)(ws + WS_VC), SGp, args.in[14] + j * 16, YMp, lo, hi, wave);
                }
            }
        }
        if (!odd && IN(ph + 1) && IN(ph + 2)) {
            if (local_ok) {
                cu_wait_ge(ctl + CW_GRP + (j * 64 + ((vcl >> 2) & 63)) * 4, 4u, ctl + CW_BAR + XB_TMO, wave);
            } else xcd_barrier(bar);
        }
        if (IN(ph + 2)) REPS(ph + 2) {
            if (!odd) {
                for (int u = vcl; u < 512; u += G) dilA_unit(lds, (u >> 5) & 7, (u & 31) >> 2, 2 * (u & 3) + (u >> 8), (const bf16*)(ws + WS_QA), (const bf16*)(ws + WS_KA), (const bf16*)(ws + WS_VA), STOp, (const float*)(ws + WS_STML), (const bf16*)(ws + WS_SG), (bf16*)(ws + WS_YMIX), wave);
            }
        }
        if (IN(ph + 2) && IN(ph + 3)) {
            if (local_ok) {
                asm volatile("s_waitcnt vmcnt(0)" ::: "memory"); __syncthreads();
                if (wg_leader(wave)) { (void)xb_add(syn + (rkx & 7), 1u); if (!odd) { (void)xb_add(syn + 2 * (rkx & 3), 1u); (void)xb_add(syn + 2 * (rkx & 3) + 1, 1u); } (void)xb_add(syn + 16, 1u); }
                cu_wait_ge(syn + (rkx & 7), odd ? 4u : 12u, ctl + CW_BAR + XB_TMO, wave);
            } else xcd_barrier(bar);
        }
        if (IN(ph + 3)) {
            const bf16* Wt = odd ? (const bf16*)(ws + WS_WOUT_O) + (size_t)j * 1024 * 1024 : (const bf16*)(ws + WS_WOUT_E) + (size_t)j * 1024 * 1024;
            pg8::Gemm g{(const bf16*)(ws + WS_YMIX), Wt, M_, 1024, 1024}; pg8::StaticOrder S; S.init(M_, 1024, G, cgm);
            if (l < 3) {
                pg8::EpiOutR E{l == 0 ? x_in : nullptr, X16, X16, mod_l + 2048, 1, norm_g + (l + 1) * 1024, mod_l + 8 * 3072 + 1024, XS, ssq + (size_t)(l + 1) * M_, nullptr, 0u};
                pg8::gemm_phase<pg8::EpiOutR, pg8::StaticOrder, true, true>(lds, g, S, E, wave);
                if (local_ok && IN(ph + 4) && wg_leader(wave)) (void)xb_add(syn + 8 + (rkx & 7), 1u);
            } else {
                pg8::EpiOutFinal E{X16, args.out, mod_l + 2048, final_g, (float*)(ws + WS_XCH), ctl + CW_PANEL, local_ok ? syn + 16 : nullptr, 32u};
                pg8::gemm_phase<pg8::EpiOutFinal, pg8::StaticOrder, false, true>(lds, g, S, E, wave);
            }
        }
        if (l < 3 && !local_ok && IN(ph + 3) && IN(ph + 4)) xcd_barrier(bar);
    }
    if (PROBE_CAT >= 0 && bx == PROBE_BLK && wave == 0) { const unsigned long long t0 = __builtin_readcyclecounter(), dur = (unsigned long long)PROBE_AMP * (PROBE_CAT == 8 ? pbar : pacc[(PROBE_CAT >= 0 && PROBE_CAT < 8) ? PROBE_CAT : 0]);
        while (__builtin_readcyclecounter() - t0 < dur) __builtin_amdgcn_s_sleep(8); }
#undef IN
#undef REPS
#undef SEAM
#undef LSEAM
}
}

static void launch_mega(const mk::Args& base, int lo, int hi, int grid, hipStream_t stream) {
    mk::Args a = base; a.ph_lo = lo; a.ph_hi = hi;
    hipLaunchKernelGGL(mk::mega, dim3(grid), dim3(mk::NWAVES * 64), mk::LDS_BYTES, stream, a);
}
extern "C" void kernel_launch(void* const* d_in, const int* in_sizes, int n_in, void* d_out, int out_size, void* d_ws, size_t ws_size, hipStream_t stream) {
    using namespace nv;
    static int grid = 0;
    if (grid == 0) {
        if (n_in != 16 || in_sizes[0] != M_ * D_ || out_size != M_ * D_ || ws_size < lay::WS_END) { fprintf(stderr, "kernel_launch: unexpected shapes / workspace (%d inputs, ws %zu)\n", n_in, ws_size); grid = -1; return; }
        int dev = 0, cus = 0, per_cu = 0;
        if (hipGetDevice(&dev) != hipSuccess || hipDeviceGetAttribute(&cus, hipDeviceAttributeMultiprocessorCount, dev) != hipSuccess) { grid = -1; return; }
        if (hipFuncSetAttribute((const void*)mk::mega, hipFuncAttributeMaxDynamicSharedMemorySize, mk::LDS_BYTES) != hipSuccess) { fprintf(stderr, "kernel_launch: hipFuncSetAttribute failed\n"); grid = -1; return; }
        if (hipOccupancyMaxActiveBlocksPerMultiprocessor(&per_cu, (const void*)mk::mega, mk::NWAVES * 64, mk::LDS_BYTES) != hipSuccess || per_cu < 1) { fprintf(stderr, "kernel_launch: occupancy query says %d blocks/CU\n", per_cu); per_cu = 1; }
        (void)hipGetLastError();
        grid = cus;
        if (grid != 256) fprintf(stderr, "kernel_launch: note: %d CUs\n", grid);
    }
    if (grid < 0) return;
    (void)hipMemsetAsync((char*)d_ws + lay::WS_CTL, 0, lay::CTL_ZERO_BYTES, stream);
    mk::Args a{};
    for (int i = 0; i < 16; ++i) a.in[i] = (const float*)d_in[i];
    a.out = (float*)d_out; a.ws = (unsigned char*)d_ws;
    launch_mega(a, mk::PH_P0A, mk::PH_END, grid, stream);
    const hipError_t le = hipPeekAtLastError();
    if (le != hipSuccess) fprintf(stderr, "kernel_launch: launch failed: %s\n", hipGetErrorName(le));
}
```

```cpp
#include <hip/hip_runtime.h>
#include <cstdio>
#include <cstdint>

namespace lay {
constexpr size_t MiB = 1u << 20;
constexpr size_t WS_CTL = 0, CTL_ZERO_BYTES = 64 * 1024;
constexpr size_t WS_MOD = 1 * MiB;
constexpr size_t WS_SHW = WS_MOD + 512 * 1024;
constexpr size_t WS_SSQ = 2 * MiB;
constexpr size_t WS_LAM = WS_SSQ + 512 * 1024;
constexpr size_t WS_WIN_E = 3 * MiB;
constexpr size_t WS_WOUT_E = 19 * MiB;
constexpr size_t WS_WIN_O = 23 * MiB;
constexpr size_t WS_WOUT_O = 33 * MiB;
constexpr size_t WS_X16 = 37 * MiB;
constexpr size_t WS_YMIX = 69 * MiB;
constexpr size_t WS_SG = 101 * MiB;
constexpr size_t WS_P = 133 * MiB;
constexpr size_t WS_QA = WS_P, WS_KA = WS_P + 16 * MiB, WS_VA = WS_P + 32 * MiB, WS_QB = WS_P + 48 * MiB, WS_KB = WS_P + 64 * MiB, WS_VB = WS_P + 80 * MiB;
constexpr size_t WS_QC = WS_P, WS_KC = WS_P + 32 * MiB, WS_VC = WS_P + 40 * MiB;
constexpr size_t WS_STML = WS_P + 96 * MiB;
constexpr size_t WS_END = WS_STML + 1 * MiB;
static_assert(WS_END <= 256 * MiB, "ws map");
constexpr size_t WS_XCH = WS_LAM + 64 * 1024;
constexpr int CW_RANK = 13312, CW_LB = 14336;
constexpr int CW_SYN = 12288;
constexpr int CW_GRP = 15360;
constexpr int CW_BAR = 1024, CW_PANEL = 8192;
static_assert(CW_PANEL + 64 * 64 <= CW_SYN && CW_SYN + 4 * 8 * 32 <= CW_RANK && CW_RANK + 8 * 64 <= CW_LB && CW_LB + 1024 <= CW_GRP && (CW_GRP + 512) * 4 <= (int)CTL_ZERO_BYTES, "control words inside the memset region");
}

namespace nv {
typedef unsigned short bf16;
constexpr int B_ = 8, S_ = 2048, D_ = 1024, M_ = B_ * S_;
constexpr float LOG2E = 1.4426950408889634f;
constexpr float QSCALE = 0.125f * LOG2E;
constexpr float EPS = 1e-6f;
__device__ __forceinline__ float silu(float x) { return x / (1.f + __expf(-x)); }
__device__ __forceinline__ int pi16(int t) { return (t & 15) * 128 + (t >> 4); }
using namespace lay;
}

namespace pg8 {
#define PG8_LAS __attribute__((address_space(3)))
typedef unsigned short bf16_t;
typedef short bf16x8 __attribute__((ext_vector_type(8)));
typedef float f32x4 __attribute__((ext_vector_type(4)));
typedef unsigned u32x4 __attribute__((ext_vector_type(4)));
constexpr int BM = 256, BK = 64, HALF = 128, HTB = HALF * BK * 2  , STAGE_BYTES = 8 * HTB, NXCD = 8, WGM = 8;

__host__ __device__ __forceinline__ int lds_byte(int r, int c) { const int st = (r >> 4) * 2 + (c >> 5), rr = r & 15, cc = c & 31, ob = rr * 64 + cc * 2; return st * 1024 + (ob ^ (((ob >> 9) & 1) << 5)); }
__host__ __device__ __forceinline__ void stage_rc(int b, int& R, int& C) { const int st = b / 1024, sb = b % 1024, swz = sb ^ (((sb >> 9) & 1) << 5); R = (st >> 1) * 16 + swz / 64; C = (st & 1) * 32 + (swz % 64) / 2; }
__host__ __device__ __forceinline__ int perm32(int rho) { const int n = rho >> 4, i = rho & 15; return 8 * (i >> 2) + 4 * n + (i & 3); }

struct Unit { int pm, pn; };
struct Gemm { const bf16_t* A; const bf16_t* Bt; int M, N, K; };

struct StaticOrder {
    int nM, nN, nwg, G, c;
    __host__ __device__ void init(int M, int N, int G_, int c_) { nM = M / BM; nN = N / BM; nwg = nM * nN; G = G_; c = c_; }
    __host__ __device__ bool next(int i, Unit& u) const {
        const long L = (long)i * G + c; if (L >= nwg) return false;
        int wgid = (int)L; { const int q = nwg / NXCD, r = nwg % NXCD, xcd = wgid % NXCD, off = wgid / NXCD; wgid = (xcd < r ? xcd * (q + 1) : r * (q + 1) + (xcd - r) * q) + off; }
        const int nig = WGM * nN, gid = wgid / nig, fm = gid * WGM, gsz = (nM - fm) < WGM ? (nM - fm) : WGM;
        u.pm = fm + ((wgid % nig) % gsz); u.pn = (wgid % nig) / gsz; return true;
    }
    __device__ __forceinline__ void a_ready(const Unit&) const {}
    __device__ __forceinline__ void done(const Unit&) const {}
};

__device__ __forceinline__ unsigned cvt_pk_bf16(float lo, float hi) { unsigned r; asm volatile("v_cvt_pk_bf16_f32 %0, %1, %2" : "=v"(r) : "v"(lo), "v"(hi)); return r; }

struct HookOrder {
    StaticOrder so; unsigned* r1; unsigned* r2;
    __device__ __forceinline__ bool next(int i, Unit& u) const { return so.next(i, u); }
    __device__ __forceinline__ void a_ready(const Unit&) const {}
    __device__ __forceinline__ void done(const Unit&) const {}
    __device__ __forceinline__ void after(int ui, int lane) const {
        if (r1 != nullptr && ui >= 1) { asm volatile("s_waitcnt vmcnt(0)" ::: "memory"); if (lane == 0) (void)__hip_atomic_fetch_add(ui == 1 ? r1 : r2, 1u, __ATOMIC_RELAXED, __HIP_MEMORY_SCOPE_AGENT); }
    }
};
template <class T> struct has_hook { static constexpr bool v = false; };
template <> struct has_hook<HookOrder> { static constexpr bool v = true; };
__device__ __forceinline__ void war_wait(unsigned* p, unsigned target) {
    if (!p) return;
    unsigned sp = 0;
    while (__hip_atomic_load(p, __ATOMIC_RELAXED, __HIP_MEMORY_SCOPE_AGENT) < target) { __builtin_amdgcn_s_sleep(1); if (++sp > (1u << 20)) break; }
}
struct EpiProj {
    static constexpr bool PERM = true, AFTER_DRAIN = false;
    int odd; const float* ssq; const float* shw; unsigned char* ws; unsigned* wptr; unsigned wtarget;
    __device__ __forceinline__ void operator()(const f32x4 (&acc)[2][2][4][2], const Unit& u, int wr, int wc, int fr, int fq) const {
        using namespace nv;
        const int row0 = u.pm * BM + wr * 64 + fr, b = u.pm >> 3, pn = u.pn;
        war_wait(wptr, wtarget);
        size_t base; int cb, lg, nh, perm, kind;
        if (!odd) {
            if (pn < 6)       { base = lay::WS_QA + (size_t)(pn >> 1) * (16u << 20); cb = (pn & 1) * 256; lg = 6; nh = 8; perm = 0; kind = 0; }
            else if (pn < 10) { base = lay::WS_QB + (size_t)((pn - 6) >> 1) * (16u << 20); cb = ((pn - 6) & 1) * 256; lg = 6; nh = 8; perm = 0; kind = 0; }
            else if (pn < 12) { base = lay::WS_VB; cb = (pn - 10) * 256; lg = 7; nh = 4; perm = 0; kind = 0; }
            else              { base = lay::WS_SG; cb = (pn - 12) * 256; lg = 0; nh = 0; perm = 0; kind = 1; }
        } else {
            if (pn < 4)       { base = lay::WS_QC; cb = pn * 256; lg = 6; nh = 16; perm = 0; kind = 0; }
            else if (pn == 4) { base = lay::WS_KC; cb = 0; lg = 6; nh = 4; perm = 0; kind = 0; }
            else if (pn == 5) { base = lay::WS_VC; cb = 0; lg = 6; nh = 4; perm = 0; kind = 0; }
            else              { base = lay::WS_SG; cb = (pn - 6) * 256; lg = 0; nh = 0; perm = 0; kind = 1; }
        }
        const bool isq = (!odd && (pn < 2 || pn == 6 || pn == 7)) || (odd && pn < 4);
        const float qs = isq ? QSCALE : 1.f;
        bf16_t* dst = (bf16_t*)(ws + base);
        const int cl0 = wc * 32 + 8 * fq;
        f32x4 bv[2][2];
#pragma unroll
        for (int bj = 0; bj < 2; ++bj)
#pragma unroll
            for (int n = 0; n < 2; ++n) bv[bj][n] = *(const f32x4*)(shw + (size_t)b * 4096 + pn * BM + cl0 + bj * HALF + 4 * n);
        float rsv[2][4];
#pragma unroll
        for (int ai = 0; ai < 2; ++ai)
#pragma unroll
            for (int m = 0; m < 4; ++m) rsv[ai][m] = ssq[row0 + ai * HALF + m * 16];
#pragma unroll
        for (int ai = 0; ai < 2; ++ai)
#pragma unroll
            for (int m = 0; m < 4; ++m) rsv[ai][m] = rsqrtf(rsv[ai][m] * (1.f / 1024.f) + EPS);
#pragma unroll
        for (int ai = 0; ai < 2; ++ai)
#pragma unroll
            for (int m = 0; m < 4; ++m) {
                const int row = row0 + ai * HALF + m * 16, t = row & 2047;
                const float rs = rsv[ai][m];
                const int tt = perm ? pi16(t) : t;
#pragma unroll
                for (int bj = 0; bj < 2; ++bj) {
                    f32x4 v0 = acc[ai][bj][m][0] * rs + bv[bj][0], v1 = acc[ai][bj][m][1] * rs + bv[bj][1];
                    const int cc = cb + cl0 + bj * HALF;
                    size_t off;
                    if (kind == 1) { off = (size_t)row * 1024 + cc;
#pragma unroll
                        for (int q = 0; q < 4; ++q) { v0[q] = v0[q] * __builtin_amdgcn_rcpf(1.f + __builtin_amdgcn_exp2f(-v0[q] * LOG2E)); v1[q] = v1[q] * __builtin_amdgcn_rcpf(1.f + __builtin_amdgcn_exp2f(-v1[q] * LOG2E)); } }
                    else { off = ((((size_t)(b * nh + (cc >> lg)) << 11) + tt) << lg) + (cc & ((1 << lg) - 1)); v0 = v0 * qs; v1 = v1 * qs; }
                    u32x4 w; w.x = cvt_pk_bf16(v0[0], v0[1]); w.y = cvt_pk_bf16(v0[2], v0[3]); w.z = cvt_pk_bf16(v1[0], v1[1]); w.w = cvt_pk_bf16(v1[2], v1[3]);
                    *(u32x4*)(dst + off) = w;
                }
            }
    }
};
typedef _Float16 h16x8 __attribute__((ext_vector_type(8)));
typedef float f32x8 __attribute__((ext_vector_type(8)));
__device__ __forceinline__ void ld_res16(const _Float16* p, f32x4& a, f32x4& b) { const f32x8 v = __builtin_convertvector(*(const h16x8*)p, f32x8); a = (f32x4){v[0], v[1], v[2], v[3]}; b = (f32x4){v[4], v[5], v[6], v[7]}; }
__device__ __forceinline__ void st_res16(_Float16* p, const f32x4& a, const f32x4& b) { const f32x8 v = {a[0], a[1], a[2], a[3], b[0], b[1], b[2], b[3]}; *(h16x8*)p = __builtin_convertvector(v, h16x8); }
struct EpiOutR {
    static constexpr bool PERM = true, AFTER_DRAIN = false;
    const float* xin; const _Float16* xin16; _Float16* xout; const float* gate; int has_next; const float* g_next; const float* scale_next; bf16_t* xs; float* ssq_next; unsigned* wptr; unsigned wtarget;
    __device__ __forceinline__ void operator()(const f32x4 (&acc)[2][2][4][2], const Unit& u, int wr, int wc, int fr, int fq) const {
        const int row0 = u.pm * BM + wr * 64 + fr, b = u.pm >> 3;
        war_wait(wptr, wtarget);
        const int c0 = u.pn * BM + wc * 32 + 8 * fq;
        f32x4 gt[2][2], gs[2][2];
#pragma unroll
        for (int bj = 0; bj < 2; ++bj)
#pragma unroll
            for (int n = 0; n < 2; ++n) { const int c = c0 + bj * HALF + 4 * n; gt[bj][n] = *(const f32x4*)(gate + (size_t)b * 3072 + c);
                if (has_next) { const f32x4 g = *(const f32x4*)(g_next + c), s = *(const f32x4*)(scale_next + (size_t)b * 3072 + c); gs[bj][n] = g * (1.f + s); } else gs[bj][n] = (f32x4){0.f, 0.f, 0.f, 0.f}; }
#pragma unroll
        for (int aq = 0; aq < 4; ++aq) { const int ai = aq >> 1, mb = (aq & 1) * 2;
            f32x4 xv[4][2][2];
#pragma unroll
            for (int m = mb; m < mb + 2; ++m)
#pragma unroll
                for (int bj = 0; bj < 2; ++bj) { const size_t off = (size_t)(row0 + ai * HALF + m * 16) * 1024 + c0 + bj * HALF;
                    if (xin) { xv[m][bj][0] = *(const f32x4*)(xin + off); xv[m][bj][1] = *(const f32x4*)(xin + off + 4); } else ld_res16(xin16 + off, xv[m][bj][0], xv[m][bj][1]); }
#pragma unroll
            for (int m = mb; m < mb + 2; ++m) {
                const int row = row0 + ai * HALF + m * 16; float ss = 0.f;
#pragma unroll
                for (int bj = 0; bj < 2; ++bj) {
                    const size_t off = (size_t)row * 1024 + c0 + bj * HALF;
                    const f32x4 n0 = xv[m][bj][0] + gt[bj][0] * acc[ai][bj][m][0], n1 = xv[m][bj][1] + gt[bj][1] * acc[ai][bj][m][1];
                    st_res16(xout + off, n0, n1);
                    if (has_next) {
                        ss += (n0[0] * n0[0] + n0[1] * n0[1]) + (n0[2] * n0[2] + n0[3] * n0[3]) + (n1[0] * n1[0] + n1[1] * n1[1]) + (n1[2] * n1[2] + n1[3] * n1[3]);
                        const f32x4 a = n0 * gs[bj][0], c = n1 * gs[bj][1];
                        u32x4 w; w.x = cvt_pk_bf16(a[0], a[1]); w.y = cvt_pk_bf16(a[2], a[3]); w.z = cvt_pk_bf16(c[0], c[1]); w.w = cvt_pk_bf16(c[2], c[3]);
                        *(u32x4*)(xs + off) = w; }
                }
                if (has_next) { ss += __shfl_xor(ss, 16); ss += __shfl_xor(ss, 32); if (fq == 0) atomicAdd(ssq_next + row, ss); }
            }
        }
    }
};

struct EpiOutFinal {
    static constexpr bool PERM = true, AFTER_DRAIN = true;
    const _Float16* xin; float* out; const float* gate; const float* fg; float* xch; unsigned* cnt; unsigned* wptr; unsigned wtarget;
    __device__ __forceinline__ void fused(f32x4 (&acc)[2][2][4][2], const Unit& u, int wr, int wc, int fr, int fq, PG8_LAS unsigned char* lds, int wid, int lane) const {
        PG8_LAS float* P = (PG8_LAS float*)lds; PG8_LAS float* S = (PG8_LAS float*)(lds + 4096);
        const int row0 = u.pm * BM + wr * 64 + fr, b = u.pm >> 3, c0 = u.pn * BM + wc * 32 + 8 * fq;
        f32x4 gt[2][2];
#pragma unroll
        for (int bj = 0; bj < 2; ++bj)
#pragma unroll
            for (int n = 0; n < 2; ++n) gt[bj][n] = *(const f32x4*)(gate + (size_t)b * 3072 + c0 + bj * HALF + 4 * n);
#pragma unroll
        for (int aq = 0; aq < 4; ++aq) { const int ai = aq >> 1, mb = (aq & 1) * 2;
            f32x4 xv[4][2][2];
#pragma unroll
            for (int m = mb; m < mb + 2; ++m)
#pragma unroll
                for (int bj = 0; bj < 2; ++bj) { const size_t off = (size_t)(row0 + ai * HALF + m * 16) * 1024 + c0 + bj * HALF; ld_res16(xin + off, xv[m][bj][0], xv[m][bj][1]); }
#pragma unroll
            for (int m = mb; m < mb + 2; ++m) { const int row = row0 + ai * HALF + m * 16; float ss = 0.f;
#pragma unroll
                for (int bj = 0; bj < 2; ++bj) {
                    const f32x4 n0 = xv[m][bj][0] + gt[bj][0] * acc[ai][bj][m][0], n1 = xv[m][bj][1] + gt[bj][1] * acc[ai][bj][m][1];
                    acc[ai][bj][m][0] = n0; acc[ai][bj][m][1] = n1;
                    ss += (n0[0] * n0[0] + n0[1] * n0[1]) + (n0[2] * n0[2] + n0[3] * n0[3]) + (n1[0] * n1[0] + n1[1] * n1[1]) + (n1[2] * n1[2] + n1[3] * n1[3]); }
                ss += __shfl_xor(ss, 16); ss += __shfl_xor(ss, 32);
                if (fq == 0) P[(ai * HALF + wr * 64 + m * 16 + fr) * 4 + wc] = ss; } }
        asm volatile("s_waitcnt lgkmcnt(0)" ::: "memory"); __builtin_amdgcn_s_barrier(); asm volatile("" ::: "memory");
        const int row = wid * 32 + (lane & 31);
        if (lane < 32) { const float t = (P[row * 4 + 0] + P[row * 4 + 1]) + (P[row * 4 + 2] + P[row * 4 + 3]);
            __hip_atomic_store(xch + (size_t)(u.pm * BM + row) * 4 + u.pn, t, __ATOMIC_RELAXED, __HIP_MEMORY_SCOPE_AGENT); }
        asm volatile("s_waitcnt vmcnt(0)" ::: "memory");
        if (lane == 0) __hip_atomic_fetch_add(cnt + 64 * u.pm, 1u, __ATOMIC_RELAXED, __HIP_MEMORY_SCOPE_AGENT);
        if (wid == 0) { unsigned spins = 0;
            while ((unsigned)__builtin_amdgcn_readfirstlane(__hip_atomic_load(cnt + 64 * u.pm, __ATOMIC_RELAXED, __HIP_MEMORY_SCOPE_AGENT)) < 32u) { __builtin_amdgcn_s_sleep(2); if (++spins > (1u << 22)) break; }
            __builtin_amdgcn_fence(__ATOMIC_ACQUIRE, "agent"); }
        asm volatile("s_waitcnt vmcnt(0) lgkmcnt(0)" ::: "memory"); __builtin_amdgcn_s_barrier(); asm volatile("" ::: "memory");
        if (lane < 32) { const float* slot = xch + (size_t)(u.pm * BM + row) * 4; float tot = 0.f;
#pragma unroll
            for (int t = 0; t < 4; ++t) tot += __hip_atomic_load(slot + t, __ATOMIC_RELAXED, __HIP_MEMORY_SCOPE_AGENT);
            S[row] = rsqrtf(tot * (1.f / 1024.f) + nv::EPS); }
        asm volatile("s_waitcnt vmcnt(0) lgkmcnt(0)" ::: "memory"); __builtin_amdgcn_s_barrier(); asm volatile("" ::: "memory");
        war_wait(wptr, wtarget);
        f32x4 gv[2][2];
#pragma unroll
        for (int bj = 0; bj < 2; ++bj)
#pragma unroll
            for (int n = 0; n < 2; ++n) gv[bj][n] = *(const f32x4*)(fg + c0 + bj * HALF + 4 * n);
#pragma unroll
        for (int ai = 0; ai < 2; ++ai)
#pragma unroll
            for (int m = 0; m < 4; ++m) { const int r = ai * HALF + wr * 64 + m * 16 + fr; const float rs = S[r]; const size_t off = (size_t)(u.pm * BM + r) * 1024 + c0;
#pragma unroll
                for (int bj = 0; bj < 2; ++bj) { *(f32x4*)(out + off + bj * HALF) = acc[ai][bj][m][0] * rs * gv[bj][0]; *(f32x4*)(out + off + bj * HALF + 4) = acc[ai][bj][m][1] * rs * gv[bj][1]; } }
    }
};

template <class Epi, class Sched, bool ALIGN_EPI = false, bool SP2 = false>
__device__ __forceinline__ void gemm_phase(PG8_LAS unsigned char* lds, const Gemm g, const Sched& S, const Epi& E, int wv) {
    int tid_ = wv * 64 + (int)__builtin_amdgcn_mbcnt_hi(~0u, __builtin_amdgcn_mbcnt_lo(~0u, 0u)); asm volatile("" : "+v"(tid_));
    const int tid = tid_, wid = __builtin_amdgcn_readfirstlane(tid >> 6), lane = tid & 63, wr = wid >> 2, wc = wid & 3, fr = lane & 15, fq = lane >> 4;
    const int K = g.K, nt = K / BK;
    unsigned voffA[2], voffB[2];
#pragma unroll
    for (int i = 0; i < 2; ++i) { int R, C; stage_rc(tid * 16 + i * 8192, R, C); const int Rb = Epi::PERM ? ((R & ~31) + perm32(R & 31)) : R;
        voffA[i] = (unsigned)(R * K + C) * 2u; voffB[i] = (unsigned)(Rb * K + C) * 2u; }
    const size_t kstep = (size_t)(BK * 2);
    const size_t hstep = (size_t)HALF * K * 2;
    const size_t tstep = 2 * hstep;
    const unsigned ldsw = (unsigned)wid * 1024u;
    const int aoff = lds_byte(wr * 64 + fr, fq * 8), boff = lds_byte(wc * 32 + fr, fq * 8);
#define PG8_SA(b, h) (((b) * 2 + (h)) * HTB)
#define PG8_SB(b, h) ((4 + (b) * 2 + (h)) * HTB)
#define PG8_STAGE(bufoff, gbase, voff) do { _Pragma("unroll") for (int _i = 0; _i < 2; ++_i) \
        __builtin_amdgcn_global_load_lds((const unsigned*)((const char*)(gbase) + (voff)[_i]), (PG8_LAS unsigned*)(lds + (bufoff) + ldsw + _i * 8192), 16, 0, 0); } while (0)
#define PG8_LDA(dst, b, h) do { _Pragma("unroll") for (int m = 0; m < 4; ++m) _Pragma("unroll") for (int k = 0; k < 2; ++k) dst[m][k] = *(const PG8_LAS bf16x8*)(lds + PG8_SA(b, h) + aoff + m * 2048 + k * 1024); } while (0)
#define PG8_LDB(dst, b, h) do { _Pragma("unroll") for (int n = 0; n < 2; ++n) _Pragma("unroll") for (int k = 0; k < 2; ++k) dst[n][k] = *(const PG8_LAS bf16x8*)(lds + PG8_SB(b, h) + boff + n * 2048 + k * 1024); } while (0)
#define PG8_MMA(ai, bj, At, Bt) do { __builtin_amdgcn_s_setprio(1); _Pragma("unroll") for (int m = 0; m < 4; ++m) _Pragma("unroll") for (int n = 0; n < 2; ++n) _Pragma("unroll") for (int k = 0; k < 2; ++k) \
        acc[ai][bj][m][n] = __builtin_amdgcn_mfma_f32_16x16x32_bf16(Bt[n][k], At[m][k], acc[ai][bj][m][n], 0, 0, 0); __builtin_amdgcn_s_setprio(0); } while (0)
#define PG8_WAIT_V(n) asm volatile("s_waitcnt vmcnt(" #n ")" ::: "memory")
#define PG8_WAIT_L(n) asm volatile("s_waitcnt lgkmcnt(" #n ")" ::: "memory")
#define PG8_BAR __builtin_amdgcn_s_barrier()
#define PG8_SCHED __builtin_amdgcn_sched_barrier(0)
    Unit cur, nxt; int ui = 0;
    if (!S.next(0, cur)) return;
    f32x4 acc[2][2][4][2];
#pragma unroll
    for (int a = 0; a < 2; ++a)
#pragma unroll
        for (int b = 0; b < 2; ++b)
#pragma unroll
            for (int m = 0; m < 4; ++m)
#pragma unroll
                for (int n = 0; n < 2; ++n) acc[a][b][m][n] = (f32x4){0.f, 0.f, 0.f, 0.f};
    bf16x8 At[4][2], B0[2][2], B1[2][2];
    const char* cA = (const char*)g.A + (size_t)cur.pm * tstep; const char* cB = (const char*)g.Bt + (size_t)cur.pn * tstep;
    S.a_ready(cur);
    if constexpr (SP2) {
        PG8_STAGE(PG8_SB(0, 0), cB, voffB); PG8_STAGE(PG8_SB(0, 1), cB + hstep, voffB); PG8_STAGE(PG8_SA(0, 0), cA, voffA); PG8_STAGE(PG8_SA(0, 1), cA + hstep, voffA);
        if (wr == 1) PG8_BAR;
        PG8_WAIT_V(2); PG8_BAR;
        PG8_STAGE(PG8_SB(1, 0), cB + kstep, voffB); PG8_STAGE(PG8_SA(1, 0), cA + kstep, voffA); PG8_STAGE(PG8_SB(1, 1), cB + hstep + kstep, voffB);
        PG8_WAIT_V(6); PG8_BAR;
    } else {
        PG8_STAGE(PG8_SB(0, 0), cB, voffB); PG8_STAGE(PG8_SA(0, 0), cA, voffA); PG8_STAGE(PG8_SB(0, 1), cB + hstep, voffB); PG8_STAGE(PG8_SA(0, 1), cA + hstep, voffA);
        if (wr == 1) PG8_BAR;
        PG8_WAIT_V(4); PG8_BAR;
        PG8_STAGE(PG8_SB(1, 0), cB + kstep, voffB); PG8_STAGE(PG8_SA(1, 0), cA + kstep, voffA); PG8_STAGE(PG8_SB(1, 1), cB + hstep + kstep, voffB);
        PG8_WAIT_V(6); PG8_BAR;
    }
    for (;;) {
        const bool has_next = S.next(ui + 1, nxt);
        const char* nA = has_next ? (const char*)g.A + (size_t)nxt.pm * tstep : cA; const char* nB = has_next ? (const char*)g.Bt + (size_t)nxt.pn * tstep : cB;
        for (int t = 0; t < nt; t += 2) {
            const bool last = (t == nt - 2);
            const char* a1 = cA + (size_t)(t + 1) * kstep;
            const char* a2 = last ? nA : cA + (size_t)(t + 2) * kstep; const char* b2 = last ? nB : cB + (size_t)(t + 2) * kstep;
            const char* a3 = a2 + kstep; const char* b3 = b2 + kstep;
            if (last && has_next) S.a_ready(nxt);
            if constexpr (SP2) {
            PG8_LDB(B0, 0, 0); PG8_LDB(B1, 0, 1); PG8_SCHED; PG8_LDA(At, 0, 0); PG8_STAGE(PG8_SA(1, 1), a1 + hstep, voffA);
            PG8_WAIT_V(8); PG8_WAIT_L(0); PG8_BAR; PG8_MMA(0, 0, At, B0); PG8_MMA(0, 1, At, B1); PG8_BAR; PG8_SCHED;
            PG8_LDA(At, 0, 1); PG8_STAGE(PG8_SB(0, 0), b2, voffB); PG8_STAGE(PG8_SB(0, 1), b2 + hstep, voffB); PG8_STAGE(PG8_SA(0, 0), a2, voffA);
            PG8_WAIT_V(8); PG8_WAIT_L(0); PG8_BAR; PG8_MMA(1, 0, At, B0); PG8_MMA(1, 1, At, B1); PG8_BAR; PG8_SCHED;
            PG8_LDB(B0, 1, 0); PG8_LDB(B1, 1, 1); PG8_SCHED; PG8_LDA(At, 1, 0); PG8_STAGE(PG8_SA(0, 1), a2 + hstep, voffA);
            PG8_WAIT_V(8); PG8_WAIT_L(0); PG8_BAR; PG8_MMA(0, 0, At, B0); PG8_MMA(0, 1, At, B1); PG8_BAR; PG8_SCHED;
            PG8_LDA(At, 1, 1); PG8_STAGE(PG8_SB(1, 0), b3, voffB); PG8_STAGE(PG8_SB(1, 1), b3 + hstep, voffB); PG8_STAGE(PG8_SA(1, 0), a3, voffA);
            PG8_WAIT_V(8); PG8_WAIT_L(0); PG8_BAR; PG8_MMA(1, 0, At, B0); PG8_MMA(1, 1, At, B1); PG8_BAR; PG8_SCHED;
            } else {
            PG8_LDB(B0, 0, 0); PG8_SCHED; PG8_LDA(At, 0, 0); PG8_STAGE(PG8_SA(1, 1), a1 + hstep, voffA);
            PG8_WAIT_L(8); PG8_BAR; PG8_WAIT_L(0); PG8_MMA(0, 0, At, B0); PG8_BAR; PG8_SCHED;
            PG8_LDB(B1, 0, 1); PG8_STAGE(PG8_SB(0, 0), b2, voffB);
            PG8_BAR; PG8_WAIT_L(0); PG8_MMA(0, 1, At, B1); PG8_BAR;
            PG8_LDA(At, 0, 1); PG8_STAGE(PG8_SA(0, 0), a2, voffA);
            PG8_BAR; PG8_WAIT_L(0); PG8_MMA(1, 0, At, B0); PG8_BAR; PG8_SCHED;
            PG8_STAGE(PG8_SB(0, 1), b2 + hstep, voffB);
            PG8_WAIT_V(6); PG8_BAR; PG8_MMA(1, 1, At, B1); PG8_BAR;
            PG8_LDB(B0, 1, 0); PG8_SCHED; PG8_LDA(At, 1, 0); PG8_STAGE(PG8_SA(0, 1), a2 + hstep, voffA);
            PG8_WAIT_L(8); PG8_BAR; PG8_WAIT_L(0); PG8_MMA(0, 0, At, B0); PG8_BAR; PG8_SCHED;
            PG8_LDB(B1, 1, 1); PG8_STAGE(PG8_SB(1, 0), b3, voffB);
            PG8_BAR; PG8_WAIT_L(0); PG8_MMA(0, 1, At, B1); PG8_BAR;
            PG8_LDA(At, 1, 1); PG8_STAGE(PG8_SA(1, 0), a3, voffA);
            PG8_BAR; PG8_WAIT_L(0); PG8_MMA(1, 0, At, B0); PG8_BAR; PG8_SCHED;
            PG8_STAGE(PG8_SB(1, 1), b3 + hstep, voffB);
            PG8_WAIT_V(6); PG8_BAR; PG8_MMA(1, 1, At, B1); PG8_BAR;
            }
        }
        if constexpr (ALIGN_EPI) { if (wr == 0) PG8_BAR; }
        if constexpr (!Epi::AFTER_DRAIN) { E(acc, cur, wr, wc, fr, fq); S.done(cur); if constexpr (has_hook<Sched>::v) S.after(ui, lane); }
        if (!has_next) break;
#pragma unroll
        for (int a = 0; a < 2; ++a)
#pragma unroll
            for (int b = 0; b < 2; ++b)
#pragma unroll
                for (int m = 0; m < 4; ++m)
#pragma unroll
                    for (int n = 0; n < 2; ++n) acc[a][b][m][n] = (f32x4){0.f, 0.f, 0.f, 0.f};
        cur = nxt; cA = nA; cB = nB; ++ui;
        if constexpr (ALIGN_EPI) { if (wr == 1) PG8_BAR; }
    }
    PG8_WAIT_V(0);
    if constexpr (!ALIGN_EPI) { if (wr == 0) PG8_BAR; }
    PG8_BAR;
    if constexpr (Epi::AFTER_DRAIN) { E.fused(acc, cur, wr, wc, fr, fq, lds, wid, lane); S.done(cur); }
#undef PG8_SA
#undef PG8_SB
#undef PG8_STAGE
#undef PG8_LDA
#undef PG8_LDB
#undef PG8_MMA
#undef PG8_WAIT_V
#undef PG8_WAIT_L
#undef PG8_BAR
#undef PG8_SCHED
}
}

namespace mk {
using nv::pi16; using nv::bf16; using nv::S_; using nv::D_; using nv::M_; using nv::LOG2E; using nv::QSCALE; using nv::EPS;
#define GAS __attribute__((address_space(1)))
#define LAS __attribute__((address_space(3)))
typedef unsigned v4u __attribute__((ext_vector_type(4)));
typedef unsigned v2u __attribute__((ext_vector_type(2)));
typedef float f32x4 __attribute__((ext_vector_type(4)));
constexpr int NWAVES = 8;
using namespace lay;
constexpr int RING_BYTES = 131072, LDSCTL_OFF = RING_BYTES, MISC_OFF = LDSCTL_OFF + 320, LDS_BYTES = 147456;

#define RLX_AGENT __ATOMIC_RELAXED, __HIP_MEMORY_SCOPE_AGENT
#define LDS_WAIT() asm volatile("s_waitcnt lgkmcnt(0)" ::: "memory")
#define VM_WAIT() asm volatile("s_waitcnt vmcnt(0)" ::: "memory")
__device__ __forceinline__ unsigned f2bfu(float f) { unsigned u = __builtin_bit_cast(unsigned, f); return (u + 0x7fffu + ((u >> 16) & 1u)) >> 16; }
__device__ __forceinline__ unsigned pk2(float lo, float hi) { return f2bfu(lo) | (f2bfu(hi) << 16); }
__device__ __forceinline__ float wsum(float v) {
#pragma unroll
    for (int o = 1; o < 64; o <<= 1) v += __shfl_xor(v, o);
    return v; }
__device__ __forceinline__ float silu_f(float x) { return x * __builtin_amdgcn_rcpf(1.f + __builtin_amdgcn_exp2f(-x * LOG2E)); }

#define XB_TMO      128
#define XB_XCNT(j)  (256  + 64 * (j))
#define XB_XSUB(j)  (1280 + 64 * (j))
#define XB_XGEN(j)  (2304 + 64 * (j))
#define XB_TOP      3328
#define XB_TOPGEN   3392
#define XCD_BAR_WORDS 3456
#define XB_SPIN_CAP (1u << 18)

__device__ __forceinline__ unsigned xb_ld(unsigned* p)              { return __hip_atomic_load(p, __ATOMIC_RELAXED, __HIP_MEMORY_SCOPE_AGENT); }
__device__ __forceinline__ unsigned xb_add(unsigned* p, unsigned v) { return __hip_atomic_fetch_add(p, v, __ATOMIC_RELAXED, __HIP_MEMORY_SCOPE_AGENT); }
__device__ __forceinline__ unsigned xb_xcc_id() { return (unsigned)__builtin_amdgcn_s_getreg((3 << 11) | 20) & 0xFu; }
#define XB_SPIN(cond, bar) do { unsigned _sp = 0; while (cond) { __builtin_amdgcn_s_sleep(1); \
    if ((++_sp & 255u) == 0u) { if (xb_ld(&(bar)[XB_TMO])) break; if (_sp > XB_SPIN_CAP) { atomicAdd(&(bar)[XB_TMO], 1u); break; } } } } while (0)

__device__ __forceinline__ bool wg_leader(int wave) { return wave == 0 && __builtin_amdgcn_mbcnt_hi(~0u, __builtin_amdgcn_mbcnt_lo(~0u, 0u)) == 0u; }
struct XcdBarrier {
    int wave;
    unsigned* bar; unsigned x;
    volatile LAS unsigned* st;
};

__device__ __forceinline__ XcdBarrier xcd_barrier_post(unsigned* bar, volatile LAS unsigned* st, int wave) {
    XcdBarrier b; b.wave = wave; b.bar = bar; b.x = xb_xcc_id(); b.st = st;
    if (wg_leader(wave)) (void)xb_add(&bar[XB_XCNT(b.x)], 1u);
    return b;
}
__device__ __forceinline__ void xcd_barrier_complete(unsigned* bar, unsigned x, unsigned& nloc, unsigned& nx) {
    const unsigned G = gridDim.x * gridDim.y * gridDim.z;
    unsigned sum, cnt, mine, sp = 0u;
    for (;;) {
        sum = 0u; cnt = 0u; mine = 0u;
#pragma unroll
        for (unsigned j = 0; j < 16; ++j) { const unsigned c = xb_ld(&bar[XB_XCNT(j)]); sum += c; cnt += (c > 0u) ? 1u : 0u; mine = (j == x) ? c : mine; }
        if (sum == G) break;
        __builtin_amdgcn_s_sleep(1);
        if ((++sp & 255u) == 0u) { if (xb_ld(&bar[XB_TMO])) break; if (sp > XB_SPIN_CAP) { atomicAdd(&bar[XB_TMO], 1u); break; } }
    }
    nloc = mine > 0u ? mine : 1u; nx = cnt > 0u ? cnt : 1u;
}

__device__ __forceinline__ void xcd_barrier(const XcdBarrier& b) {
    asm volatile("s_waitcnt vmcnt(0)" ::: "memory");
    __syncthreads();
    if (wg_leader(b.wave)) {
        unsigned* bar = b.bar;
        __builtin_amdgcn_s_waitcnt(0);
        unsigned nloc = b.st[0], nx = b.st[1];
        if (nloc == 0u) { xcd_barrier_complete(bar, b.x, nloc, nx); b.st[0] = nloc; b.st[1] = nx; }
        const unsigned old = xb_add(&bar[XB_XSUB(b.x)], 1u);
        const unsigned gen = old / nloc;
        if (old + 1u == (gen + 1u) * nloc) {
            __builtin_amdgcn_fence(__ATOMIC_RELEASE, "agent");
            asm volatile("s_waitcnt vmcnt(0)" ::: "memory");
            const unsigned og = xb_add(&bar[XB_TOP], 1u);
            const unsigned tg = og / nx;
            if (og + 1u == (tg + 1u) * nx) xb_add(&bar[XB_TOPGEN], 1u);
            else XB_SPIN(xb_ld(&bar[XB_TOPGEN]) == tg, bar);
            __builtin_amdgcn_fence(__ATOMIC_ACQUIRE, "agent");
            xb_add(&bar[XB_XGEN(b.x)], 1u);
            asm volatile("s_waitcnt vmcnt(0)" ::: "memory");
        } else {
            XB_SPIN(xb_ld(&bar[XB_XGEN(b.x)]) == gen, bar);
            __builtin_amdgcn_fence(__ATOMIC_ACQUIRE, "agent");
            asm volatile("s_waitcnt vmcnt(0)" ::: "memory");
        }
    }
    __syncthreads();
}


__device__ __forceinline__ void p0_transpose_item(const float* W, int K, int N, bf16* WT, LAS float* scr, int item, int lane) {
    const int nblk = N / 32, kb = item / nblk, nb = item % nblk, k0 = 64 * kb, n0 = 32 * nb;
#pragma unroll 8
    for (int i = 0; i < 32; ++i) { const int kk = 2 * i + (lane >> 5); scr[kk * 33 + (lane & 31)] = W[(size_t)(k0 + kk) * N + n0 + (lane & 31)]; }
    LDS_WAIT(); asm volatile("" ::: "memory");
    const int c = lane & 7;
#pragma unroll
    for (int j = 0; j < 4; ++j) { const int n = (lane >> 3) + 8 * j; const LAS float* s = scr + (8 * c) * 33 + n;
        v4u o; o.x = pk2(s[0 * 33], s[1 * 33]); o.y = pk2(s[2 * 33], s[3 * 33]); o.z = pk2(s[4 * 33], s[5 * 33]); o.w = pk2(s[6 * 33], s[7 * 33]);
        *(GAS v4u*)(WT + (size_t)(n0 + n) * K + k0 + 8 * c) = o; }
    LDS_WAIT(); asm volatile("" ::: "memory");
}
__device__ __forceinline__ void gemv8_item(const float* W, int ldw, int n0, const LAS float* vec, LAS float* red, const float* bias, float* out, int ldo, int wave, int lane) {
    float acc[8];
#pragma unroll
    for (int b = 0; b < 8; ++b) acc[b] = 0.f;
    const float* wp = W + (size_t)(wave * 128) * ldw + n0 + lane;
#pragma unroll 8
    for (int kk = 0; kk < 128; ++kk) { const float w = wp[(size_t)kk * ldw]; const int k = wave * 128 + kk;
#pragma unroll
        for (int b = 0; b < 8; ++b) acc[b] += vec[b * 1024 + k] * w; }
#pragma unroll
    for (int b = 0; b < 8; ++b) red[(wave * 8 + b) * 64 + lane] = acc[b];
    __syncthreads();
    { float s = 0.f;
#pragma unroll
      for (int w = 0; w < 8; ++w) s += red[(w * 8 + wave) * 64 + lane];
      out[(size_t)wave * ldo + n0 + lane] = s + (bias ? bias[n0 + lane] : 0.f); }
    __syncthreads();
}

typedef short bf16x8 __attribute__((ext_vector_type(8)));
typedef short s16x4 __attribute__((ext_vector_type(4)));
typedef short v4i16_t __attribute__((ext_vector_type(4)));
typedef float f32x16 __attribute__((ext_vector_type(16)));
constexpr float NEGBIG = -1e30f;
constexpr float THR = 8.f;
typedef _Float16 h16x4_t __attribute__((ext_vector_type(4)));
__device__ __forceinline__ int crow(int r, int hi) { return (r & 3) + 8 * (r >> 2) + 4 * hi; }
__device__ __forceinline__ unsigned cvtpk_c(float lo, float hi) { typedef float f2_t __attribute__((ext_vector_type(2))); typedef __bf16 b2_t __attribute__((ext_vector_type(2)));
    f2_t v = {lo, hi}; b2_t bb = __builtin_convertvector(v, b2_t); return __builtin_bit_cast(unsigned, bb); }
__device__ __forceinline__ float swapmax(float v) { auto rr = __builtin_amdgcn_permlane32_swap(__float_as_uint(v), __float_as_uint(v), false, false); return fmaxf(__uint_as_float(rr[0]), __uint_as_float(rr[1])); }
__device__ __forceinline__ float swapsum(float v) { auto rr = __builtin_amdgcn_permlane32_swap(__float_as_uint(v), __float_as_uint(v), false, false); return __uint_as_float(rr[0]) + __uint_as_float(rr[1]); }
__device__ __forceinline__ s16x4 vtr(const LAS char* p) { return __builtin_bit_cast(s16x4, __builtin_amdgcn_ds_read_tr16_b64_v4i16((LAS v4i16_t*)p)); }
__device__ __forceinline__ float max3(float a, float b, float c) { return fmaxf(fmaxf(a, b), c); }
__device__ __forceinline__ float rowmax16(const f32x16& p) {
    const float a = max3(p[0], p[1], p[2]), b = max3(p[3], p[4], p[5]), c = max3(p[6], p[7], p[8]), d = max3(p[9], p[10], p[11]), e = max3(p[12], p[13], p[14]);
    return max3(max3(a, b, c), max3(d, e, p[15]), a); }
__device__ __forceinline__ float rowsum16(const f32x16& p) {
    typedef float f2v __attribute__((ext_vector_type(2)));
    const f2v a = (f2v){p[0], p[1]} + (f2v){p[2], p[3]}, b = (f2v){p[4], p[5]} + (f2v){p[6], p[7]}, c = (f2v){p[8], p[9]} + (f2v){p[10], p[11]}, d = (f2v){p[12], p[13]} + (f2v){p[14], p[15]};
    const f2v e = (a + b) + (c + d); return e.x + e.y; }
__device__ __forceinline__ float rowsum32(const f32x16& p, const f32x16& q) {
    typedef float f2v __attribute__((ext_vector_type(2)));
    f2v a = (f2v){p[0], p[1]} + (f2v){q[0], q[1]};
#pragma unroll
    for (int i = 1; i < 8; ++i) a = a + ((f2v){p[2 * i], p[2 * i + 1]} + (f2v){q[2 * i], q[2 * i + 1]});
    return a.x + a.y; }
__device__ __forceinline__ void glds16(const void* gsrc, LAS unsigned char* dst_uniform) {
    __builtin_amdgcn_global_load_lds((const unsigned*)gsrc, (LAS unsigned*)dst_uniform, 16, 0, 0);
}
__device__ __forceinline__ void glds16_asm_s(unsigned voff, const void* sbase_uniform, unsigned lds_dst_uniform) { unsigned keep;
    asm volatile("s_mov_b32 %0, m0\n\ts_mov_b32 m0, %3\n\ts_nop 0\n\tglobal_load_lds_dwordx4 %1, %2\n\ts_mov_b32 m0, %0" : "=&s"(keep) : "v"(voff), "s"(sbase_uniform), "s"(lds_dst_uniform) : "memory"); }

template <int DV> struct WState { bf16x8 qr[4]; f32x16 o[DV / 32]; float m, l; };
__device__ __forceinline__ void q_fetch(bf16x8 (&q)[4], const bf16* qrow  ) {
#pragma unroll
    for (int d0 = 0; d0 < 4; ++d0) q[d0] = *(const bf16x8*)(qrow + d0 * 16);
}
template <int DV> __device__ __forceinline__ void w_begin(WState<DV>& w, const bf16x8 (&q)[4]) {
#pragma unroll
    for (int d0 = 0; d0 < 4; ++d0) { w.qr[d0] = q[d0]; asm volatile("" : "+v"(w.qr[d0])); }
#pragma unroll
    for (int d = 0; d < DV / 32; ++d)
#pragma unroll
        for (int r = 0; r < 16; ++r) w.o[d][r] = 0.f;
    w.m = 0.f; w.l = 0.f;
}
__device__ __forceinline__ int v_rd_base(int lane) { return ((lane >> 4) & 1) * 32 + (lane & 3) * 8 + (4 * (lane >> 5) + ((lane & 15) >> 2)) * 64; }
constexpr int VHI = 512;
#define PK4(P, BASE, OUT) do { v4u wv = {cvtpk_c(P[BASE + 0], P[BASE + 1]), cvtpk_c(P[BASE + 2], P[BASE + 3]), cvtpk_c(P[BASE + 4], P[BASE + 5]), cvtpk_c(P[BASE + 6], P[BASE + 7])}; \
    OUT = __builtin_bit_cast(bf16x8, wv); } while (0)
typedef float f2_t __attribute__((ext_vector_type(2)));
#define P2_(p, i) ((f2_t){p[2 * (i)], p[2 * (i) + 1]})

template <int DV, bool FIRST, class MaskF>
__device__ __forceinline__ void step32(WState<DV>& w, const LAS char* kb, const LAS char* vb, const f32x16& R, float doff, bool mixed, MaskF mf, int lane) {
    const int r32 = lane & 31, hi = lane >> 5;
    f32x16 p; const float mref = FIRST ? 0.f : w.m;
    if (!mixed) { const float sgn = doff > 0.f ? -1.f : 1.f, add = -fabsf(doff) - mref;
#pragma unroll
        for (int i = 0; i < 8; ++i) { const f2_t v = P2_(R, i) * sgn + add; p[2 * i] = v.x; p[2 * i + 1] = v.y; } }
    else {
#pragma unroll
        for (int r = 0; r < 16; ++r) p[r] = -fabsf(R[r] + doff) - mref; }
    { const LAS char* krow = kb + r32 * 128; const int ksw = (r32 >> 1) & 7;
      bf16x8 kf[4];
#pragma unroll
      for (int d0 = 0; d0 < 4; ++d0) kf[d0] = *(const LAS bf16x8*)(krow + (((2 * d0 + hi) ^ ksw) << 4));
#pragma unroll
      for (int d0 = 0; d0 < 4; ++d0) p = __builtin_amdgcn_mfma_f32_32x32x16_bf16(kf[d0], w.qr[d0], p, 0, 0, 0); }
    if (mf.on) mf(p);
    const float pmax = swapmax(rowmax16(p));
    if (FIRST) { w.m = pmax;
#pragma unroll
        for (int r = 0; r < 16; ++r) p[r] -= pmax; }
    else if (__any(pmax > THR)) { const float inc = pmax > THR ? pmax : 0.f, alpha = __builtin_amdgcn_exp2f(-inc); w.m += inc; w.l *= alpha;
#pragma unroll
        for (int r = 0; r < 16; ++r) p[r] -= inc;
#pragma unroll
        for (int d = 0; d < DV / 32; ++d)
#pragma unroll
            for (int r = 0; r < 16; ++r) w.o[d][r] *= alpha; }
#pragma unroll
    for (int r = 0; r < 16; ++r) p[r] = __builtin_amdgcn_exp2f(p[r]);
    w.l += swapsum(rowsum16(p));
    bf16x8 pa0, pa1; PK4(p, 0, pa0); PK4(p, 8, pa1);
    const LAS char* vbase = vb + v_rd_base(lane);
#pragma unroll
    for (int d = 0; d < DV / 32; ++d) {
        const s16x4 l0 = vtr(vbase + d * 2048), h0 = vtr(vbase + d * 2048 + VHI), l1 = vtr(vbase + d * 2048 + 1024), h1 = vtr(vbase + d * 2048 + 1024 + VHI);
        const bf16x8 v0 = (bf16x8){l0[0], l0[1], l0[2], l0[3], h0[0], h0[1], h0[2], h0[3]}, v1 = (bf16x8){l1[0], l1[1], l1[2], l1[3], h1[0], h1[1], h1[2], h1[3]};
        w.o[d] = __builtin_amdgcn_mfma_f32_32x32x16_bf16(v0, pa0, w.o[d], 0, 0, 0);
        w.o[d] = __builtin_amdgcn_mfma_f32_32x32x16_bf16(v1, pa1, w.o[d], 0, 0, 0);
    }
}
struct NoMask { static constexpr bool on = false; __device__ __forceinline__ void operator()(f32x16&) const {} };

#define ROLE_OF(wave) ((wave) >> 2)
#define ATT_WAIT_BAR(N) asm volatile("s_waitcnt vmcnt(" #N ") lgkmcnt(0)\n\ts_barrier" ::: "memory")
__device__ __forceinline__ void diff_unit(LAS unsigned char* lds, int b, int h, int qt, const bf16* QB, const bf16* KB, const bf16* VB, const bf16* SG,
                                          const float* subln_g, float lam, float lam_init, bf16* YM, int wv) {
    int tid = wv * 64 + (int)__builtin_amdgcn_mbcnt_hi(~0u, __builtin_amdgcn_mbcnt_lo(~0u, 0u)); asm volatile("" : "+v"(tid));
    const int lane = tid & 63, wave = __builtin_amdgcn_readfirstlane(tid >> 6), r32 = lane & 31, hi = lane >> 5;
    const int which = wave >> 2, sub = wave & 3, q0 = qt * 128 + sub * 32;
    const float slope = __builtin_amdgcn_exp2f(-2.f * (float)(h + 1)) * LOG2E;
    const bf16* K1 = KB + (size_t)(b * 8 + h * 2) * S_ * 64; const bf16* Vh = VB + (size_t)(b * 4 + h) * S_ * 128;
    unsigned offK, offV0, offV1, dstK, dstV0, dstV1;
    { const int kkb = 8 * (wave & 3) + (lane >> 3), c = (lane & 7) ^ ((kkb >> 1) & 7);
      offK = (unsigned)((8 * wave + (lane >> 3)) * 64 + c * 8) * 2u; dstK = wave * 1024;
      const int v0 = wave, v1 = wave + 8;
      offV0 = (unsigned)((32 * (v0 >> 3) + 16 * (v0 & 1) + (lane >> 2)) * 128 + ((v0 >> 1) & 3) * 32 + (lane & 3) * 8) * 2u; dstV0 = 16384 + (v0 >> 3) * 8192 + ((v0 >> 1) & 3) * 2048 + (v0 & 1) * 1024;
      offV1 = (unsigned)((32 * (v1 >> 3) + 16 * (v1 & 1) + (lane >> 2)) * 128 + ((v1 >> 1) & 3) * 32 + (lane & 3) * 8) * 2u; dstV1 = 16384 + (v1 >> 3) * 8192 + ((v1 >> 1) & 3) * 2048 + (v1 & 1) * 1024; }
    const unsigned lds0 = (unsigned)(uintptr_t)lds;
    constexpr int NT = S_ / 64;
    const int tdb = 2 * qt;
#define TILE_OF(i) ((i) < 2 ? tdb + (i) : ((i) - 2 < tdb ? (i) - 2 : (i)))
#define RFL(x) ((unsigned)__builtin_amdgcn_readfirstlane((int)(x)))
#define DDMA(i) do { const int ii_ = (i) < NT ? (i) : NT - 1; const int ts_ = TILE_OF(ii_); const unsigned bb_ = RFL(lds0 + (unsigned)(((i) & 3) * 32768)); \
        const char* kb_ = (const char*)K1 + (size_t)ts_ * 8192; const char* vb_ = (const char*)Vh + (size_t)ts_ * 16384; \
        glds16_asm_s(offK, kb_, RFL(bb_ + dstK)); glds16_asm_s(offK, kb_ + (size_t)S_ * 128, RFL(bb_ + 8192u + dstK)); \
        glds16_asm_s(offV0, vb_, RFL(bb_ + dstV0)); glds16_asm_s(offV1, vb_, RFL(bb_ + dstV1)); } while (0)
    DDMA(0); DDMA(1);
    WState<128> w;
    { bf16x8 q[4]; q_fetch(q, QB + ((size_t)(b * 8 + h * 2 + which) * S_ + q0 + r32) * 64 + hi * 8); w_begin<128>(w, q); }
    const float basef = (float)(4 * hi - r32);
    f32x16 Tr;
#pragma unroll
    for (int r = 0; r < 16; ++r) Tr[r] = slope * (basef + 64.f + (float)((r & 3) + 8 * (r >> 2)));
    f32x16 p0, p1, e0, e1; bf16x8 pa0, pa1, pa2, pa3;
#define KB_(i) ((const LAS char*)(lds + ((i) & 3) * 32768) + which * 8192)
#define VB_(i) ((const LAS char*)(lds + ((i) & 3) * 32768) + 16384)
    struct F4 { bf16x8 a, b, c, d; };
    const int ksw = (r32 >> 1) & 7;
#define SB_() __builtin_amdgcn_sched_barrier(0)
#define CR_(r) ((float)(((r) & 3) + 8 * ((r) >> 2)))
#define CTILE(E, dk, MREF) do { const int dki_ = (dk); const float dk_ = (float)dki_; \
        if (dki_ >= 64)       { const float ad_ = -slope * (dk_ - 64.f) - (MREF); _Pragma("unroll") for (int i = 0; i < 8; ++i) { const f2_t v = ad_ - P2_(Tr, i); E[2 * i] = v.x; E[2 * i + 1] = v.y; } } \
        else if (dki_ <= -64) { const float ad_ = slope * (dk_ - 64.f) - (MREF); _Pragma("unroll") for (int i = 0; i < 8; ++i) { const f2_t v = ad_ + P2_(Tr, i); E[2 * i] = v.x; E[2 * i + 1] = v.y; } } \
        else { const float sb_ = slope * (dk_ - 64.f), mr_ = (MREF); _Pragma("unroll") for (int r = 0; r < 16; ++r) E[r] = -fabsf(Tr[r] + sb_) - mr_; } } while (0)
#define VF_(P) (bf16x8){lo_[0], lo_[1], lo_[2], lo_[3], hi_[0], hi_[1], hi_[2], hi_[3]}
#define LDV1(DST, OFF) do { const s16x4 lo_ = vtr(vbp + (OFF)), hi_ = vtr(vbp + (OFF) + VHI); DST = VF_(0); } while (0)
#define LOADV(F, DI) do { LDV1(F.a, (DI) * 2048); LDV1(F.b, (DI) * 2048 + 1024); LDV1(F.c, 8192 + (DI) * 2048); LDV1(F.d, 8192 + (DI) * 2048 + 1024); } while (0)
#define KCO_(d0) (((2 * (d0) + hi) ^ ksw) << 4)
#define LOADK(F, dp) do { F.a = *(const LAS bf16x8*)(kbp + KCO_(2 * (dp))); F.b = *(const LAS bf16x8*)(kbp + 4096 + KCO_(2 * (dp))); \
        F.c = *(const LAS bf16x8*)(kbp + KCO_(2 * (dp) + 1)); F.d = *(const LAS bf16x8*)(kbp + 4096 + KCO_(2 * (dp) + 1)); } while (0)
#define PVM(F, DI) do { w.o[DI] = __builtin_amdgcn_mfma_f32_32x32x16_bf16(F.a, pa0, w.o[DI], 0, 0, 0); w.o[DI] = __builtin_amdgcn_mfma_f32_32x32x16_bf16(F.b, pa1, w.o[DI], 0, 0, 0); \
        w.o[DI] = __builtin_amdgcn_mfma_f32_32x32x16_bf16(F.c, pa2, w.o[DI], 0, 0, 0); w.o[DI] = __builtin_amdgcn_mfma_f32_32x32x16_bf16(F.d, pa3, w.o[DI], 0, 0, 0); } while (0)
#define QKM(F, dp, C0, C1) do { p0 = __builtin_amdgcn_mfma_f32_32x32x16_bf16(F.a, w.qr[2 * (dp)], C0, 0, 0, 0); p1 = __builtin_amdgcn_mfma_f32_32x32x16_bf16(F.b, w.qr[2 * (dp)], C1, 0, 0, 0); \
        p0 = __builtin_amdgcn_mfma_f32_32x32x16_bf16(F.c, w.qr[2 * (dp) + 1], p0, 0, 0, 0); p1 = __builtin_amdgcn_mfma_f32_32x32x16_bf16(F.d, w.qr[2 * (dp) + 1], p1, 0, 0, 0); } while (0)
#define SOFTMAX_SEG(FIRST_, inext, icur) do { const float pmax = swapmax(fmaxf(rowmax16(p0), rowmax16(p1))); skp = !(FIRST_) && __all(pmax < SKIP_BELOW); \
        if (!skp) { \
        if (FIRST_) { w.m = pmax; _Pragma("unroll") for (int r = 0; r < 16; ++r) { p0[r] -= pmax; p1[r] -= pmax; } } \
        else if (__any(pmax > THR)) { const float inc = pmax > THR ? pmax : 0.f, alpha = __builtin_amdgcn_exp2f(-inc); w.m += inc; w.l *= alpha; \
            _Pragma("unroll") for (int r = 0; r < 16; ++r) { p0[r] -= inc; p1[r] -= inc; } \
            _Pragma("unroll") for (int dd = 0; dd < 4; ++dd) _Pragma("unroll") for (int r = 0; r < 16; ++r) w.o[dd][r] *= alpha; } \
        _Pragma("unroll") for (int r = 0; r < 16; ++r) { p0[r] = __builtin_amdgcn_exp2f(p0[r]); p1[r] = __builtin_amdgcn_exp2f(p1[r]); } \
        w.l += swapsum(rowsum32(p0, p1)); \
        PK4(p0, 0, pa0); PK4(p0, 8, pa1); PK4(p1, 0, pa2); PK4(p1, 8, pa3); \
        { const LAS char* vbp = VB_(icur) + v_rd_base(lane); LOADV(X, 0); LOADV(Y, 1); } }     \
        { const int tn_ = TILE_OF((inext) < NT ? (inext) : NT - 1); CTILE(e0, tn_ * 64 - q0, w.m); CTILE(e1, tn_ * 64 + 32 - q0, w.m); } } while (0)
    constexpr float SKIP_BELOW = -28.f; bool skp = false;
    CTILE(e0, tdb * 64 - q0, 0.f); CTILE(e1, tdb * 64 + 32 - q0, 0.f);
#define MSEG(i) do { const LAS char* vbp = VB_((i) - 1) + v_rd_base(lane); const LAS char* kbp = KB_(i) + r32 * 128; \
        if ((i) > 0 && !skp) { LOADV(Z, 2); PVM(X, 0); LOADV(X, 3); PVM(Y, 1); PVM(Z, 2); PVM(X, 3); } \
        LOADK(Y, 0); LOADK(Z, 1); QKM(Y, 0, e0, e1); QKM(Z, 1, p0, p1); } while (0)
    const int role = ROLE_OF(wave);
    F4 X, Y, Z;
    ATT_WAIT_BAR(4);
    DDMA(2);
    if (role == 0) {
        MSEG(0); SOFTMAX_SEG(true, 1, 0);
        ATT_WAIT_BAR(4);
#pragma unroll 1
        for (int i = 1; i < NT; ++i) { DDMA(i + 2); MSEG(i); SOFTMAX_SEG(false, i + 1, i); ATT_WAIT_BAR(4); }
    } else {
        MSEG(0);
        ATT_WAIT_BAR(4);
        DDMA(3); SOFTMAX_SEG(true, 1, 0); MSEG(1);
        ATT_WAIT_BAR(4);
#pragma unroll 1
        for (int i = 2; i < NT; ++i) { DDMA(i + 2); SOFTMAX_SEG(false, i, i - 1); MSEG(i); ATT_WAIT_BAR(4); }
        SOFTMAX_SEG(false, NT, NT - 1);
    }
    { const LAS char* vbp = VB_(NT - 1) + v_rd_base(lane);
      if (!skp) { LOADV(Z, 2); PVM(X, 0); LOADV(X, 3); PVM(Y, 1); PVM(Z, 2); PVM(X, 3); } }
#undef MSEG
#undef SOFTMAX_SEG
#undef QKM
#undef PVM
#undef LOADK
#undef KCO_
#undef LOADV
#undef LDV1
#undef VF_
#undef CTILE
#undef CR_
#undef SB_
    ATT_WAIT_BAR(0);
#undef DDMA
#undef RFL
#undef TILE_OF
#undef KB_
#undef VB_
    LAS float* XCH = (LAS float*)lds + sub * 4096;
    const size_t rowoff = ((size_t)b * S_ + q0 + r32) * 1024 + 512 + h * 128;
    v2u sgv[16]; f32x4 gv[16];
    if (which == 0) {
#pragma unroll
        for (int i = 0; i < 16; ++i) { const int dv = 32 * (i >> 2) + 8 * (i & 3) + 4 * hi; sgv[i] = *(const v2u*)(SG + rowoff + dv); gv[i] = *(const f32x4*)(subln_g + dv); } }
    if (which == 1) { const float sc2 = lam / w.l;
#pragma unroll
        for (int d = 0; d < 4; ++d)
#pragma unroll
            for (int r = 0; r < 16; ++r) XCH[(d * 16 + r) * 64 + lane] = w.o[d][r] * sc2; }
    __syncthreads();
    if (which == 0) { const float il = 1.f / w.l; float ss = 0.f;
#pragma unroll
        for (int d = 0; d < 4; ++d)
#pragma unroll
            for (int r = 0; r < 16; ++r) { const float v = w.o[d][r] * il - XCH[(d * 16 + r) * 64 + lane]; w.o[d][r] = v; ss += v * v; }
        ss = swapsum(ss);
        const float rs = rsqrtf(ss * (1.f / 128.f) + EPS) * (1.f - lam_init);
#pragma unroll
        for (int i = 0; i < 16; ++i) { const int d = i >> 2, rr = i & 3, dv = 32 * d + 8 * rr + 4 * hi; const f32x4 g = gv[i];
            const float s0 = __uint_as_float(sgv[i].x << 16), s1 = __uint_as_float(sgv[i].x & 0xffff0000u), s2 = __uint_as_float(sgv[i].y << 16), s3 = __uint_as_float(sgv[i].y & 0xffff0000u);
            v2u o2; o2.x = pk2(w.o[d][4 * rr] * rs * g.x * s0, w.o[d][4 * rr + 1] * rs * g.y * s1); o2.y = pk2(w.o[d][4 * rr + 2] * rs * g.z * s2, w.o[d][4 * rr + 3] * rs * g.w * s3);
            *(v2u*)(YM + rowoff + dv) = o2; } }
    __syncthreads();
}

template <class RowFn>
__device__ __forceinline__ void stage_blocks(LAS unsigned char* lds, int nblk, const bf16* Kh, const bf16* Vh, RowFn rowfn, int wave, int lane) {
    for (int pc = wave; pc < nblk * 8; pc += NWAVES) {
        const int blk = pc >> 3, j = pc & 7;
        if (j < 4) { const int kk = 8 * j + (lane >> 3), c = (lane & 7) ^ ((kk >> 1) & 7); const long ro = rowfn(blk, kk);
            if (ro >= 0) glds16(Kh + ro + c * 8, lds + blk * 4096 + j * 1024); }
        else { const int vp = j - 4, kk = 16 * (vp & 1) + (lane >> 2); const long ro = rowfn(blk, kk);
            if (ro >= 0) glds16(Vh + ro + (vp >> 1) * 32 + (lane & 3) * 8, lds + 65536 + blk * 4096 + (vp >> 1) * 2048 + (vp & 1) * 1024); }
    }
}
struct BandMask { bool on; int dk, W, r32, hi; __device__ __forceinline__ void operator()(f32x16& p) const {
#pragma unroll
    for (int r = 0; r < 16; ++r) { const int dist = crow(r, hi) - r32 + dk; if (dist > W || dist < -W) p[r] = NEGBIG; } } };
#define STORE_Y64(w, sc, sgv, YM, rowoff) do { _Pragma("unroll") for (int i_ = 0; i_ < 8; ++i_) { const int d_ = i_ >> 2, rr_ = i_ & 3, dv_ = 32 * d_ + 8 * rr_ + 4 * hi; \
        const float s0 = __uint_as_float(sgv[i_].x << 16), s1 = __uint_as_float(sgv[i_].x & 0xffff0000u), s2 = __uint_as_float(sgv[i_].y << 16), s3 = __uint_as_float(sgv[i_].y & 0xffff0000u); \
        v2u o2; o2.x = pk2(w.o[d_][4 * rr_] * sc * s0, w.o[d_][4 * rr_ + 1] * sc * s1); o2.y = pk2(w.o[d_][4 * rr_ + 2] * sc * s2, w.o[d_][4 * rr_ + 3] * sc * s3); \
        *(v2u*)(YM + rowoff + dv_) = o2; } } while (0)

__device__ __forceinline__ void band_unit(LAS unsigned char* lds, int b, int g, int s4, const bf16* QC, const bf16* KC, const bf16* VC, const bf16* SG, const float* sink, bf16* YM, int it_lo, int it_hi, int wv) {
    int tid = wv * 64 + (int)__builtin_amdgcn_mbcnt_hi(~0u, __builtin_amdgcn_mbcnt_lo(~0u, 0u)); asm volatile("" : "+v"(tid));
    const int lane = tid & 63, wave = __builtin_amdgcn_readfirstlane(tid >> 6), r32 = lane & 31, hi = lane >> 5;
    const int head = g * 4 + (wave >> 1), sub = wave & 1, ks = s4 * 256 - 128;
    const bf16* Kh = KC + (size_t)(b * 4 + g) * S_ * 64; const bf16* Vh = VC + (size_t)(b * 4 + g) * S_ * 64;
    stage_blocks(lds, 16, Kh, Vh, [&](int blk, int kk) -> long { const int t = ks + blk * 32 + kk; return (t >= 0 && t < S_) ? (long)t * 64 : -1L; }, wave, lane);
    const float slope = __builtin_amdgcn_exp2f(-0.5f * (float)(head + 1)) * LOG2E;
    const bf16* Qh = QC + ((size_t)(b * 16 + head) * S_ + r32) * 64 + hi * 8;
    bf16x8 qn[4]; q_fetch(qn, Qh + (size_t)(s4 * 256 + it_lo * 64 + sub * 32) * 64);
    f32x16 R;
#pragma unroll
    for (int r = 0; r < 16; ++r) R[r] = slope * (float)(crow(r, hi) - r32);
    const float sk = sink[head] * LOG2E;
    __syncthreads();
#pragma unroll 1
    for (int it = it_lo; it < it_hi; ++it) {
        const int q0 = s4 * 256 + it * 64 + sub * 32;
        WState<64> w; w_begin<64>(w, qn);
        if (it + 1 < it_hi) q_fetch(qn, Qh + (size_t)(q0 + 64) * 64);
        const size_t rowoff = ((size_t)b * S_ + q0 + r32) * 1024 + head * 64;
        v2u sgv[8];
#pragma unroll
        for (int i = 0; i < 8; ++i) sgv[i] = *(const v2u*)(SG + rowoff + 32 * (i >> 2) + 8 * (i & 3) + 4 * hi);
        { const int j = (q0 - ks) >> 5; step32<64, true>(w, (const LAS char*)(lds + j * 4096), (const LAS char*)(lds + 65536 + j * 4096), R, 0.f, true, NoMask(), lane); }
#pragma unroll 1
        for (int i = 1; i < 9; ++i) {
            const int dk = (i & 1) ? -32 * ((i + 1) >> 1) : 32 * (i >> 1);
            const int kb0 = q0 + dk; if (kb0 < 0 || kb0 >= S_) continue;
            const int j = (kb0 - ks) >> 5;
            step32<64, false>(w, (const LAS char*)(lds + j * 4096), (const LAS char*)(lds + 65536 + j * 4096), R, slope * (float)dk, false, BandMask{dk == 128 || dk == -128, dk, 128, r32, hi}, lane);
        }
        const float Mx = fmaxf(w.m, sk), e = __builtin_amdgcn_exp2f(w.m - Mx);
        const float sc = e / (w.l * e + __builtin_amdgcn_exp2f(sk - Mx));
        STORE_Y64(w, sc, sgv, YM, rowoff);
    }
    __syncthreads();
}

struct DilMask { bool on; int dm0, dr, own, r32, hi; __device__ __forceinline__ void operator()(f32x16& p) const {
    const float base = (float)(16 * (dm0 + 4 * hi - r32) + dr);
    if (own) {
#pragma unroll
        for (int r = 0; r < 16; ++r) { const float ad = fabsf(base + (float)(16 * ((r & 3) + 8 * (r >> 2))));
            const float bonus = __builtin_amdgcn_fmed3f(fmaf(256.f - ad, 0.0625f, 1.f), 0.f, 1.f);
            p[r] = fmaf(fminf(1024.f - ad, 0.f), 1e30f, p[r] + bonus); } }
    else {
#pragma unroll
        for (int r = 0; r < 16; ++r) { const float ad = fabsf(base + (float)(16 * ((r & 3) + 8 * (r >> 2)))); p[r] = fmaf(fminf(256.f - ad, 0.f), 1e30f, p[r]); } } } };
__device__ __forceinline__ void dilB_unit(LAS unsigned char* lds, int b, int h, int r4, const bf16* QA, const bf16* KA, const bf16* VA, _Float16* STO, float* STML, int wv) {
    int tid = wv * 64 + (int)__builtin_amdgcn_mbcnt_hi(~0u, __builtin_amdgcn_mbcnt_lo(~0u, 0u)); asm volatile("" : "+v"(tid));
    const int lane = tid & 63, wave = __builtin_amdgcn_readfirstlane(tid >> 6), r32 = lane & 31, hi = lane >> 5;
    const size_t hb = (size_t)(b * 8 + h) * S_;
    const bf16* Kh = KA + hb * 64; const bf16* Vh = VA + hb * 64;
    stage_blocks(lds, 16, Kh, Vh, [&](int blk, int kk) -> long { return (long)(16 * ((blk & 3) * 32 + kk) + r4 + 4 * (blk >> 2)) * 64; }, wave, lane);
    const float slope = __builtin_amdgcn_exp2f(-(float)(h + 1)) * LOG2E;
    f32x16 R;
#pragma unroll
    for (int r = 0; r < 16; ++r) R[r] = 16.f * slope * (float)(crow(r, hi) - r32);
    const bf16* Qh = QA + (hb + 16 * r32) * 64 + hi * 8;
    bf16x8 qn[4]; q_fetch(qn, Qh + (size_t)(16 * 32 * (wave & 3) + r4 + 4 * (wave >> 2)) * 64);
    __syncthreads();
#pragma unroll 1
    for (int tk = 0; tk < 2; ++tk) {
        const int qi = tk * 2 + (wave >> 2), qmb = tk ? ((wave & 3) ^ 2) : (wave & 3), cq = r4 + 4 * qi, m0 = 32 * qmb;
        WState<64> w; w_begin<64>(w, qn);
        if (tk == 0) q_fetch(qn, Qh + (size_t)(16 * 32 * ((wave & 3) ^ 2) + r4 + 4 * (2 + (wave >> 2))) * 64);
        { const int blk = qi * 4 + qmb;
          step32<64, true>(w, (const LAS char*)(lds + blk * 4096), (const LAS char*)(lds + 65536 + blk * 4096), R, 0.f, true, DilMask{true, 0, 0, 1, r32, hi}, lane); }
#pragma unroll 1
        for (int s = 1; s < 16; ++s) {
            const int ki = (qi + (s >> 2)) & 3, kmb = (qmb + (s & 3)) & 3;
            const int dm0 = 32 * (kmb - qmb), dr = 4 * (ki - qi), own = (ki == qi);
            if (own ? (dm0 >= 96 || dm0 <= -96) : (dm0 >= 64 || dm0 <= -64)) continue;
            const int blk = ki * 4 + kmb;
            step32<64, false>(w, (const LAS char*)(lds + blk * 4096), (const LAS char*)(lds + 65536 + blk * 4096), R, slope * (float)(16 * dm0 + dr), dm0 == 0, DilMask{true, dm0, dr, own, r32, hi}, lane);
        }
        const int t = 16 * (m0 + r32) + cq;
        _Float16* so = STO + (hb + t) * 64; const float il = 1.f / w.l;
#pragma unroll
        for (int d = 0; d < 2; ++d)
#pragma unroll
            for (int rr = 0; rr < 4; ++rr) *(h16x4_t*)(so + 32 * d + 8 * rr + 4 * hi) = __builtin_convertvector((f32x4){w.o[d][4 * rr] * il, w.o[d][4 * rr + 1] * il, w.o[d][4 * rr + 2] * il, w.o[d][4 * rr + 3] * il}, h16x4_t);
        if (hi == 0) { float2 ml; ml.x = w.m; ml.y = w.l; *(float2*)(STML + (hb + t) * 2) = ml; }
    }
    __syncthreads();
}
__device__ __forceinline__ void dilA_unit(LAS unsigned char* lds, int b, int h, int qt, const bf16* QA, const bf16* KA, const bf16* VA, const _Float16* STO, const float* STML, const bf16* SG, bf16* YM, int wv) {
    int tid = wv * 64 + (int)__builtin_amdgcn_mbcnt_hi(~0u, __builtin_amdgcn_mbcnt_lo(~0u, 0u)); asm volatile("" : "+v"(tid));
    const int lane = tid & 63, wave = __builtin_amdgcn_readfirstlane(tid >> 6), r32 = lane & 31, hi = lane >> 5;
    const size_t hb = (size_t)(b * 8 + h) * S_;
    const bf16* Kh = KA + hb * 64; const bf16* Vh = VA + hb * 64;
    const int q0 = qt * 256 + wave * 32, ks = qt * 256 - 64, tq = q0 + r32;
    stage_blocks(lds, 12, Kh, Vh, [&](int blk, int kk) -> long { const int t = ks + blk * 32 + kk; return (t >= 0 && t < S_) ? (long)t * 64 : -1L; }, wave, lane);
    const float slope = __builtin_amdgcn_exp2f(-(float)(h + 1)) * LOG2E;
    WState<64> w;
    { bf16x8 q[4]; q_fetch(q, QA + (hb + tq) * 64 + hi * 8);
      const size_t rowoff = ((size_t)b * S_ + tq) * 1024 + h * 64; v2u sgv[8];
#pragma unroll
      for (int i = 0; i < 8; ++i) sgv[i] = *(const v2u*)(SG + rowoff + 32 * (i >> 2) + 8 * (i & 3) + 4 * hi);
      const _Float16* so = STO + (hb + tq) * 64; h16x4_t sv[8];
#pragma unroll
      for (int i = 0; i < 8; ++i) sv[i] = *(const h16x4_t*)(so + 32 * (i >> 2) + 8 * (i & 3) + 4 * hi);
      const float2 ml = *(const float2*)(STML + (hb + tq) * 2);
      w_begin<64>(w, q);
#pragma unroll
      for (int i = 0; i < 8; ++i) { const f32x4 f = __builtin_convertvector(sv[i], f32x4) * ml.y; w.o[i >> 2][4 * (i & 3)] = f.x; w.o[i >> 2][4 * (i & 3) + 1] = f.y; w.o[i >> 2][4 * (i & 3) + 2] = f.z; w.o[i >> 2][4 * (i & 3) + 3] = f.w; }
      w.m = ml.x; w.l = ml.y;
      f32x16 R;
#pragma unroll
      for (int r = 0; r < 16; ++r) R[r] = slope * (float)(crow(r, hi) - r32);
      __syncthreads();
#pragma unroll 1
      for (int i = 0; i < 5; ++i) {
          const int dk = 32 * (i - 2), kb0 = q0 + dk; if (kb0 < 0 || kb0 >= S_) continue;
          const int j = (kb0 - ks) >> 5;
          step32<64, false>(w, (const LAS char*)(lds + j * 4096), (const LAS char*)(lds + 65536 + j * 4096), R, slope * (float)dk, dk == 0, BandMask{dk == 64 || dk == -64, dk, 64, r32, hi}, lane);
      }
      const float sc = 1.f / w.l;
      STORE_Y64(w, sc, sgv, YM, rowoff); }
    __syncthreads();
}

__device__ __forceinline__ void xcc_local_barrier(unsigned* lb, unsigned x, unsigned* tmo, int wave) {
    asm volatile("s_waitcnt vmcnt(0)" ::: "memory");
    __syncthreads();
    if (wg_leader(wave)) {
        const unsigned old = xb_add(&lb[64 * x], 1u), gen = old / 32u;
        if (old + 1u == (gen + 1u) * 32u) xb_add(&lb[512 + 64 * x], 1u);
        else { unsigned sp = 0; while (xb_ld(&lb[512 + 64 * x]) == gen) { __builtin_amdgcn_s_sleep(1); if ((++sp & 255u) == 0u) { if (xb_ld(tmo)) break; if (sp > XB_SPIN_CAP) { atomicAdd(tmo, 1u); break; } } } }
        __builtin_amdgcn_fence(__ATOMIC_ACQUIRE, "agent");
        asm volatile("s_waitcnt vmcnt(0)" ::: "memory");
    }
    __syncthreads();
}
__device__ __forceinline__ void cu_wait_ge(unsigned* p, unsigned target, unsigned* tmo, int wave) {
    if (wg_leader(wave)) { unsigned sp = 0;
        while (xb_ld(p) < target) { __builtin_amdgcn_s_sleep(1); if ((++sp & 255u) == 0u) { if (xb_ld(tmo)) break; if (sp > XB_SPIN_CAP) { atomicAdd(tmo, 1u); break; } } }
        __builtin_amdgcn_fence(__ATOMIC_ACQUIRE, "agent"); asm volatile("s_waitcnt vmcnt(0)" ::: "memory"); }
    __syncthreads();
}
struct Args { const float* in[16]; float* out; unsigned char* ws; int ph_lo, ph_hi; };
constexpr int PROBE_BLK = 0, PROBE_UNIT = 2;
constexpr int PROBE_CAT = -1, PROBE_AMP = 4;
constexpr int PROBE_PH = -1, PROBE_REPS = 1;
constexpr int PH_P0A = 0, PH_P0B = 1, PH_L0 = 2, PH_FINAL = 18, PH_END = 18;

__global__ void __launch_bounds__(NWAVES * 64, 2) mega(Args args) {
    extern __shared__ __attribute__((aligned(16))) unsigned char lds_raw[];
    LAS unsigned char* lds = (LAS unsigned char*)lds_raw;
    volatile LAS unsigned* MISC = (volatile LAS unsigned*)(lds + MISC_OFF);
    const int tid = threadIdx.x, lane = tid & 63, wave = __builtin_amdgcn_readfirstlane(tid >> 6);
    const int G = gridDim.x; const int bx = blockIdx.x; const int vcu = (G % 8 == 0) ? (bx % 8) * (G / 8) + bx / 8 : bx;
    unsigned char* ws = args.ws;
    unsigned* ctl = (unsigned*)(ws + WS_CTL);
    for (int u = tid; u < (LDS_BYTES - LDSCTL_OFF) / 4; u += NWAVES * 64) ((LAS unsigned*)(lds + LDSCTL_OFF))[u] = 0u;
    __syncthreads();
    const unsigned myx = xb_xcc_id() & 7u;
    if (tid == 0) MISC[17] = xb_add(ctl + CW_RANK + 64 * myx, 1u);
    __syncthreads();
    const unsigned myrank = MISC[17];
    constexpr int lo = PH_P0A, hi = PH_END;
    const bool use_bar = (hi - lo) > 1;
    XcdBarrier bar; bar.bar = ctl + CW_BAR; bar.x = 0; bar.st = nullptr;
    if (use_bar) bar = xcd_barrier_post(ctl + CW_BAR, MISC + 8, wave);
    unsigned long long pacc[8] = {0, 0, 0, 0, 0, 0, 0, 0}; unsigned long long plast = 0, pbar = 0; const bool pon = (PROBE_CAT >= 0) && (PROBE_CAT < 8) && bx == 0 && wave == 0;
#define IN(k) (lo <= (k) && (k) < hi)
#define REPS(k) for (int rep_ = 0; rep_ < ((k) == PROBE_PH ? PROBE_REPS : 1); ++rep_)
#define SEAM(k) do { if (IN(k) && IN((k) + 1)) { if (PROBE_CAT == 8) { const unsigned long long tb_ = __builtin_readcyclecounter(); xcd_barrier(bar); pbar += __builtin_readcyclecounter() - tb_; } else xcd_barrier(bar); } } while (0)
    const float* x_in = args.in[0]; const float* c_in = args.in[1]; const float* ada_w = args.in[2]; const float* ada_b = args.in[3]; const float* norm_g = args.in[4];
    const float* ab_w_in = args.in[5]; const float* ab_w_out = args.in[6]; const float* c_w_in = args.in[12]; const float* c_w_out = args.in[13]; const float* final_g = args.in[15];
    float* mod = (float*)(ws + WS_MOD); float* shw = (float*)(ws + WS_SHW); float* ssq = (float*)(ws + WS_SSQ); float* lam = (float*)(ws + WS_LAM);
    bf16* XS = (bf16*)args.out;
    _Float16* STOp = (_Float16*)(args.out + (size_t)8 * 1024 * 1024); _Float16* X16 = (_Float16*)(ws + WS_X16);
    const int gw = vcu * NWAVES + wave, NGW = G * NWAVES;

    if (IN(PH_P0A)) REPS(PH_P0A) {
        LAS float* vec = (LAS float*)lds; LAS float* red = (LAS float*)(lds + 32768);
        for (int i = tid; i < 8 * 1024; i += NWAVES * 64) vec[i] = nv::silu(c_in[i]);
        __syncthreads();
        for (int it = bx; it < 4 * 48; it += G) { const int l = it / 48, jc = it % 48;
            gemv8_item(ada_w + (size_t)l * 1024 * 3072, 3072, jc * 64, vec, red, ada_b + l * 3072, mod + (size_t)l * 8 * 3072, 3072, wave, lane); }
        __syncthreads();
        LAS float* scr = (LAS float*)(lds + wave * 16384);
        constexpr int I_WE = 16 * 128, I_WO = 16 * 32, I_CE = 16 * 80;
        constexpr int NITEMS = 2 * I_WE + 2 * I_WO + 2 * I_CE + 2 * I_WO;
        for (int it = gw; it < NITEMS; it += NGW) { int r = it;
            if (r < 2 * I_WE) { const int j = r / I_WE; p0_transpose_item(ab_w_in + (size_t)j * 1024 * 4096, 1024, 4096, (bf16*)(ws + WS_WIN_E) + (size_t)j * 4096 * 1024, scr, r % I_WE, lane); continue; } r -= 2 * I_WE;
            if (r < 2 * I_WO) { const int j = r / I_WO; p0_transpose_item(ab_w_out + (size_t)j * 1024 * 1024, 1024, 1024, (bf16*)(ws + WS_WOUT_E) + (size_t)j * 1024 * 1024, scr, r % I_WO, lane); continue; } r -= 2 * I_WO;
            if (r < 2 * I_CE) { const int j = r / I_CE; p0_transpose_item(c_w_in + (size_t)j * 1024 * 2560, 1024, 2560, (bf16*)(ws + WS_WIN_O) + (size_t)j * 2560 * 1024, scr, r % I_CE, lane); continue; } r -= 2 * I_CE;
            { const int j = r / I_WO; p0_transpose_item(c_w_out + (size_t)j * 1024 * 1024, 1024, 1024, (bf16*)(ws + WS_WOUT_O) + (size_t)j * 1024 * 1024, scr, r % I_WO, lane); } }
        for (int i = bx * 512 + tid; i < 3 * M_; i += G * 512) ssq[M_ + i] = 0.f;
        if (bx == 0 && tid < 2) { const float* lq1 = args.in[7]; const float* lk1 = args.in[8]; const float* lq2 = args.in[9]; const float* lk2 = args.in[10];
            float s1 = 0.f, s2 = 0.f;
            for (int d = 0; d < 64; ++d) { s1 += lq1[tid * 64 + d] * lk1[tid * 64 + d]; s2 += lq2[tid * 64 + d] * lk2[tid * 64 + d]; }
            lam[tid] = expf(s1) - expf(s2) + (0.8f - 0.6f * expf(-0.3f * (float)(2 * tid))); }
        __syncthreads();
    }
    SEAM(PH_P0A);
    if (IN(PH_P0B)) REPS(PH_P0B) {
        LAS float* vec = (LAS float*)lds; LAS float* red = (LAS float*)(lds + 32768);
        int cur_l = -1;
        for (int it = bx; it < 2 * 64 + 2 * 40; it += G) {
            int l, nc; if (it < 128) { l = (it / 64) * 2; nc = it % 64; } else { l = ((it - 128) / 40) * 2 + 1; nc = (it - 128) % 40; }
            if (l != cur_l) { __syncthreads(); for (int i = tid; i < 8 * 1024; i += NWAVES * 64) vec[i] = mod[(size_t)l * 8 * 3072 + (i >> 10) * 3072 + (i & 1023)]; cur_l = l; __syncthreads(); }
            const int j = l >> 1; const float* W = (l & 1) ? c_w_in + (size_t)j * 1024 * 2560 : ab_w_in + (size_t)j * 1024 * 4096; const int ldw = (l & 1) ? 2560 : 4096;
            gemv8_item(W, ldw, nc * 64, vec, red, nullptr, shw + (size_t)l * 8 * 4096, 4096, wave, lane); }
        {
            const f32x4* gr = (const f32x4*)norm_g + lane; f32x4 gv[4];
#pragma unroll
            for (int j = 0; j < 4; ++j) gv[j] = gr[64 * j];
#pragma unroll 1
            for (int row0 = gw; row0 < M_; row0 += 4 * NGW) {
                f32x4 xv[4][4], sv[4][4];
#pragma unroll
                for (int q = 0; q < 4; ++q) { const int row = row0 + q * NGW; const int rr = row < M_ ? row : row0; const int b = rr >> 11;
                    const GAS f32x4* xr = (const GAS f32x4*)(x_in + (size_t)rr * D_) + lane; const f32x4* sr = (const f32x4*)(mod + (size_t)b * 3072 + 1024) + lane;
#pragma unroll
                    for (int j = 0; j < 4; ++j) { xv[q][j] = xr[64 * j]; sv[q][j] = sr[64 * j]; } }
#pragma unroll
                for (int q = 0; q < 4; ++q) { const int row = row0 + q * NGW; if (row >= M_) break;
                    GAS v2u* o8 = (GAS v2u*)(XS + (size_t)row * D_) + lane; float ss = 0.f;
#pragma unroll
                    for (int j = 0; j < 4; ++j) { const f32x4 v = xv[q][j], g = gv[j], s = sv[q][j]; ss += (v.x * v.x + v.y * v.y) + (v.z * v.z + v.w * v.w);
                        v2u o; o.x = pk2(v.x * g.x * (1.f + s.x), v.y * g.y * (1.f + s.y)); o.y = pk2(v.z * g.z * (1.f + s.z), v.w * g.w * (1.f + s.w)); o8[64 * j] = o; }
                    ss = wsum(ss); if (lane == 0) ssq[row] = ss; }
            }
        }
    }
    SEAM(PH_P0B);
    bool local_ok = use_bar && lo == 0 && G == 256 && myrank < 32u;
    if (local_ok) {
#pragma unroll
        for (int jx = 0; jx < 8; ++jx) local_ok = local_ok && (xb_ld(ctl + CW_RANK + 64 * jx) == 32u); }
    local_ok = __builtin_amdgcn_readfirstlane((int)local_ok) != 0;
    const int bbx = local_ok ? (int)myx : (vcu >> 5) & 7, rkx = local_ok ? (int)myrank : (vcu & 31);
    const int vcl = (vcu & ~255) + bbx * 32 + rkx;
    const int cgm = local_ok ? rkx * 8 + bbx : bx;
#define LSEAM(k) do { if (IN(k) && IN((k) + 1)) { if (local_ok) xcc_local_barrier(ctl + CW_LB, myx, ctl + CW_BAR + XB_TMO, wave); else xcd_barrier(bar); } } while (0)
#pragma unroll 1
    for (int l = 0; l < 4; ++l) {
        const int j = l >> 1, odd = l & 1; const int ph = PH_L0 + 4 * l;
        const float* mod_l = mod + (size_t)l * 8 * 3072;
        unsigned* syn = ctl + CW_SYN + (l * 8 + bbx) * 32;
        if (IN(ph)) REPS(ph) {
            const int N = odd ? 2560 : 4096;
            const bf16* Wt = odd ? (const bf16*)(ws + WS_WIN_O) + (size_t)j * 2560 * 1024 : (const bf16*)(ws + WS_WIN_E) + (size_t)j * 4096 * 1024;
            if (local_ok && l > 0 && IN(ph - 1)) cu_wait_ge(syn - 32 * 8 + 8 + (rkx & 7), 4u, ctl + CW_BAR + XB_TMO, wave);
            pg8::Gemm g{XS, Wt, M_, N, 1024}; pg8::HookOrder S; S.so.init(M_, N, G, cgm); S.r1 = (odd && local_ok && IN(ph + 1)) ? syn + 17 : nullptr; S.r2 = syn + 18;
            pg8::EpiProj E{odd, ssq + (size_t)l * M_, shw + (size_t)l * 8 * 4096, ws, (local_ok && l > 0 && IN(ph - 1)) ? syn - 32 * 8 + 16 : nullptr, 32u};
            pg8::gemm_phase<pg8::EpiProj, pg8::HookOrder, true, true>(lds, g, S, E, wave);
        }
        if (odd && local_ok) { if (IN(ph) && IN(ph + 1)) cu_wait_ge(syn + 17, 256u, ctl + CW_BAR + XB_TMO, wave); }
        else LSEAM(ph);
        if (IN(ph + 1)) REPS(ph + 1) {
            const bf16* SGp = (const bf16*)(ws + WS_SG); bf16* YMp = (bf16*)(ws + WS_YMIX);
            if (!odd) {
                REPS(100 + ph + 1) for (int u = vcl; u < 256; u += G) dilB_unit(lds, u >> 5, (u >> 2) & 7, u & 3, (const bf16*)(ws + WS_QA), (const bf16*)(ws + WS_KA), (const bf16*)(ws + WS_VA), STOp, (float*)(ws + WS_STML), wave);
                if (local_ok) { asm volatile("s_waitcnt vmcnt(0)" ::: "memory"); __syncthreads(); if (wg_leader(wave)) (void)xb_add(ctl + CW_GRP + (j * 64 + ((vcl >> 2) & 63)) * 4, 1u); }
                const float lam_init = __uint_as_float(__builtin_amdgcn_readfirstlane(__float_as_uint(0.8f - 0.6f * __expf(-0.3f * (float)l)))); const float lam_v = __uint_as_float(__builtin_amdgcn_readfirstlane(__float_as_uint(lam[j])));
                REPS(200 + ph + 1) for (int u = vcl; u < 512; u += G) { const int iu = u >> 8, ru = u & 31, bh = ((u >> 5) & 7) * 4, qt = 2 * (ru & 7) + iu; const int hh = iu ? 3 - (ru >> 3) : (ru >> 3);
                    diff_unit(lds, bh >> 2, hh, qt, (const bf16*)(ws + WS_QB), (const bf16*)(ws + WS_KB), (const bf16*)(ws + WS_VB), SGp, args.in[11] + j * 128, lam_v, lam_init, YMp, wave); }
            } else {
                const int late = rkx < 16 ? 1 : 0;
#pragma unroll 1
                for (int k = 0; k < 4; ++k) {
                    int gb, gg, gs, lo = 0, hi = 4;
                    if (local_ok) { if (k >= 2 - late) break; gb = bbx; gg = k ? (rkx >> 3) : (((rkx >> 3) + 2) & 3); gs = rkx & 7; lo = k ? 3 : 0; hi = (k || !late) ? 4 : 3;
                        if (k) cu_wait_ge(syn + 18, 128u, ctl + CW_BAR + XB_TMO, wave); }
                    else { const int u = vcl + k * G; if (u >= 256) break; gb = u >> 5; gg = (u >> 3) & 3; gs = u & 7; }
                    band_unit(lds, gb, gg, gs, (const bf16*)(ws + WS_QC), (const bf16*)(ws + WS_KC), (const bf16*)(ws + WS_VC), SGp, args.in[14] + j * 16, YMp, lo, hi, wave);
                }
            }
        }
        if (!odd && IN(ph + 1) && IN(ph + 2)) {
            if (local_ok) {
                cu_wait_ge(ctl + CW_GRP + (j * 64 + ((vcl >> 2) & 63)) * 4, 4u, ctl + CW_BAR + XB_TMO, wave);
            } else xcd_barrier(bar);
        }
        if (IN(ph + 2)) REPS(ph + 2) {
            if (!odd) {
                for (int u = vcl; u < 512; u += G) dilA_unit(lds, (u >> 5) & 7, (u & 31) >> 2, 2 * (u & 3) + (u >> 8), (const bf16*)(ws + WS_QA), (const bf16*)(ws + WS_KA), (const bf16*)(ws + WS_VA), STOp, (const float*)(ws + WS_STML), (const bf16*)(ws + WS_SG), (bf16*)(ws + WS_YMIX), wave);
            }
        }
        if (IN(ph + 2) && IN(ph + 3)) {
            if (local_ok) {
                asm volatile("s_waitcnt vmcnt(0)" ::: "memory"); __syncthreads();
                if (wg_leader(wave)) { (void)xb_add(syn + (rkx & 7), 1u); if (!odd) { (void)xb_add(syn + 2 * (rkx & 3), 1u); (void)xb_add(syn + 2 * (rkx & 3) + 1, 1u); } (void)xb_add(syn + 16, 1u); }
                cu_wait_ge(syn + (rkx & 7), odd ? 4u : 12u, ctl + CW_BAR + XB_TMO, wave);
            } else xcd_barrier(bar);
        }
        if (IN(ph + 3)) {
            const bf16* Wt = odd ? (const bf16*)(ws + WS_WOUT_O) + (size_t)j * 1024 * 1024 : (const bf16*)(ws + WS_WOUT_E) + (size_t)j * 1024 * 1024;
            pg8::Gemm g{(const bf16*)(ws + WS_YMIX), Wt, M_, 1024, 1024}; pg8::StaticOrder S; S.init(M_, 1024, G, cgm);
            if (l < 3) {
                pg8::EpiOutR E{l == 0 ? x_in : nullptr, X16, X16, mod_l + 2048, 1, norm_g + (l + 1) * 1024, mod_l + 8 * 3072 + 1024, XS, ssq + (size_t)(l + 1) * M_, nullptr, 0u};
                pg8::gemm_phase<pg8::EpiOutR, pg8::StaticOrder, true, true>(lds, g, S, E, wave);
                if (local_ok && IN(ph + 4) && wg_leader(wave)) (void)xb_add(syn + 8 + (rkx & 7), 1u);
            } else {
                pg8::EpiOutFinal E{X16, args.out, mod_l + 2048, final_g, (float*)(ws + WS_XCH), ctl + CW_PANEL, local_ok ? syn + 16 : nullptr, 32u};
                pg8::gemm_phase<pg8::EpiOutFinal, pg8::StaticOrder, false, true>(lds, g, S, E, wave);
            }
        }
        if (l < 3 && !local_ok && IN(ph + 3) && IN(ph + 4)) xcd_barrier(bar);
    }
    if (PROBE_CAT >= 0 && bx == PROBE_BLK && wave == 0) { const unsigned long long t0 = __builtin_readcyclecounter(), dur = (unsigned long long)PROBE_AMP * (PROBE_CAT == 8 ? pbar : pacc[(PROBE_CAT >= 0 && PROBE_CAT < 8) ? PROBE_CAT : 0]);
        while (__builtin_readcyclecounter() - t0 < dur) __builtin_amdgcn_s_sleep(8); }
#undef IN
#undef REPS
#undef SEAM
#undef LSEAM
}
}

static void launch_mega(const mk::Args& base, int lo, int hi, int grid, hipStream_t stream) {
    mk::Args a = base; a.ph_lo = lo; a.ph_hi = hi;
    hipLaunchKernelGGL(mk::mega, dim3(grid), dim3(mk::NWAVES * 64), mk::LDS_BYTES, stream, a);
}
extern "C" void kernel_launch(void* const* d_in, const int* in_sizes, int n_in, void* d_out, int out_size, void* d_ws, size_t ws_size, hipStream_t stream) {
    using namespace nv;
    static int grid = 0;
    if (grid == 0) {
        if (n_in != 16 || in_sizes[0] != M_ * D_ || out_size != M_ * D_ || ws_size < lay::WS_END) { fprintf(stderr, "kernel_launch: unexpected shapes / workspace (%d inputs, ws %zu)\n", n_in, ws_size); grid = -1; return; }
        int dev = 0, cus = 0, per_cu = 0;
        if (hipGetDevice(&dev) != hipSuccess || hipDeviceGetAttribute(&cus, hipDeviceAttributeMultiprocessorCount, dev) != hipSuccess) { grid = -1; return; }
        if (hipFuncSetAttribute((const void*)mk::mega, hipFuncAttributeMaxDynamicSharedMemorySize, mk::LDS_BYTES) != hipSuccess) { fprintf(stderr, "kernel_launch: hipFuncSetAttribute failed\n"); grid = -1; return; }
        if (hipOccupancyMaxActiveBlocksPerMultiprocessor(&per_cu, (const void*)mk::mega, mk::NWAVES * 64, mk::LDS_BYTES) != hipSuccess || per_cu < 1) { fprintf(stderr, "kernel_launch: occupancy query says %d blocks/CU\n", per_cu); per_cu = 1; }
        (void)hipGetLastError();
        grid = cus;
        if (grid != 256) fprintf(stderr, "kernel_launch: note: %d CUs\n", grid);
    }
    if (grid < 0) return;
    (void)hipMemsetAsync((char*)d_ws + lay::WS_CTL, 0, lay::CTL_ZERO_BYTES, stream);
    mk::Args a{};
    for (int i = 0; i < 16; ++i) a.in[i] = (const float*)d_in[i];
    a.out = (float*)d_out; a.ws = (unsigned char*)d_ws;
    launch_mega(a, mk::PH_P0A, mk::PH_END, grid, stream);
    const hipError_t le = hipPeekAtLastError();
    if (le != hipSuccess) fprintf(stderr, "kernel_launch: launch failed: %s\n", hipGetErrorName(le));
}
```
